# Optimizing an MI355X kernel written in HIP

```python
import math
import jax
import jax.numpy as jnp
from jax import lax
import numpy as np

D_MODEL = 1024
BATCH = 2
SEQ = 16384
DEPTH = 4

N_MIXERS = 3
MOBA_HEADS = 8
MOBA_HEAD_DIM = D_MODEL // MOBA_HEADS
MOBA_BLOCK = 256
MOBA_TOPK = 3
MOBA_Q_BLOCK = 64
SCONV_WIDTH = 3
GDN_HEADS = 8
GDN_HEAD_DIM = D_MODEL // GDN_HEADS
GDN_CONV_WIDTH = 4
GDN_CHUNK = 64
FFN_DIM = 2816
FFN_CONV_WIDTH = 3

NORM_EPS = 1e-6
NEG_INF = -1e30

N_MOBA = (DEPTH + 2) // 3
N_SCONV = (DEPTH + 1) // 3
N_GDN = DEPTH // 3

kernel_name = 'hybrid_moba_shortconv_gdn_convffn'


def rmsnorm(x, g):
    xf = x.astype(jnp.float32)
    y = xf * lax.rsqrt(jnp.mean(xf * xf, axis=-1, keepdims=True) + NORM_EPS)
    return (y * g.astype(jnp.float32)).astype(x.dtype)


def l2norm(x):
    return x * lax.rsqrt(jnp.sum(x * x, axis=-1, keepdims=True) + NORM_EPS)


def causal_dwconv(x, w):
    width = w.shape[0]
    seq = x.shape[1]
    xp = jnp.pad(x, ((0, 0), (width - 1, 0), (0, 0)))
    out = w[width - 1] * x
    for k in range(width - 1):
        out = out + w[k] * xp[:, k:k + seq]
    return out


def alibi_slopes(n_heads):
    return jnp.exp2(-8.0 * jnp.arange(1, n_heads + 1, dtype=jnp.float32) / n_heads)


def moba_attention(h, w_qkv, w_o):
    bsz, seq, _ = h.shape
    nh, hd, blk, qb = MOBA_HEADS, MOBA_HEAD_DIM, MOBA_BLOCK, MOBA_Q_BLOCK
    qkv = (h @ w_qkv).reshape(bsz, seq, 3, nh, hd)
    q, k, v = [jnp.swapaxes(qkv[:, :, i], 1, 2) for i in range(3)]
    n_blk = -(-seq // blk)
    pad = n_blk * blk - seq
    k_blocks = jnp.pad(k, ((0, 0), (0, 0), (0, pad), (0, 0))).reshape(bsz, nh, n_blk, blk, hd)
    v_blocks = jnp.pad(v, ((0, 0), (0, 0), (0, pad), (0, 0))).reshape(bsz, nh, n_blk, blk, hd)
    k_mean = jnp.mean(k_blocks.astype(jnp.float32), axis=3)
    n_top = min(MOBA_TOPK, n_blk)
    slopes = alibi_slopes(nh)
    scale = hd ** -0.5
    n_qb = seq // qb
    q_chunks = jnp.moveaxis(q.reshape(bsz, nh, n_qb, qb, hd), 2, 0)
    b_idx = jnp.arange(bsz)[:, None, None, None]
    h_idx = jnp.arange(nh)[None, :, None, None]
    blk_ids = jnp.arange(n_blk)
    offs = jnp.arange(blk)

    def attend(args):
        c, qc = args
        pos_q = c * qb + jnp.arange(qb)
        own = (c * qb) // blk
        gate = jnp.einsum('bhqd,bhnd->bhqn', qc.astype(jnp.float32), k_mean)
        gate = jnp.where(blk_ids < own, gate, NEG_INF)
        _, sel = lax.top_k(gate, n_top)
        sel_ok = jnp.arange(n_top) < own
        k_sel = k_blocks[b_idx, h_idx, sel]
        v_sel = v_blocks[b_idx, h_idx, sel]
        k_own = lax.dynamic_index_in_dim(k_blocks, own, axis=2, keepdims=False)
        v_own = lax.dynamic_index_in_dim(v_blocks, own, axis=2, keepdims=False)
        s_sel = jnp.einsum('bhqd,bhqjkd->bhqjk', qc, k_sel).astype(jnp.float32) * scale
        dist_sel = (pos_q[:, None, None] - (sel[..., None] * blk + offs)).astype(jnp.float32)
        s_sel = s_sel - slopes[:, None, None, None] * dist_sel
        s_sel = jnp.where(sel_ok[:, None], s_sel, NEG_INF)
        dist_own = pos_q[:, None] - (own * blk + offs)[None, :]
        s_own = jnp.einsum('bhqd,bhkd->bhqk', qc, k_own).astype(jnp.float32) * scale
        s_own = s_own - slopes[:, None, None] * dist_own.astype(jnp.float32)
        s_own = jnp.where(dist_own >= 0, s_own, NEG_INF)
        scores = jnp.concatenate([s_sel.reshape(bsz, nh, qb, n_top * blk), s_own], axis=-1)
        p = jax.nn.softmax(scores, axis=-1).astype(v.dtype)
        p_sel = p[..., :n_top * blk].reshape(bsz, nh, qb, n_top, blk)
        p_own = p[..., n_top * blk:]
        return (jnp.einsum('bhqjk,bhqjkd->bhqd', p_sel, v_sel)
                + jnp.einsum('bhqk,bhkd->bhqd', p_own, v_own))

    o = lax.map(attend, (jnp.arange(n_qb), q_chunks))
    o = jnp.moveaxis(o, 0, 2).reshape(bsz, nh, seq, hd)
    o = jnp.swapaxes(o, 1, 2).reshape(bsz, seq, nh * hd)
    return o @ w_o


def short_conv_mixer(h, w_in, conv_w, w_out):
    d = D_MODEL
    proj = h @ w_in
    b_gate, c_gate, xv = proj[..., :d], proj[..., d:2 * d], proj[..., 2 * d:]
    return (b_gate * causal_dwconv(c_gate * xv, conv_w)) @ w_out


def gated_deltanet(h, w_in, conv_w, a_log, dt_bias, norm_w, w_o):
    bsz, seq, _ = h.shape
    nh, dh, cs = GDN_HEADS, GDN_HEAD_DIM, GDN_CHUNK
    d = nh * dh
    f32 = jnp.float32
    proj = h @ w_in
    qkv = jax.nn.silu(causal_dwconv(proj[..., :3 * d], conv_w))
    z = proj[..., 3 * d:4 * d].reshape(bsz, seq, nh, dh).astype(f32)
    b_logit = proj[..., 4 * d:4 * d + nh].astype(f32)
    a_in = proj[..., 4 * d + nh:].astype(f32)
    q, k, v = [qkv[..., i * d:(i + 1) * d].reshape(bsz, seq, nh, dh).astype(f32) for i in range(3)]
    q = l2norm(q) * (dh ** -0.5)
    k = l2norm(k)
    beta = jax.nn.sigmoid(b_logit)
    g = -jnp.exp(a_log.astype(f32)) * jax.nn.softplus(a_in + dt_bias.astype(f32))
    n_ch = seq // cs

    def chunks(t):
        t = jnp.moveaxis(t, 2, 1)
        return t.reshape((bsz, nh, n_ch, cs) + t.shape[3:])

    q, k, v, beta, g = chunks(q), chunks(k), chunks(v), chunks(beta), chunks(g)
    gc = jnp.cumsum(g, axis=-1)
    idx = jnp.arange(cs)
    incl = idx[:, None] >= idx[None, :]
    strict = idx[:, None] > idx[None, :]
    diff = gc[..., :, None] - gc[..., None, :]
    decay = jnp.where(incl, jnp.exp(jnp.where(incl, diff, 0.0)), 0.0)
    k_beta = k * beta[..., None]
    v_beta = v * beta[..., None]
    a_mat = jnp.where(strict, jnp.einsum('bhnid,bhnjd->bhnij', k_beta, k) * decay, 0.0)
    eye = jnp.eye(cs, dtype=f32)
    t_mat = lax.linalg.triangular_solve(a_mat + eye, jnp.broadcast_to(eye, a_mat.shape),
                                        left_side=True, lower=True, unit_diagonal=True)
    u = t_mat @ v_beta
    w = t_mat @ (k_beta * jnp.exp(gc)[..., None])
    attn = jnp.where(incl, jnp.einsum('bhnid,bhnjd->bhnij', q, k) * decay, 0.0)
    q_dec = q * jnp.exp(gc)[..., None]
    g_last = gc[..., -1]
    k_dec = k * jnp.exp(g_last[..., None] - gc)[..., None]
    state_decay = jnp.exp(g_last)

    def step(state, inp):
        q_i, k_i, u_i, w_i, a_i, sd_i = inp
        v_new = u_i - w_i @ state
        o_i = q_i @ state + a_i @ v_new
        state = state * sd_i[..., None, None] + jnp.einsum('bhck,bhcv->bhkv', k_i, v_new)
        return state, o_i

    xs = (jnp.moveaxis(q_dec, 2, 0), jnp.moveaxis(k_dec, 2, 0), jnp.moveaxis(u, 2, 0),
          jnp.moveaxis(w, 2, 0), jnp.moveaxis(attn, 2, 0), jnp.moveaxis(state_decay, 2, 0))
    state0 = jnp.zeros((bsz, nh, dh, dh), f32)
    _, o = lax.scan(step, state0, xs)
    o = jnp.moveaxis(o, 0, 2).reshape(bsz, nh, seq, dh)
    o = jnp.swapaxes(o, 1, 2)
    o = o * lax.rsqrt(jnp.mean(o * o, axis=-1, keepdims=True) + NORM_EPS) * norm_w.astype(f32)
    o = o * jax.nn.silu(z)
    return o.reshape(bsz, seq, d).astype(h.dtype) @ w_o


def conv_ffn(h, w_up, conv_w, w_down):
    u = causal_dwconv(h @ w_up, conv_w)
    gate, up = u[..., :FFN_DIM], u[..., FFN_DIM:]
    return (jax.nn.silu(gate) * up) @ w_down


def setup_inputs(seed: int = 0) -> dict:
    key = jax.random.key(seed)
    ks = jax.random.split(key, 24)
    f32 = jnp.float32
    d = D_MODEL

    def dense(k, shape):
        return jax.random.normal(k, shape, f32) * (shape[-2] ** -0.5)

    def gain(k, shape):
        return 1.0 + 0.02 * jax.random.normal(k, shape, f32)

    def conv(k, shape):
        return jax.random.normal(k, shape, f32) * (shape[-2] ** -0.5)

    dt = jnp.exp(jax.random.uniform(ks[14], (N_GDN, GDN_HEADS), f32, math.log(1e-3), math.log(1e-1)))
    return {
        'x': jax.random.normal(ks[0], (BATCH, SEQ, d), f32),
        'mix_norm': gain(ks[1], (DEPTH, d)),
        'ffn_norm': gain(ks[2], (DEPTH, d)),
        'final_norm': gain(ks[3], (d,)),
        'moba_w_qkv': dense(ks[4], (N_MOBA, d, 3 * d)),
        'moba_w_o': dense(ks[5], (N_MOBA, d, d)),
        'sconv_w_in': dense(ks[6], (N_SCONV, d, 3 * d)),
        'sconv_conv': conv(ks[7], (N_SCONV, SCONV_WIDTH, d)),
        'sconv_w_out': dense(ks[8], (N_SCONV, d, d)),
        'gdn_w_in': dense(ks[9], (N_GDN, d, 4 * d + 2 * GDN_HEADS)),
        'gdn_conv': conv(ks[10], (N_GDN, GDN_CONV_WIDTH, 3 * d)),
        'gdn_a_log': jnp.log(jax.random.uniform(ks[11], (N_GDN, GDN_HEADS), f32, 1.0, 16.0)),
        'gdn_dt_bias': dt + jnp.log(-jnp.expm1(-dt)),
        'gdn_norm': gain(ks[12], (N_GDN, GDN_HEAD_DIM)),
        'gdn_w_o': dense(ks[13], (N_GDN, d, d)),
        'ffn_w_up': dense(ks[15], (DEPTH, d, 2 * FFN_DIM)),
        'ffn_conv': conv(ks[16], (DEPTH, FFN_CONV_WIDTH, 2 * FFN_DIM)),
        'ffn_w_down': dense(ks[17], (DEPTH, FFN_DIM, d)),
    }


def reference(x, mix_norm, ffn_norm, final_norm, moba_w_qkv, moba_w_o, sconv_w_in, sconv_conv,
              sconv_w_out, gdn_w_in, gdn_conv, gdn_a_log, gdn_dt_bias, gdn_norm, gdn_w_o,
              ffn_w_up, ffn_conv, ffn_w_down):
    for i in range(DEPTH):
        kind, j = i % N_MIXERS, i // N_MIXERS
        h = rmsnorm(x, mix_norm[i])
        if kind == 0:
            h = moba_attention(h, moba_w_qkv[j], moba_w_o[j])
        elif kind == 1:
            h = short_conv_mixer(h, sconv_w_in[j], sconv_conv[j], sconv_w_out[j])
        else:
            h = gated_deltanet(h, gdn_w_in[j], gdn_conv[j], gdn_a_log[j], gdn_dt_bias[j],
                               gdn_norm[j], gdn_w_o[j])
        x = x + h
        x = x + conv_ffn(rmsnorm(x, ffn_norm[i]), ffn_w_up[i], ffn_conv[i], ffn_w_down[i])
    return rmsnorm(x, final_norm)
```

```cpp
#include <hip/hip_runtime.h>
#include <stdio.h>
#include <string.h>

#ifndef MK_N_LAUNCHES
#define MK_N_LAUNCHES 1
#endif

#define LAS __attribute__((address_space(3)))
typedef unsigned short bf16_t;
typedef short bf16x8 __attribute__((ext_vector_type(8)));
typedef float f32x4 __attribute__((ext_vector_type(4)));
typedef float f32x2 __attribute__((ext_vector_type(2)));
typedef unsigned u32x4 __attribute__((ext_vector_type(4)));
typedef unsigned u32x2 __attribute__((ext_vector_type(2)));

constexpr int T_TOK = 32768, SEQ = 16384, DM = 1024, FFD = 2816, NH = 8, HD = 128, NBLK = 64, BLK = 256;
constexpr float EPS = 1e-6f;
constexpr float LOG2E = 1.4426950408889634f, LN2 = 0.6931471805599453f;

constexpr size_t MiB = 1u << 20;
constexpr size_t WS_CTL = 0, CTL_ZERO_BYTES = 4 * MiB;
constexpr size_t CTL_CNT = 512 * 1024;
constexpr size_t WS_SSQ = 1 * MiB;
constexpr size_t WS_MISC = 6 * MiB;
constexpr size_t MISC_KMEAN = 0, MISC_BGW = 512 * 1024;
constexpr size_t WS_W = 7 * MiB;
constexpr size_t WS_XB = 107 * MiB;
constexpr size_t WS_S = 171 * MiB;
constexpr size_t WS_END = 512 * MiB;
constexpr size_t W_MOBA_QKV0 = 0, W_MOBA_QKV1 = 6 * MiB, W_MOBA_O0 = 12 * MiB, W_MOBA_O1 = 14 * MiB, W_SC_IN = 16 * MiB, W_SC_OUT = 22 * MiB,
                 W_GDN_IN = 24 * MiB, W_GDN_O = 32 * MiB, W_FFN_UP = 34 * MiB, W_FFN_UP_STRIDE = 11 * MiB, W_FFN_DN = 78 * MiB, W_FFN_DN_STRIDE = 5767168;
constexpr size_t S_MOBA_KN = 322 * MiB, S_MOBA_KMAX = 323 * MiB, S_MOBA_MASK = 324 * MiB;
constexpr size_t S_MOBA_QKV = 0, S_MOBA_PO = 192 * MiB, S_MOBA_LIST = 288 * MiB, S_MOBA_LSE = 320 * MiB;
constexpr size_t S_SC_PROJ = 0, S_SC_Y = 192 * MiB;
constexpr size_t S_GDN_PROJ = 0, S_GDN_ATTN = 256 * MiB, S_GDN_BG = 288 * MiB, S_GDN_HALO = 290 * MiB, S_GDN_GC = 300 * MiB;
constexpr size_t S_FFN_ACT = 0, S_FFN_HALO = 176 * MiB;

constexpr int LDS_BYTES = 163840;
constexpr int LDS_BARW = 163840 - 64;

__device__ __forceinline__ unsigned cvt_pk_bf16(float lo, float hi) { unsigned r; asm volatile("v_cvt_pk_bf16_f32 %0, %1, %2" : "=v"(r) : "v"(lo), "v"(hi)); return r; }
__device__ __forceinline__ float bf_lo(unsigned u) { return __builtin_bit_cast(float, u << 16); }
__device__ __forceinline__ float bf_hi(unsigned u) { return __builtin_bit_cast(float, u & 0xffff0000u); }
__device__ __forceinline__ f32x4 bf4(u32x2 w) { return (f32x4){bf_lo(w.x), bf_hi(w.x), bf_lo(w.y), bf_hi(w.y)}; }
__device__ __forceinline__ float bf2f(bf16_t b) { return __builtin_bit_cast(float, (unsigned)b << 16); }
__device__ __forceinline__ bf16_t f2bf(float f) { unsigned u = __builtin_bit_cast(unsigned, f); return (bf16_t)((u + 0x7fffu + ((u >> 16) & 1u)) >> 16); }
__device__ __forceinline__ float fast_exp2(float x) { return __builtin_amdgcn_exp2f(x); }
__device__ __forceinline__ float fast_rcp(float x) { return __builtin_amdgcn_rcpf(x); }
__device__ __forceinline__ float silu_f(float x) { return x * fast_rcp(1.0f + fast_exp2(-x * LOG2E)); }
__device__ __forceinline__ int opaque_tid() { int t = threadIdx.x; asm volatile("" : "+v"(t)); return t; }
typedef unsigned long long u64_t;
constexpr float SSQ_SCALE = 4294967296.0f, SSQ_INV = 1.0f / 4294967296.0f;
__device__ __forceinline__ u64_t ssq_fix(float s) { return (u64_t)(s * SSQ_SCALE); }
__device__ __forceinline__ float ssq_rs(u64_t v) { return 1.0f / sqrtf((float)v * (SSQ_INV / DM) + EPS); }
__device__ __forceinline__ float wave_sum(float v) {
#pragma unroll
    for (int o = 1; o < 64; o <<= 1) v += __shfl_xor(v, o);
    return v;
}
__device__ __forceinline__ float dpp_shr1(float v) {
    return __builtin_bit_cast(float, __builtin_amdgcn_update_dpp(0, __builtin_bit_cast(int, v), 0x111, 0xf, 0xf, false));
}
__device__ __forceinline__ bf16x8 pack8(f32x4 a, f32x4 b) {
    u32x4 p;
    asm volatile("v_cvt_pk_bf16_f32 %0, %4, %5\n\tv_cvt_pk_bf16_f32 %1, %6, %7\n\tv_cvt_pk_bf16_f32 %2, %8, %9\n\tv_cvt_pk_bf16_f32 %3, %10, %11\n\ts_nop 1"
                 : "=&v"(p[0]), "=&v"(p[1]), "=&v"(p[2]), "=&v"(p[3])
                 : "v"(a[0]), "v"(a[1]), "v"(a[2]), "v"(a[3]), "v"(b[0]), "v"(b[1]), "v"(b[2]), "v"(b[3]));
    return __builtin_bit_cast(bf16x8, p);
}

#define XB_TMO      128
#define XB_XCNT(j)  (256  + 64 * (j))
#define XB_XSUB(j)  (1280 + 64 * (j))
#define XB_XGEN(j)  (2304 + 64 * (j))
#define XB_TOP      3328
#define XB_TOPGEN   3392
#define XCD_BAR_WORDS 3456
#define XB_SPIN_CAP (1u << 18)
__device__ __forceinline__ unsigned xb_ld(unsigned* p)              { return __hip_atomic_load(p, __ATOMIC_RELAXED, __HIP_MEMORY_SCOPE_AGENT); }
__device__ __forceinline__ unsigned xb_add(unsigned* p, unsigned v) { return __hip_atomic_fetch_add(p, v, __ATOMIC_RELAXED, __HIP_MEMORY_SCOPE_AGENT); }
__device__ __forceinline__ unsigned xb_xcc_id() { return (unsigned)__builtin_amdgcn_s_getreg((3 << 11) | 20) & 0xFu; }
#define XB_SPIN(cond, bar) do { unsigned _sp = 0; while (cond) { __builtin_amdgcn_s_sleep(1); \
    if ((++_sp & 255u) == 0u) { if (xb_ld(&(bar)[XB_TMO])) break; if (_sp > XB_SPIN_CAP) { atomicAdd(&(bar)[XB_TMO], 1u); break; } } } } while (0)
struct XcdBarrier { unsigned* bar; unsigned x; volatile LAS unsigned* st; };
__device__ __forceinline__ XcdBarrier xcd_barrier_post(unsigned* bar, volatile LAS unsigned* st) {
    XcdBarrier b; b.bar = bar; b.x = xb_xcc_id(); b.st = st;
    if (threadIdx.x == 0) (void)xb_add(&bar[XB_XCNT(b.x)], 1u);
    return b;
}
__device__ __forceinline__ void xcd_barrier_complete(unsigned* bar, unsigned x, unsigned& nloc, unsigned& nx) {
    const unsigned G = gridDim.x * gridDim.y * gridDim.z;
    unsigned sum, cnt, mine, sp = 0u;
    for (;;) {
        sum = 0u; cnt = 0u; mine = 0u;
#pragma unroll
        for (unsigned j = 0; j < 16; ++j) { const unsigned c = xb_ld(&bar[XB_XCNT(j)]); sum += c; cnt += (c > 0u) ? 1u : 0u; mine = (j == x) ? c : mine; }
        if (sum == G) break;
        __builtin_amdgcn_s_sleep(1);
        if ((++sp & 255u) == 0u) { if (xb_ld(&bar[XB_TMO])) break; if (sp > XB_SPIN_CAP) { atomicAdd(&bar[XB_TMO], 1u); break; } }
    }
    nloc = mine > 0u ? mine : 1u; nx = cnt > 0u ? cnt : 1u;
}
__device__ __forceinline__ void xcd_barrier(const XcdBarrier& b) {
    asm volatile("s_waitcnt vmcnt(0)" ::: "memory");
    __syncthreads();
    if (threadIdx.x == 0) {
        unsigned* bar = b.bar;
        __builtin_amdgcn_s_waitcnt(0);
        unsigned nloc = b.st[0], nx = b.st[1];
        if (nloc == 0u) { xcd_barrier_complete(bar, b.x, nloc, nx); b.st[0] = nloc; b.st[1] = nx; }
        const unsigned old = xb_add(&bar[XB_XSUB(b.x)], 1u);
        const unsigned gen = old / nloc;
        if (old + 1u == (gen + 1u) * nloc) {
            __builtin_amdgcn_fence(__ATOMIC_RELEASE, "agent");
            asm volatile("s_waitcnt vmcnt(0)" ::: "memory");
            const unsigned og = xb_add(&bar[XB_TOP], 1u);
            const unsigned tg = og / nx;
            if (og + 1u == (tg + 1u) * nx) xb_add(&bar[XB_TOPGEN], 1u);
            else XB_SPIN(xb_ld(&bar[XB_TOPGEN]) == tg, bar);
            __builtin_amdgcn_fence(__ATOMIC_ACQUIRE, "agent");
            xb_add(&bar[XB_XGEN(b.x)], 1u);
            asm volatile("s_waitcnt vmcnt(0)" ::: "memory");
        } else {
            XB_SPIN(xb_ld(&bar[XB_XGEN(b.x)]) == gen, bar);
            __builtin_amdgcn_fence(__ATOMIC_ACQUIRE, "agent");
            asm volatile("s_waitcnt vmcnt(0)" ::: "memory");
        }
    }
    __syncthreads();
}

namespace pg8 {
constexpr int BM = 256, BK = 64, HALF = 128, HTB = HALF * BK * 2, STAGE_BYTES = 8 * HTB, NXCD = 8, WGM = 8;
__host__ __device__ __forceinline__ int lds_byte(int r, int c) { const int st = (r >> 4) * 2 + (c >> 5), rr = r & 15, cc = c & 31, ob = rr * 64 + cc * 2; return st * 1024 + (ob ^ (((ob >> 9) & 1) << 5)); }
__host__ __device__ __forceinline__ void stage_rc(int b, int& R, int& C) { const int st = b / 1024, sb = b % 1024, swz = sb ^ (((sb >> 9) & 1) << 5); R = (st >> 1) * 16 + swz / 64; C = (st & 1) * 32 + (swz % 64) / 2; }
__host__ __device__ __forceinline__ int perm32(int rho) { const int n = rho >> 4, i = rho & 15; return 8 * (i >> 2) + 4 * n + (i & 3); }
struct Unit { int pm, pn; };
struct Gemm { const bf16_t* A; const bf16_t* Bt; int M, N, K, lda; };
struct StaticOrder {
    int nM, nN, nwg, G, c;
    __host__ __device__ void init(int M, int N, int G_, int c_) { nM = M / BM; nN = N / BM; nwg = nM * nN; G = G_; c = c_; }
    __host__ __device__ bool next(int i, Unit& u) const {
        const long L = (long)i * G + c; if (L >= nwg) return false;
        int wgid = (int)L; { const int q = nwg / NXCD, r = nwg % NXCD, xcd = wgid % NXCD, off = wgid / NXCD; wgid = (xcd < r ? xcd * (q + 1) : r * (q + 1) + (xcd - r) * q) + off; }
        const int nig = WGM * nN, gid = wgid / nig, fm = gid * WGM, gsz = (nM - fm) < WGM ? (nM - fm) : WGM;
        u.pm = fm + ((wgid % nig) % gsz); u.pn = (wgid % nig) / gsz; return true;
    }
};
template <class Epi, bool TOKPERM>
__device__ __forceinline__ void gemm_phase(LAS unsigned char* lds, const Gemm g, const StaticOrder& S, const Epi& E) {
    const int tid = opaque_tid(), wid = __builtin_amdgcn_readfirstlane(tid >> 6), lane = tid & 63, wr = wid >> 2, wc = wid & 3, fr = lane & 15, fq = lane >> 4;
    const int K = g.K, nt = K / BK, lda = g.lda;
    unsigned voffA[2], voffB[2];
#pragma unroll
    for (int i = 0; i < 2; ++i) { int R, C; stage_rc(tid * 16 + i * 8192, R, C); const int Rb = (R & ~31) + perm32(R & 31);
        const int Ra = TOKPERM ? (128 * (R >> 6) + 8 * (R & 15) + ((R >> 4) & 3)) : R;
        voffA[i] = (unsigned)(Ra * lda + C) * 2u; voffB[i] = (unsigned)(Rb * K + C) * 2u; }
    const size_t kstep = (size_t)(BK * 2);
    const size_t hstepA = TOKPERM ? (size_t)4 * lda * 2 : (size_t)HALF * lda * 2, hstepB = (size_t)HALF * K * 2;
    const size_t tstepA = (size_t)BM * lda * 2, tstepB = (size_t)BM * K * 2;
    const unsigned ldsw = (unsigned)wid * 1024u;
    const int aoff = lds_byte(wr * 64 + fr, fq * 8), boff = lds_byte(wc * 32 + fr, fq * 8);
#define PG8_SA(b, h) (((b) * 2 + (h)) * HTB)
#define PG8_SB(b, h) ((4 + (b) * 2 + (h)) * HTB)
#define PG8_STAGE(bufoff, gbase, voff) do { _Pragma("unroll") for (int _i = 0; _i < 2; ++_i) \
        __builtin_amdgcn_global_load_lds((const unsigned*)((const char*)(gbase) + (voff)[_i]), (LAS unsigned*)(lds + (bufoff) + ldsw + _i * 8192), 16, 0, 0); } while (0)
#define PG8_LDA(dst, b, h) do { _Pragma("unroll") for (int m = 0; m < 4; ++m) _Pragma("unroll") for (int k = 0; k < 2; ++k) dst[m][k] = *(const LAS bf16x8*)(lds + PG8_SA(b, h) + aoff + m * 2048 + k * 1024); } while (0)
#define PG8_LDB(dst, b, h) do { _Pragma("unroll") for (int n = 0; n < 2; ++n) _Pragma("unroll") for (int k = 0; k < 2; ++k) dst[n][k] = *(const LAS bf16x8*)(lds + PG8_SB(b, h) + boff + n * 2048 + k * 1024); } while (0)
#define PG8_MMA(ai, bj, At, Bt) do { __builtin_amdgcn_s_setprio(1); _Pragma("unroll") for (int m = 0; m < 4; ++m) _Pragma("unroll") for (int n = 0; n < 2; ++n) _Pragma("unroll") for (int k = 0; k < 2; ++k) \
        acc[ai][bj][m][n] = __builtin_amdgcn_mfma_f32_16x16x32_bf16(Bt[n][k], At[m][k], acc[ai][bj][m][n], 0, 0, 0); __builtin_amdgcn_s_setprio(0); } while (0)
#define PG8_WAIT_V(n) asm volatile("s_waitcnt vmcnt(" #n ")" ::: "memory")
#define PG8_WAIT_L(n) asm volatile("s_waitcnt lgkmcnt(" #n ")" ::: "memory")
#define PG8_BAR __builtin_amdgcn_s_barrier()
#define PG8_SCHED __builtin_amdgcn_sched_barrier(0)
    Unit cur, nxt; int ui = 0;
    if (!S.next(0, cur)) return;
    f32x4 acc[2][2][4][2];
#pragma unroll
    for (int a = 0; a < 2; ++a)
#pragma unroll
        for (int b = 0; b < 2; ++b)
#pragma unroll
            for (int m = 0; m < 4; ++m)
#pragma unroll
                for (int n = 0; n < 2; ++n) acc[a][b][m][n] = (f32x4){0.f, 0.f, 0.f, 0.f};
    bf16x8 At[4][2], B0[2][2], B1[2][2];
    const char* cA = (const char*)g.A + (size_t)cur.pm * tstepA; const char* cB = (const char*)g.Bt + (size_t)cur.pn * tstepB;
    PG8_STAGE(PG8_SB(0, 0), cB, voffB); PG8_STAGE(PG8_SB(0, 1), cB + hstepB, voffB); PG8_STAGE(PG8_SA(0, 0), cA, voffA); PG8_STAGE(PG8_SA(0, 1), cA + hstepA, voffA);
    if (wr == 1) PG8_BAR;
    PG8_WAIT_V(2); PG8_BAR;
    PG8_STAGE(PG8_SB(1, 0), cB + kstep, voffB); PG8_STAGE(PG8_SA(1, 0), cA + kstep, voffA); PG8_STAGE(PG8_SB(1, 1), cB + hstepB + kstep, voffB);
    PG8_WAIT_V(6); PG8_BAR;
    for (;;) {
        const bool has_next = S.next(ui + 1, nxt);
        const char* nA = has_next ? (const char*)g.A + (size_t)nxt.pm * tstepA : cA; const char* nB = has_next ? (const char*)g.Bt + (size_t)nxt.pn * tstepB : cB;
        for (int t = 0; t < nt; t += 2) {
            const bool last = (t == nt - 2);
            const char* a1 = cA + (size_t)(t + 1) * kstep;
            const char* a2 = last ? nA : cA + (size_t)(t + 2) * kstep; const char* b2 = last ? nB : cB + (size_t)(t + 2) * kstep;
            const char* a3 = a2 + kstep; const char* b3 = b2 + kstep;
            PG8_LDB(B0, 0, 0); PG8_LDB(B1, 0, 1); PG8_SCHED; PG8_LDA(At, 0, 0); PG8_STAGE(PG8_SA(1, 1), a1 + hstepA, voffA);
            PG8_WAIT_V(8); PG8_WAIT_L(0); PG8_BAR; PG8_MMA(0, 0, At, B0); PG8_MMA(0, 1, At, B1); PG8_BAR; PG8_SCHED;
            PG8_LDA(At, 0, 1); PG8_STAGE(PG8_SB(0, 0), b2, voffB); PG8_STAGE(PG8_SB(0, 1), b2 + hstepB, voffB); PG8_STAGE(PG8_SA(0, 0), a2, voffA);
            PG8_WAIT_V(8); PG8_WAIT_L(0); PG8_BAR; PG8_MMA(1, 0, At, B0); PG8_MMA(1, 1, At, B1); PG8_BAR; PG8_SCHED;
            PG8_LDB(B0, 1, 0); PG8_LDB(B1, 1, 1); PG8_SCHED; PG8_LDA(At, 1, 0); PG8_STAGE(PG8_SA(0, 1), a2 + hstepA, voffA);
            PG8_WAIT_V(8); PG8_WAIT_L(0); PG8_BAR; PG8_MMA(0, 0, At, B0); PG8_MMA(0, 1, At, B1); PG8_BAR; PG8_SCHED;
            PG8_LDA(At, 1, 1); PG8_STAGE(PG8_SB(1, 0), b3, voffB); PG8_STAGE(PG8_SB(1, 1), b3 + hstepB, voffB); PG8_STAGE(PG8_SA(1, 0), a3, voffA);
            PG8_WAIT_V(8); PG8_WAIT_L(0); PG8_BAR; PG8_MMA(1, 0, At, B0); PG8_MMA(1, 1, At, B1); PG8_BAR; PG8_SCHED;
        }
        if (wr == 0) PG8_BAR;
        E(acc, cur, wr, wc, fr, fq);
        if (!has_next) break;
#pragma unroll
        for (int a = 0; a < 2; ++a)
#pragma unroll
            for (int b = 0; b < 2; ++b)
#pragma unroll
                for (int m = 0; m < 4; ++m)
#pragma unroll
                    for (int n = 0; n < 2; ++n) acc[a][b][m][n] = (f32x4){0.f, 0.f, 0.f, 0.f};
        cur = nxt; cA = nA; cB = nB; ++ui;
        if (wr == 1) PG8_BAR;
    }
    PG8_WAIT_V(0);
    PG8_BAR;
#undef PG8_SA
#undef PG8_SB
#undef PG8_STAGE
#undef PG8_LDA
#undef PG8_LDB
#undef PG8_MMA
#undef PG8_WAIT_V
#undef PG8_WAIT_L
#undef PG8_BAR
#undef PG8_SCHED
}

struct EpiIn {
    bf16_t* O; int ldc; const u64_t* ssq; bf16_t* halo;
    __device__ __forceinline__ void operator()(const f32x4 (&acc)[2][2][4][2], const Unit& u, int wr, int wc, int fr, int fq) const {
        const int row0 = u.pm * BM + wr * 64 + fr, col0 = u.pn * BM + wc * 32 + 8 * fq;
        u64_t sq[2][4];
#pragma unroll
        for (int ai = 0; ai < 2; ++ai)
#pragma unroll
            for (int m = 0; m < 4; ++m) sq[ai][m] = ssq[row0 + ai * HALF + m * 16];
        __builtin_amdgcn_sched_barrier(0);
#pragma unroll
        for (int ai = 0; ai < 2; ++ai)
#pragma unroll
            for (int m = 0; m < 4; ++m) { const int t = row0 + ai * HALF + m * 16; const float rs = ssq_rs(sq[ai][m]);
                bf16_t* rowp = O + (size_t)t * ldc + col0;
#pragma unroll
                for (int bj = 0; bj < 2; ++bj) { const f32x4 v0 = acc[ai][bj][m][0] * rs, v1 = acc[ai][bj][m][1] * rs;
                    u32x4 w; w.x = cvt_pk_bf16(v0[0], v0[1]); w.y = cvt_pk_bf16(v0[2], v0[3]); w.z = cvt_pk_bf16(v1[0], v1[1]); w.w = cvt_pk_bf16(v1[2], v1[3]);
                    *(u32x4*)(rowp + bj * HALF) = w;
                    if (halo != nullptr && m == 3 && fr >= 13 && (col0 + bj * HALF) < 3072) *(u32x4*)(halo + ((size_t)(t >> 6) * 3 + (fr - 13)) * 3072 + col0 + bj * HALF) = w; } }
    }
};
struct EpiOut {
    bf16_t* XB; u64_t* ssq_next; LAS float* ts;
    __device__ __forceinline__ void operator()(const f32x4 (&acc)[2][2][4][2], const Unit& u, int wr, int wc, int fr, int fq) const {
        const int row0 = u.pm * BM + wr * 64 + fr, col0 = u.pn * BM + wc * 32 + 8 * fq;
        u32x4 xin[2][4][2];
#pragma unroll
        for (int ai = 0; ai < 2; ++ai)
#pragma unroll
            for (int m = 0; m < 4; ++m)
#pragma unroll
                for (int bj = 0; bj < 2; ++bj) xin[ai][m][bj] = *(const u32x4*)(XB + (size_t)(row0 + ai * HALF + m * 16) * DM + col0 + bj * HALF);
        __builtin_amdgcn_sched_barrier(0);
#pragma unroll
        for (int ai = 0; ai < 2; ++ai)
#pragma unroll
            for (int m = 0; m < 4; ++m) { const int t = row0 + ai * HALF + m * 16; float ss = 0.f;
#pragma unroll
                for (int bj = 0; bj < 2; ++bj) { const u32x4 xi = xin[ai][m][bj];
                    f32x4 v0, v1; v0[0] = bf_lo(xi.x); v0[1] = bf_hi(xi.x); v0[2] = bf_lo(xi.y); v0[3] = bf_hi(xi.y); v1[0] = bf_lo(xi.z); v1[1] = bf_hi(xi.z); v1[2] = bf_lo(xi.w); v1[3] = bf_hi(xi.w);
                    v0 = v0 + acc[ai][bj][m][0]; v1 = v1 + acc[ai][bj][m][1];
                    u32x4 w; w.x = cvt_pk_bf16(v0[0], v0[1]); w.y = cvt_pk_bf16(v0[2], v0[3]); w.z = cvt_pk_bf16(v1[0], v1[1]); w.w = cvt_pk_bf16(v1[2], v1[3]);
                    *(u32x4*)(XB + (size_t)t * DM + col0 + bj * HALF) = w;
                    ss += (v0[0] * v0[0] + v0[1] * v0[1]) + (v0[2] * v0[2] + v0[3] * v0[3]) + (v1[0] * v1[0] + v1[1] * v1[1]) + (v1[2] * v1[2] + v1[3] * v1[3]); }
                ss += __shfl_xor(ss, 16); ss += __shfl_xor(ss, 32);
                if (fq == 0) ts[(wr * 64 + fr + ai * HALF + m * 16) * 4 + wc] = ss; }
        asm volatile("s_waitcnt lgkmcnt(0)" ::: "memory"); __builtin_amdgcn_s_barrier(); asm volatile("" ::: "memory");
        const int tid = opaque_tid();
        if (tid < 256) { const f32x4 p = *(const LAS f32x4*)(ts + tid * 4); atomicAdd(ssq_next + u.pm * BM + tid, ssq_fix((p[0] + p[1]) + (p[2] + p[3]))); }
    }
};
struct EpiUp {
    bf16_t* ACT; float* halo; const float* cw; const u64_t* ssq;
    __device__ __forceinline__ void operator()(f32x4 (&acc)[2][2][4][2], const Unit& u, int wr, int wc, int fr, int fq) const {
        asm volatile("" : "+v"(fr), "+v"(fq));
        const int tbase = u.pm * BM + 128 * wr + 8 * fr, ch0 = u.pn * 128 + wc * 32 + 8 * fq;
#pragma unroll
        for (int ai = 0; ai < 2; ++ai)
#pragma unroll
            for (int m = 0; m < 4; ++m) { const float rs = ssq_rs(ssq[tbase + 4 * ai + m]);
#pragma unroll
                for (int bj = 0; bj < 2; ++bj)
#pragma unroll
                    for (int n = 0; n < 2; ++n) acc[ai][bj][m][n] = acc[ai][bj][m][n] * rs; }
        if (fr == 0 || fr == 15) {
            float* hb = halo + ((size_t)(tbase >> 7) * 4 + (fr == 0 ? 0 : 2)) * (2 * FFD) + ch0;
#pragma unroll
            for (int jj = 0; jj < 2; ++jj)
#pragma unroll
                for (int n = 0; n < 2; ++n) {
                    const f32x4 g0 = (fr == 0) ? acc[0][0][jj][n] : acc[1][0][2 + jj][n], u0 = (fr == 0) ? acc[0][1][jj][n] : acc[1][1][2 + jj][n];
                    *(f32x4*)(hb + (size_t)jj * (2 * FFD) + 4 * n) = g0; *(f32x4*)(hb + (size_t)jj * (2 * FFD) + FFD + 4 * n) = u0; }
        }
#pragma unroll
        for (int n = 0; n < 2; ++n) {
#pragma unroll
            for (int half = 1; half >= 0; --half) {
                f32x4 w[3];
#pragma unroll
                for (int k = 0; k < 3; ++k) w[k] = *(const f32x4*)(cw + (size_t)k * (2 * FFD) + half * FFD + ch0 + 4 * n);
                f32x4 p6, p7;
#pragma unroll
                for (int e = 0; e < 4; ++e) { p6[e] = dpp_shr1(acc[1][half][2][n][e]); p7[e] = dpp_shr1(acc[1][half][3][n][e]); }
#pragma unroll
                for (int j = 7; j >= 0; --j) {
                    const int j1 = j >= 1 ? j - 1 : 0, j2 = j >= 2 ? j - 2 : 0;
                    const f32x4 x0 = acc[j >> 2][half][j & 3][n];
                    const f32x4 x1 = (j >= 1) ? acc[j1 >> 2][half][j1 & 3][n] : p7;
                    const f32x4 x2 = (j >= 2) ? acc[j2 >> 2][half][j2 & 3][n] : (j == 1 ? p7 : p6);
                    const f32x4 cv = w[2] * x0 + w[1] * x1 + w[0] * x2;
                    if (half == 1) acc[j >> 2][1][j & 3][n] = cv;
                    else { f32x4 a; const f32x4 up = acc[j >> 2][1][j & 3][n];
#pragma unroll
                        for (int e = 0; e < 4; ++e) a[e] = silu_f(cv[e]) * up[e];
                        acc[j >> 2][0][j & 3][n] = a; }
                }
                asm volatile("" ::: "memory");
            }
        }
#pragma unroll
        for (int j = 0; j < 8; ++j) {
            if (fr == 0 && j < 2) continue;
            const f32x4 v0 = acc[j >> 2][0][j & 3][0], v1 = acc[j >> 2][0][j & 3][1];
            u32x4 w; w.x = cvt_pk_bf16(v0[0], v0[1]); w.y = cvt_pk_bf16(v0[2], v0[3]); w.z = cvt_pk_bf16(v1[0], v1[1]); w.w = cvt_pk_bf16(v1[2], v1[3]);
            *(u32x4*)(ACT + (size_t)(tbase + j) * FFD + ch0) = w;
        }
    }
};
}

struct Params { const float* in[18]; float* out; unsigned char* ws; int ph_lo, ph_hi; };
enum { IN_X = 0, IN_MIXN, IN_FFNN, IN_FINN, IN_MOBA_QKV, IN_MOBA_O, IN_SC_IN, IN_SC_CONV, IN_SC_OUT, IN_GDN_IN, IN_GDN_CONV, IN_GDN_ALOG, IN_GDN_DTB, IN_GDN_NORM, IN_GDN_O, IN_FFN_UP, IN_FFN_CONV, IN_FFN_DN };

__device__ __forceinline__ void transpose_item(const float* W, int ldw, int K, int srccol0, const float* gain, bf16_t* WT, int dstrow0, int k0, LAS float* scr, int lane) {
    float wv[32];
    { const float* wp = W + (size_t)(k0 + (lane >> 5)) * ldw + srccol0 + (lane & 31); unsigned off = 0;
#pragma unroll
      for (int i = 0; i < 32; ++i) { wv[i] = wp[off]; off += 2 * ldw; asm volatile("" : "+v"(off)); }
      __builtin_amdgcn_sched_barrier(0); }
#pragma unroll
    for (int i = 0; i < 32; ++i) { const int kk = 2 * i + (lane >> 5); float v = wv[i]; if (gain) v *= gain[k0 + kk]; scr[kk * 33 + (lane & 31)] = v; }
    asm volatile("s_waitcnt lgkmcnt(0)" ::: "memory");
    const int c = lane & 7;
#pragma unroll
    for (int j = 0; j < 4; ++j) { const int n = (lane >> 3) + 8 * j; const LAS float* s = scr + (8 * c) * 33 + n;
        u32x4 o; o.x = cvt_pk_bf16(s[0 * 33], s[1 * 33]); o.y = cvt_pk_bf16(s[2 * 33], s[3 * 33]); o.z = cvt_pk_bf16(s[4 * 33], s[5 * 33]); o.w = cvt_pk_bf16(s[6 * 33], s[7 * 33]);
        *(u32x4*)(WT + (size_t)(dstrow0 + n) * K + k0 + 8 * c) = o; }
    asm volatile("s_waitcnt lgkmcnt(0)" ::: "memory");
}
__device__ __forceinline__ void phase_prologue(const Params& P, LAS unsigned char* lds, int wg, int G) {
    const int tid = opaque_tid(), lane = tid & 63, wave = tid >> 6;
    LAS float* scr = (LAS float*)(lds + wave * 16384);
    const int gw = wg * 8 + wave, NGW = G * 8;
    bf16_t* Wb = (bf16_t*)(P.ws + WS_W);
    constexpr int NITEMS = 3072 + 1024 + 1536 + 512 + 2048 + 512 + 4 * 2816 + 4 * 1408;
    for (int it = gw; it < NITEMS; it += NGW) {
        int r = it; const float* src; int ldw, K, N; const float* gain; size_t doff; int map = 0;
        if (r < 3072) { const int j = r / 1536; r -= j * 1536; src = P.in[IN_MOBA_QKV] + (size_t)j * DM * 3072; ldw = 3072; K = DM; N = 3072; gain = P.in[IN_MIXN] + (j == 0 ? 0 : 3) * DM; doff = j == 0 ? W_MOBA_QKV0 : W_MOBA_QKV1; }
        else if ((r -= 3072) < 1024) { const int j = r / 512; r -= j * 512; src = P.in[IN_MOBA_O] + (size_t)j * DM * DM; ldw = DM; K = DM; N = DM; gain = nullptr; doff = j == 0 ? W_MOBA_O0 : W_MOBA_O1; }
        else if ((r -= 1024) < 1536) { src = P.in[IN_SC_IN]; ldw = 3072; K = DM; N = 3072; gain = P.in[IN_MIXN] + 1 * DM; doff = W_SC_IN; }
        else if ((r -= 1536) < 512) { src = P.in[IN_SC_OUT]; ldw = DM; K = DM; N = DM; gain = nullptr; doff = W_SC_OUT; }
        else if ((r -= 512) < 2048) { src = P.in[IN_GDN_IN]; ldw = 4112; K = DM; N = 4096; gain = P.in[IN_MIXN] + 2 * DM; doff = W_GDN_IN; }
        else if ((r -= 2048) < 512) { src = P.in[IN_GDN_O]; ldw = DM; K = DM; N = DM; gain = nullptr; doff = W_GDN_O; }
        else if ((r -= 512) < 4 * 2816) { const int j = r / 2816; r -= j * 2816; src = P.in[IN_FFN_UP] + (size_t)j * DM * (2 * FFD); ldw = 2 * FFD; K = DM; N = 2 * FFD; gain = P.in[IN_FFNN] + j * DM; doff = W_FFN_UP + j * W_FFN_UP_STRIDE; map = 1; }
        else { r -= 4 * 2816; const int j = r / 1408; r -= j * 1408; src = P.in[IN_FFN_DN] + (size_t)j * FFD * DM; ldw = DM; K = FFD; N = DM; gain = nullptr; doff = W_FFN_DN + j * W_FFN_DN_STRIDE; }
        const int nblk = N / 32, kb = r / nblk, nb = r % nblk, n0 = 32 * nb;
        int sc0 = n0;
        if (map == 1) { const int tile = n0 >> 8, w = n0 & 255; sc0 = (w < 128) ? tile * 128 + w : FFD + tile * 128 + (w - 128); }
        transpose_item(src, ldw, K, sc0, gain, (bf16_t*)((unsigned char*)Wb + doff), n0, 64 * kb, scr, lane);
    }
    { float* bgw = (float*)(P.ws + WS_MISC + MISC_BGW); const float* src = P.in[IN_GDN_IN]; const float* gain = P.in[IN_MIXN] + 2 * DM;
      for (int i = wg * 512 + tid; i < 16 * DM; i += G * 512) { const int c = i >> 10, k = i & 1023; bgw[i] = src[(size_t)k * 4112 + 4096 + c] * gain[k]; } }
    { const float* x = P.in[IN_X]; bf16_t* xb = (bf16_t*)(P.ws + WS_XB); u64_t* ssq = (u64_t*)(P.ws + WS_SSQ);
      for (int t0 = gw; t0 < T_TOK; t0 += 4 * NGW) {
          f32x4 v[4][4];
#pragma unroll
          for (int r = 0; r < 4; ++r) { const f32x4* xr = (const f32x4*)(x + (size_t)(t0 + r * NGW) * DM) + lane;
#pragma unroll
              for (int j = 0; j < 4; ++j) v[r][j] = xr[64 * j]; }
#pragma unroll
          for (int r = 0; r < 4; ++r) { const int t = t0 + r * NGW; u32x2* brow = (u32x2*)(xb + (size_t)t * DM) + lane; float s = 0.f;
#pragma unroll
              for (int j = 0; j < 4; ++j) { const f32x4 q = v[r][j]; u32x2 w; w.x = cvt_pk_bf16(q[0], q[1]); w.y = cvt_pk_bf16(q[2], q[3]); brow[64 * j] = w; s += (q[0] * q[0] + q[1] * q[1]) + (q[2] * q[2] + q[3] * q[3]); }
              s = wave_sum(s); if (lane == 0) ssq[t] = ssq_fix(s); } } }
}

__device__ __forceinline__ void phase_final(const Params& P, int wg, int G) {
    const int tid = opaque_tid(), lane = tid & 63, wave = tid >> 6, gw = wg * 8 + wave, NGW = G * 8;
    const u64_t* ssq = (const u64_t*)(P.ws + WS_SSQ) + (size_t)8 * T_TOK; const f32x4* gn = (const f32x4*)P.in[IN_FINN] + lane; const bf16_t* xb = (const bf16_t*)(P.ws + WS_XB);
    const f32x4 g0 = gn[0], g1 = gn[64], g2 = gn[128], g3 = gn[192];
    for (int t0 = gw; t0 < T_TOK; t0 += 4 * NGW) {
        u32x2 v[4][4]; float rs[4];
#pragma unroll
        for (int r = 0; r < 4; ++r) { const int t = t0 + r * NGW; rs[r] = ssq_rs(ssq[t]); const u32x2* xr = (const u32x2*)(xb + (size_t)t * DM) + lane;
#pragma unroll
            for (int j = 0; j < 4; ++j) v[r][j] = xr[64 * j]; }
#pragma unroll
        for (int r = 0; r < 4; ++r) { const int t = t0 + r * NGW; f32x4* xo = (f32x4*)(P.out + (size_t)t * DM) + lane;
            xo[0] = bf4(v[r][0]) * rs[r] * g0; xo[64] = bf4(v[r][1]) * rs[r] * g1; xo[128] = bf4(v[r][2]) * rs[r] * g2; xo[192] = bf4(v[r][3]) * rs[r] * g3; }
    }
}

__device__ __forceinline__ void phase_ffn_fix(const Params& P, int layer, int wg, int G) {
    const float* halo = (const float*)(P.ws + WS_S + S_FFN_HALO); bf16_t* act = (bf16_t*)(P.ws + WS_S + S_FFN_ACT); const float* cw = P.in[IN_FFN_CONV] + (size_t)layer * 3 * (2 * FFD);
    const int tid = opaque_tid();
    for (int i = wg * 512 + tid; i < 512 * FFD; i += G * 512) {
        const int row = i / FFD, c = i - row * FFD, g = row >> 1, tau = row & 1, t = 128 * g + tau, s = t & (SEQ - 1);
        const float* hg = halo + (size_t)g * 4 * (2 * FFD); const float* hp = hg - 4 * (2 * FFD);
        float g0, g1, g2, u0, u1, u2;
        if (tau == 0) { g0 = hg[c]; u0 = hg[FFD + c]; if (s >= 2) { g1 = hp[3 * (2 * FFD) + c]; u1 = hp[3 * (2 * FFD) + FFD + c]; g2 = hp[2 * (2 * FFD) + c]; u2 = hp[2 * (2 * FFD) + FFD + c]; } else { g1 = g2 = u1 = u2 = 0.f; } }
        else { g0 = hg[(2 * FFD) + c]; u0 = hg[(2 * FFD) + FFD + c]; g1 = hg[c]; u1 = hg[FFD + c]; if (s >= 2) { g2 = hp[3 * (2 * FFD) + c]; u2 = hp[3 * (2 * FFD) + FFD + c]; } else { g2 = u2 = 0.f; } }
        const float gc = cw[2 * (2 * FFD) + c] * g0 + cw[(2 * FFD) + c] * g1 + cw[c] * g2;
        const float uc = cw[2 * (2 * FFD) + FFD + c] * u0 + cw[(2 * FFD) + FFD + c] * u1 + cw[FFD + c] * u2;
        act[(size_t)t * FFD + c] = f2bf(silu_f(gc) * uc);
    }
}

__device__ __forceinline__ void phase_sconv(const Params& P, int wg, int G) {
    const bf16_t* proj = (const bf16_t*)(P.ws + WS_S + S_SC_PROJ); bf16_t* y = (bf16_t*)(P.ws + WS_S + S_SC_Y); const float* cw = P.in[IN_SC_CONV];
    const int c = 2 * opaque_tid();
    const float w00 = cw[c], w01 = cw[c + 1], w10 = cw[DM + c], w11 = cw[DM + c + 1], w20 = cw[2 * DM + c], w21 = cw[2 * DM + c + 1];
    for (int ch = wg; ch < T_TOK / 64; ch += G) {
        const int t0 = ch * 64, s0 = t0 & (SEQ - 1);
        float p1a = 0.f, p1b = 0.f, p2a = 0.f, p2b = 0.f;
        if (s0 != 0) {
            const unsigned c1 = *(const unsigned*)(proj + (size_t)(t0 - 1) * 3072 + DM + c), x1 = *(const unsigned*)(proj + (size_t)(t0 - 1) * 3072 + 2 * DM + c);
            const unsigned c2 = *(const unsigned*)(proj + (size_t)(t0 - 2) * 3072 + DM + c), x2 = *(const unsigned*)(proj + (size_t)(t0 - 2) * 3072 + 2 * DM + c);
            p1a = bf_lo(c1) * bf_lo(x1); p1b = bf_hi(c1) * bf_hi(x1); p2a = bf_lo(c2) * bf_lo(x2); p2b = bf_hi(c2) * bf_hi(x2);
        }
#pragma unroll 1
        for (int i0 = 0; i0 < 64; i0 += 16) {
            unsigned bb[16], cc[16], xx[16];
#pragma unroll
            for (int i = 0; i < 16; ++i) { const bf16_t* r = proj + (size_t)(t0 + i0 + i) * 3072; bb[i] = *(const unsigned*)(r + c); cc[i] = *(const unsigned*)(r + DM + c); xx[i] = *(const unsigned*)(r + 2 * DM + c); }
#pragma unroll
            for (int i = 0; i < 16; ++i) {
                const float pa = bf_lo(cc[i]) * bf_lo(xx[i]), pb = bf_hi(cc[i]) * bf_hi(xx[i]);
                const float ya = bf_lo(bb[i]) * (w20 * pa + w10 * p1a + w00 * p2a), yb = bf_hi(bb[i]) * (w21 * pb + w11 * p1b + w01 * p2b);
                *(unsigned*)(y + (size_t)(t0 + i0 + i) * DM + c) = cvt_pk_bf16(ya, yb);
                p2a = p1a; p2b = p1b; p1a = pa; p1b = pb; }
        }
    }
}

__device__ __forceinline__ void phase_moba_kmean_vt(const Params& P, LAS unsigned char* lds, int wg, int G) {
    const bf16_t* qkv = (const bf16_t*)(P.ws + WS_S + S_MOBA_QKV); bf16_t* kmh = (bf16_t*)(P.ws + WS_MISC + MISC_KMEAN); bf16_t* kml = kmh + 1024 * 128;
    const int tid = opaque_tid();
    LAS float* red = (LAS float*)lds;
    for (int u = wg; u < 1024; u += G) {
        const int b = u >> 9, h = (u >> 6) & 7, blk = u & 63; const size_t row0 = (size_t)b * SEQ + (size_t)blk * BLK;
        __syncthreads();
        { const int d2 = tid & 63, part = tid >> 6; float s0 = 0.f, s1 = 0.f; const bf16_t* kp = qkv + (row0 + part * 32) * 3072 + DM + h * HD + 2 * d2;
          unsigned kq[32];
#pragma unroll
          for (int i = 0; i < 32; ++i) kq[i] = *(const unsigned*)(kp + (size_t)i * 3072);
#pragma unroll
          for (int i = 0; i < 32; ++i) { s0 += bf_lo(kq[i]); s1 += bf_hi(kq[i]); }
          red[part * 128 + 2 * d2] = s0; red[part * 128 + 2 * d2 + 1] = s1; }
        {
            float* kn = (float*)(P.ws + WS_S + S_MOBA_KN); const int lane_ = tid & 63, w_ = tid >> 6; float mxn = 0.f; unsigned kv[32];
            const bf16_t* kp = qkv + (row0 + w_ * 32) * 3072 + DM + h * HD + 2 * lane_;
#pragma unroll
            for (int i = 0; i < 32; ++i) kv[i] = *(const unsigned*)(kp + (size_t)i * 3072);
#pragma unroll
            for (int i = 0; i < 32; ++i) { const float a = bf_lo(kv[i]), c = bf_hi(kv[i]); const float nn = sqrtf(wave_sum(a * a + c * c)); mxn = fmaxf(mxn, nn); if (lane_ == 0) kn[(row0 + w_ * 32 + i) * NH + h] = nn; }
            if (lane_ == 0) red[1024 + w_] = mxn; }
        __syncthreads();
        if (tid == 0) { float m = 0.f;
#pragma unroll
            for (int w = 0; w < 8; ++w) m = fmaxf(m, red[1024 + w]);
            ((float*)(P.ws + WS_S + S_MOBA_KMAX))[u] = m; }
        if (tid < 128) { float s = 0.f;
#pragma unroll
            for (int p = 0; p < 8; ++p) s += red[p * 128 + tid];
            const float m = s * (1.0f / BLK); const bf16_t hi = f2bf(m); kmh[(size_t)u * 128 + tid] = hi; kml[(size_t)u * 128 + tid] = f2bf(m - bf2f(hi)); }
    }
}


__device__ __forceinline__ void phase_moba_gate2(const Params& P, LAS unsigned char* lds, int mj, int wg, int G) {
    const bf16_t* qkv = (const bf16_t*)(P.ws + WS_S + S_MOBA_QKV); const bf16_t* kmh = (const bf16_t*)(P.ws + WS_MISC + MISC_KMEAN); const bf16_t* kml = kmh + 1024 * 128;
    int* cnt = (int*)(P.ws + WS_CTL + CTL_CNT) + mj * 1024; unsigned short* list = (unsigned short*)(P.ws + WS_S + S_MOBA_LIST);
    const int tid = opaque_tid(), lane = tid & 63, wave = __builtin_amdgcn_readfirstlane(tid >> 6), i16 = lane & 15, quad = lane >> 4;
    LAS float* SC = (LAS float*)(lds + 34816); LAS int* cntL = (LAS int*)(lds + 34816 + 66560); LAS int* baseL = cntL + 64; LAS float* qnL = (LAS float*)(baseL + 64); LAS float* kmxL = qnL + 256;
    for (int u = wg; u < 63 * 16; u += G) {
        const int own = 63 - u / 16, bh = u & 15, b = bh >> 3, h = bh & 7, nnb = (own + 15) >> 4;
        __syncthreads();
        if (tid < 64) cntL[tid] = 0;
        for (int c = tid; c < nnb * 256; c += 512) { const int row = c >> 4, pc = c & 15;
            *(LAS u32x4*)(lds + row * 272 + pc * 16) = *(const u32x4*)(kmh + (size_t)(bh * NBLK + row) * 128 + pc * 8);
            *(LAS u32x4*)(lds + 17408 + row * 272 + pc * 16) = *(const u32x4*)(kml + (size_t)(bh * NBLK + row) * 128 + pc * 8); }
        bf16x8 qf[2][4];
#pragma unroll
        for (int q2 = 0; q2 < 2; ++q2) { const bf16_t* qp = qkv + ((size_t)b * SEQ + own * BLK + 16 * (2 * wave + q2) + i16) * 3072 + h * HD + 8 * quad;
#pragma unroll
            for (int ks = 0; ks < 4; ++ks) qf[q2][ks] = *(const bf16x8*)(qp + 32 * ks);
            float s2 = 0.f;
#pragma unroll
            for (int ks = 0; ks < 4; ++ks) { const u32x4 w4 = __builtin_bit_cast(u32x4, qf[q2][ks]);
#pragma unroll
                for (int e = 0; e < 4; ++e) { const float a = bf_lo(w4[e]), c = bf_hi(w4[e]); s2 += a * a + c * c; } }
            s2 += __shfl_xor(s2, 16); s2 += __shfl_xor(s2, 32);
            if (quad == 0) qnL[16 * (2 * wave + q2) + i16] = s2; }
        if (tid < 64) kmxL[tid] = ((const float*)(P.ws + WS_S + S_MOBA_KMAX))[bh * NBLK + tid];
        __syncthreads();
#pragma unroll
        for (int q2 = 0; q2 < 2; ++q2)
#pragma unroll 1
            for (int nb = 0; nb < nnb; ++nb) { f32x4 acc = (f32x4){0.f, 0.f, 0.f, 0.f};
#pragma unroll
                for (int ks = 0; ks < 4; ++ks) { acc = __builtin_amdgcn_mfma_f32_16x16x32_bf16(qf[q2][ks], *(const LAS bf16x8*)(lds + 17408 + (16 * nb + i16) * 272 + (32 * ks + 8 * quad) * 2), acc, 0, 0, 0);
                                                 acc = __builtin_amdgcn_mfma_f32_16x16x32_bf16(qf[q2][ks], *(const LAS bf16x8*)(lds + (16 * nb + i16) * 272 + (32 * ks + 8 * quad) * 2), acc, 0, 0, 0); }
#pragma unroll
                for (int jj = 0; jj < 4; ++jj) SC[(16 * (2 * wave + q2) + 4 * quad + jj) * 65 + 16 * nb + i16] = acc[jj]; }
        __syncthreads();
        int sel[3] = {-1, -1, -1}, lp[3] = {0, 0, 0};
        if (tid < 256) { const LAS float* sr = SC + tid * 65;
            float v0 = -3.0e38f, v1 = -3.0e38f, v2 = -3.0e38f; int i0 = -1, i1 = -1, i2 = -1;
            for (int n = 0; n < own; ++n) { const float s = sr[n];
                if (s > v0) { v2 = v1; i2 = i1; v1 = v0; i1 = i0; v0 = s; i0 = n; } else if (s > v1) { v2 = v1; i2 = i1; v1 = s; i1 = n; } else if (s > v2) { v2 = s; i2 = n; } }
            sel[0] = i0; sel[1] = i1; sel[2] = i2;
            const int tl_ = own * BLK + tid; const float qn = sqrtf(qnL[tid]) * 0.08838834764831845f, kself = ((const float*)(P.ws + WS_S + S_MOBA_KN))[((size_t)b * SEQ + tl_) * NH + h], slope = exp2f(-(float)(h + 1));
            unsigned mbits = 0u;
#pragma unroll
            for (int s = 0; s < 3; ++s) if (sel[s] >= 0) { const float bound = qn * (kmxL[sel[s]] + kself) - slope * (float)(tl_ - (sel[s] * BLK + BLK - 1));
                if (bound < -110.0f) sel[s] = -1; else mbits |= 1u << s; }
            ((unsigned char*)(P.ws + WS_S + S_MOBA_MASK))[((size_t)b * SEQ + tl_) * NH + h] = (unsigned char)mbits;
#pragma unroll
            for (int s = 0; s < 3; ++s) lp[s] = (sel[s] >= 0) ? __hip_atomic_fetch_add(cntL + sel[s], 1, __ATOMIC_RELAXED, __HIP_MEMORY_SCOPE_WORKGROUP) : 0;
        }
        __syncthreads();
        if (tid < 64) { const int c = cntL[tid]; baseL[tid] = (c > 0) ? atomicAdd(cnt + (b * NH + h) * NBLK + tid, c) : 0; }
        __syncthreads();
        if (tid < 256) { const int tl = own * BLK + tid;
#pragma unroll
            for (int s = 0; s < 3; ++s) if (sel[s] >= 0) list[(size_t)((b * NH + h) * NBLK + sel[s]) * SEQ + baseL[sel[s]] + lp[s]] = (unsigned short)((tl << 2) | s); }
    }
}

constexpr int AT_KSTRIDE = 272, AT_VS = 256 * 272, AT_VSTRIDE = 288, AT_PREF = AT_VS + 256 * 288;
typedef short s16x4 __attribute__((ext_vector_type(4)));
struct AtRegs { u32x4 p[8]; bf16x8 q[4]; unsigned mbits; float ls[3]; };
#define AT_BAR() do { asm volatile("s_waitcnt lgkmcnt(0)" ::: "memory"); __builtin_amdgcn_s_barrier(); asm volatile("" ::: "memory"); } while (0)
template <bool OWN>
__device__ __forceinline__ void attn_issue_kq(const Params& P, int b, int h, int j, int tl, int tid, AtRegs& R) {
    const bf16_t* qkvb = (const bf16_t*)(P.ws + WS_S + S_MOBA_QKV) + (size_t)b * SEQ * 3072;
    const int piece = tid & 15, r0 = tid >> 4, quad = (tid & 63) >> 4;
    const char* kp = (const char*)(qkvb + (size_t)(j * BLK + 8 * ((r0 & 15) >> 2) + 4 * (r0 >> 4) + (r0 & 3)) * 3072 + DM + h * HD + piece * 8);
#pragma unroll
    for (int it = 0; it < 8; ++it) R.p[it] = *(const u32x4*)(kp + (size_t)it * (32 * 3072 * 2));
    const bf16_t* qp = qkvb + (size_t)tl * 3072 + h * HD + quad * 8;
#pragma unroll
    for (int ks = 0; ks < 4; ++ks) R.q[ks] = *(const bf16x8*)(qp + 32 * ks);
    if (OWN) { R.mbits = (j != 0) ? (unsigned)((const unsigned char*)(P.ws + WS_S + S_MOBA_MASK))[((size_t)b * SEQ + tl) * NH + h] : 0u;
        const float* plse = (const float*)(P.ws + WS_S + S_MOBA_LSE) + ((size_t)tl * NH + h) * 3;
#pragma unroll
        for (int s = 0; s < 3; ++s) R.ls[s] = plse[s]; }
}
template <bool OWN, int nkb>
__device__ __forceinline__ void attn_tile(const Params& P, LAS unsigned char* lds, int b, int h, int j, int tl, bool valid, int slot, AtRegs& R, bool hasN, int hN, int jN, int tlN) {
    const int tid = opaque_tid(), lane = tid & 63, i = lane & 15, quad = lane >> 4, piece = tid & 15, r0 = tid >> 4;
    bf16_t* qkvb = (bf16_t*)(P.ws + WS_S + S_MOBA_QKV) + (size_t)b * SEQ * 3072;
    AT_BAR();
#pragma unroll
    for (int it = 0; it < 8; ++it) *(LAS u32x4*)(lds + (r0 + 32 * it) * AT_KSTRIDE + piece * 16) = R.p[it];
    bf16x8 qf[4]; unsigned mbits = 0u; float ls[3] = {0.f, 0.f, 0.f};
#pragma unroll
    for (int ks = 0; ks < 4; ++ks) qf[ks] = R.q[ks];
    if (OWN) { mbits = R.mbits;
#pragma unroll
        for (int s = 0; s < 3; ++s) ls[s] = R.ls[s]; }
    AT_BAR();
    bf16_t* op = qkvb + (size_t)tl * 3072 + h * HD + 4 * quad;
    u32x2 pv[3][8];
    if (OWN) { const bf16_t* ppo = (const bf16_t*)(P.ws + WS_S + S_MOBA_PO) + ((size_t)tl * NH + h) * 3 * HD + 4 * quad;
#pragma unroll
        for (int s = 0; s < 3; ++s) { const bf16_t* src = ((mbits >> s) & 1u) ? ppo + (size_t)s * HD : op;
#pragma unroll
            for (int db = 0; db < 8; ++db) pv[s][db] = *(const u32x2*)(src + 16 * db); } }
    { const char* vp = (const char*)(qkvb + (size_t)(j * BLK + r0) * 3072 + 2 * DM + h * HD + piece * 8);
#pragma unroll
      for (int it = 0; it < 8; ++it) R.p[it] = *(const u32x4*)(vp + (size_t)it * (32 * 3072 * 2)); }
    f32x4 sc[16];
#pragma unroll
    for (int kb = 0; kb < 16; ++kb) {
        sc[kb] = (f32x4){0.f, 0.f, 0.f, 0.f};
        if (kb < nkb) {
#pragma unroll
            for (int ks = 0; ks < 4; ++ks) { const bf16x8 kf = *(const LAS bf16x8*)(lds + (16 * kb + i) * AT_KSTRIDE + (32 * ks + 8 * quad) * 2);
                sc[kb] = __builtin_amdgcn_mfma_f32_16x16x32_bf16(kf, qf[ks], sc[kb], 0, 0, 0); }
        }
    }
    const float slope = exp2f(-(float)(h + 1)) * LOG2E, scale = 0.08838834764831845f * LOG2E;
    float mx = -3.0e38f;
    const int rq = tl - j * BLK - 8 * quad; const float c0 = -slope * (float)rq;
#pragma unroll
    for (int kb = 0; kb < 16; ++kb) if (kb < nkb) {
#pragma unroll
        for (int jj = 0; jj < 4; ++jj) { const int K = 32 * (kb >> 1) + 4 * (kb & 1) + jj;
            float s = fmaf(sc[kb][jj], scale, fmaf(slope, (float)K, c0)); if (OWN && K > rq) s = -1.0e30f; sc[kb][jj] = s; mx = fmaxf(mx, s); }
    }
    mx = fmaxf(mx, __shfl_xor(mx, 16)); mx = fmaxf(mx, __shfl_xor(mx, 32));
    float l = 0.f;
#pragma unroll
    for (int kb = 0; kb < 16; ++kb) if (kb < nkb) {
#pragma unroll
        for (int jj = 0; jj < 4; ++jj) { const float p = fast_exp2(sc[kb][jj] - mx); sc[kb][jj] = p; l += p; }
    }
    l += __shfl_xor(l, 16); l += __shfl_xor(l, 32);
    const float lse = (mx + __log2f(l)) * LN2;
    f32x4 oacc[8];
    if (OWN) {
        float M = lse;
#pragma unroll
        for (int s = 0; s < 3; ++s) { ls[s] = ((mbits >> s) & 1u) ? ls[s] : -3.0e38f; M = fmaxf(M, ls[s]); }
        const float wown = __expf(lse - M); float wsl[3]; float den = wown;
#pragma unroll
        for (int s = 0; s < 3; ++s) { wsl[s] = ((mbits >> s) & 1u) ? __expf(ls[s] - M) : 0.f; den += wsl[s]; }
        const float rden = 1.0f / den, wo = wown / l * rden;
#pragma unroll
        for (int s = 0; s < 3; ++s) wsl[s] *= rden;
#pragma unroll
        for (int kb = 0; kb < 16; ++kb) if (kb < nkb) sc[kb] = sc[kb] * wo;
#pragma unroll
        for (int db = 0; db < 8; ++db) { f32x4 o = (f32x4){0.f, 0.f, 0.f, 0.f};
#pragma unroll
            for (int s = 0; s < 3; ++s) { const u32x2 q = pv[s][db]; const float ww = wsl[s];
                o[0] += ww * bf_lo(q.x); o[1] += ww * bf_hi(q.x); o[2] += ww * bf_lo(q.y); o[3] += ww * bf_hi(q.y); }
            oacc[db] = o; }
    } else {
#pragma unroll
        for (int db = 0; db < 8; ++db) oacc[db] = (f32x4){0.f, 0.f, 0.f, 0.f};
    }
    bf16x8 pf[8];
#pragma unroll
    for (int s = 0; s < 8; ++s) if (2 * s < nkb) pf[s] = pack8(sc[2 * s], sc[2 * s + 1]);
#pragma unroll
    for (int it = 0; it < 8; ++it) *(LAS u32x4*)(lds + AT_VS + (r0 + 32 * it) * AT_VSTRIDE + piece * 16) = R.p[it];
    AT_BAR();
    if (hasN) attn_issue_kq<OWN>(P, b, hN, jN, tlN, tid, R);
#pragma unroll
    for (int s = 0; s < 8; ++s) if (2 * s < nkb) {
#pragma unroll
        for (int db = 0; db < 8; ++db) {
            const LAS unsigned char* vp = lds + AT_VS + (32 * s + 8 * quad + (i >> 2)) * AT_VSTRIDE + (16 * db + 4 * (i & 3)) * 2;
            const s16x4 lo = __builtin_amdgcn_ds_read_tr16_b64_v4i16((LAS s16x4*)vp), hi = __builtin_amdgcn_ds_read_tr16_b64_v4i16((LAS s16x4*)(vp + 4 * AT_VSTRIDE));
            const bf16x8 vf = __builtin_shufflevector(lo, hi, 0, 1, 2, 3, 4, 5, 6, 7);
            oacc[db] = __builtin_amdgcn_mfma_f32_16x16x32_bf16(vf, pf[s], oacc[db], 0, 0, 0); }
    }
    if (!OWN) {
        if (valid) {
            const float inv = 1.0f / l; const size_t pr = ((size_t)tl * NH + h) * 3 + slot;
            bf16_t* po = (bf16_t*)(P.ws + WS_S + S_MOBA_PO) + pr * HD + 4 * quad;
#pragma unroll
            for (int db = 0; db < 8; ++db) { u32x2 w; w.x = cvt_pk_bf16(oacc[db][0] * inv, oacc[db][1] * inv); w.y = cvt_pk_bf16(oacc[db][2] * inv, oacc[db][3] * inv); *(u32x2*)(po + 16 * db) = w; }
            if (quad == 0) ((float*)(P.ws + WS_S + S_MOBA_LSE))[pr] = lse;
        }
    } else {
#pragma unroll
        for (int db = 0; db < 8; ++db) { u32x2 w; w.x = cvt_pk_bf16(oacc[db][0], oacc[db][1]); w.y = cvt_pk_bf16(oacc[db][2], oacc[db][3]); *(u32x2*)(op + 16 * db) = w; }
    }
}

__device__ __forceinline__ void phase_moba_gather(const Params& P, LAS unsigned char* lds, int mj, int b, int wg, int G) {
    const int* cnt = (const int*)(P.ws + WS_CTL + CTL_CNT) + mj * 1024 + b * 512;
    const unsigned short* list = (const unsigned short*)(P.ws + WS_S + S_MOBA_LIST) + (size_t)b * 512 * SEQ;
    const int tid = opaque_tid(), lane = tid & 63, wid = tid >> 6;
    LAS int* pref = (LAS int*)(lds + AT_PREF); LAS int* cl = pref + 520; LAS int* wtot = cl + 512;
    __syncthreads();
    { const int c = cnt[tid]; int v = (c + 127) >> 7; cl[tid] = c;
#pragma unroll
      for (int o = 1; o < 64; o <<= 1) { const int y = __shfl_up(v, o); if (lane >= o) v += y; }
      if (lane == 63) wtot[wid] = v;
      __syncthreads();
      int base = 0; for (int w = 0; w < wid; ++w) base += wtot[w];
      pref[tid + 1] = base + v; if (tid == 0) pref[0] = 0; }
    __syncthreads();
    const int total = pref[512];
    const int nx = G >> 3, xr = (G & 7) ? 0 : 1;
    int item = xr ? (wg & 7) * nx + (wg >> 3) : wg;
    if (item >= total) return;
#define AT_DECODE(it_, hj_, va_, ad_) do { int lo_ = 0, hi_ = 512; while (hi_ - lo_ > 1) { const int mid_ = (lo_ + hi_) >> 1; if (pref[mid_] <= (it_)) lo_ = mid_; else hi_ = mid_; } \
        hj_ = lo_; const int c_ = cl[lo_], e_ = ((it_) - pref[lo_]) * 128 + 16 * wid + (lane & 15); va_ = e_ < c_; ad_ = list + (size_t)lo_ * SEQ + (va_ ? e_ : c_ - 1); } while (0)
    int hjA, hjB = 0, hjC = 0; bool vaA, vaB = false, vaC = false; const unsigned short* ad; unsigned eA, eB = 0, eC = 0;
    AT_DECODE(item, hjA, vaA, ad); eA = *ad;
    bool hasB = item + G < total;
    if (hasB) { AT_DECODE(item + G, hjB, vaB, ad); eB = *ad; }
    AtRegs R;
    attn_issue_kq<false>(P, b, hjA >> 6, hjA & 63, (int)(eA >> 2), tid, R);
    for (;;) {
        const bool hasC = item + 2 * G < total;
        if (hasC) { AT_DECODE(item + 2 * G, hjC, vaC, ad); eC = *ad; }
        attn_tile<false, 16>(P, lds, b, hjA >> 6, hjA & 63, (int)(eA >> 2), vaA, (int)(eA & 3), R, hasB, hjB >> 6, hjB & 63, (int)(eB >> 2));
        if (!hasB) break;
        hjA = hjB; vaA = vaB; eA = eB; hjB = hjC; vaB = vaC; eB = eC; hasB = hasC; item += G;
    }
#undef AT_DECODE
}
__device__ __forceinline__ void phase_moba_own(const Params& P, LAS unsigned char* lds, int b, int wg, int G) {
    const int tid = opaque_tid(), lane = tid & 63, wid = tid >> 6;
    const int nx = G >> 3, xr = (G & 7) ? 0 : 1;
    int it = xr ? (wg & 7) * nx + (wg >> 3) : wg;
    if (it >= 1024) return;
#define AT_OWN(it_, h_, j_, c_, tl_) do { const int hj_ = (it_) >> 1; c_ = (((it_) >> 8) ^ (it_)) & 1; h_ = hj_ >> 6; j_ = hj_ & 63; tl_ = j_ * BLK + 128 * c_ + 16 * wid + (lane & 15); } while (0)
    int hA, jA, cA, tlA, hB = 0, jB = 0, cB = 0, tlB = 0;
    AT_OWN(it, hA, jA, cA, tlA);
    AtRegs R;
    attn_issue_kq<true>(P, b, hA, jA, tlA, tid, R);
    for (;;) {
        const bool hasB = it + G < 1024;
        if (hasB) AT_OWN(it + G, hB, jB, cB, tlB);
        if (cA) attn_tile<true, 16>(P, lds, b, hA, jA, tlA, true, 0, R, hasB, hB, jB, tlB); else attn_tile<true, 8>(P, lds, b, hA, jA, tlA, true, 0, R, hasB, hB, jB, tlB);
        if (!hasB) break;
        hA = hB; jA = jB; cA = cB; tlA = tlB; it += G;
    }
#undef AT_OWN
}
__device__ __forceinline__ void phase_gdn_bg(const Params& P, int wg, int G) {
    const int tid = opaque_tid(), lane = tid & 63, wave = tid >> 6, gw = wg * 8 + wave, NGW = G * 8;
    const bf16_t* X = (const bf16_t*)(P.ws + WS_XB); const u64_t* ssq = (const u64_t*)(P.ws + WS_SSQ) + (size_t)4 * T_TOK; const float* bgw = (const float*)(P.ws + WS_MISC + MISC_BGW);
    float* bg = (float*)(P.ws + WS_S + S_GDN_BG); const float* alog = P.in[IN_GDN_ALOG]; const float* dtb = P.in[IN_GDN_DTB];
    for (int t = gw; t < T_TOK; t += NGW) {
        const u32x2* xr = (const u32x2*)(X + (size_t)t * DM) + lane; f32x4 x4[4];
#pragma unroll
        for (int jj = 0; jj < 4; ++jj) x4[jj] = bf4(xr[64 * jj]);
        float mine = 0.f;
#pragma unroll
        for (int c = 0; c < 16; ++c) { const f32x4* wr_ = (const f32x4*)(bgw + (size_t)c * DM) + lane; float a = 0.f;
#pragma unroll
            for (int jj = 0; jj < 4; ++jj) { const f32x4 w4 = wr_[64 * jj]; a += (x4[jj][0] * w4[0] + x4[jj][1] * w4[1]) + (x4[jj][2] * w4[2] + x4[jj][3] * w4[3]); }
            a = wave_sum(a); if (lane == c) mine = a; }
        if (lane < 16) { const float raw = mine * ssq_rs(ssq[t]); float o;
            if (lane < 8) o = 1.0f / (1.0f + __expf(-raw));
            else { const int hh = lane - 8; const float xx = raw + dtb[hh]; const float sp = fmaxf(xx, 0.f) + log1pf(__expf(-fabsf(xx))); o = -__expf(alog[hh]) * sp; }
            bg[(size_t)t * 16 + lane] = o; }
    }
}
__device__ __forceinline__ u32x2 pack4(f32x4 v) { u32x2 w; w.x = cvt_pk_bf16(v[0], v[1]); w.y = cvt_pk_bf16(v[2], v[3]); return w; }
__device__ __forceinline__ void phase_gdn_chunk2(const Params& P, LAS unsigned char* lds, int wg, int G) {
    bf16_t* proj = (bf16_t*)(P.ws + WS_S + S_GDN_PROJ); bf16_t* attn = (bf16_t*)(P.ws + WS_S + S_GDN_ATTN); const float* bg = (const float*)(P.ws + WS_S + S_GDN_BG);
    const bf16_t* halo = (const bf16_t*)(P.ws + WS_S + S_GDN_HALO); float* gcum = (float*)(P.ws + WS_S + S_GDN_GC); bf16_t* wbuf = (bf16_t*)P.out; const float* cw = P.in[IN_GDN_CONV];
    LAS float* qL = (LAS float*)lds; LAS float* kL = qL + 64 * 132; LAS float* vL = kL + 64 * 132; LAS float* AL = vL + 64 * 132;
    LAS unsigned char* Qb = lds + 118784; LAS unsigned char* Kb = lds + 136192; LAS float* betaL = (LAS float*)(lds + 153600); LAS float* gcL = betaL + 64; LAS float* DinvL = (LAS float*)(lds + 154112);
    const int tid = opaque_tid(), lane = tid & 63, wave = __builtin_amdgcn_readfirstlane(tid >> 6), i16 = lane & 15, quad = lane >> 4;
    for (int u = wg; u < 4096; u += G) {
        const int b = u >> 11, h = (u >> 8) & 7, n = u & 255; const size_t t0 = (size_t)b * SEQ + (size_t)n * 64;
        bf16_t* projw = proj + t0 * 4096;
        __syncthreads();
        float be_pre = 0.f, gg_pre = 0.f;
        if (wave == 0) { const float* bgp = bg + (t0 + lane) * 16; be_pre = bgp[h]; gg_pre = bgp[8 + h]; }
        if (tid < 384) { const int mat = tid >> 7, d = tid & 127, col = mat * DM + h * HD + d;
            const float w0 = cw[col], w1 = cw[3072 + col], w2 = cw[2 * 3072 + col], w3 = cw[3 * 3072 + col];
            float x3 = 0.f, x2 = 0.f, x1 = 0.f;
            if (n > 0) { const bf16_t* hp = halo + ((t0 >> 6) - 1) * 3 * 3072 + col; x3 = bf2f(hp[0]); x2 = bf2f(hp[3072]); x1 = bf2f(hp[2 * 3072]); }
            const bf16_t* src = proj + t0 * 4096 + col; unsigned off = 0; bf16_t raw[64];
#pragma unroll
            for (int i = 0; i < 64; ++i) { raw[i] = src[off]; off += 4096; asm volatile("" : "+v"(off)); }
            __builtin_amdgcn_sched_barrier(0);
            LAS float* dst = (mat == 0 ? qL : (mat == 1 ? kL : vL)) + d;
#pragma unroll
            for (int i = 0; i < 64; ++i) { const float x0 = bf2f(raw[i]); dst[i * 132] = silu_f(w3 * x0 + w2 * x1 + w1 * x2 + w0 * x3); x3 = x2; x2 = x1; x1 = x0; } }
        __syncthreads();
#pragma unroll 4
        for (int rr = 0; rr < 16; ++rr) { const int r = wave * 16 + rr; LAS float* rowp = (r < 64 ? qL + r * 132 : kL + (r - 64) * 132) + 2 * lane;
            f32x2 v = *(LAS f32x2*)rowp; const float ss = wave_sum(v.x * v.x + v.y * v.y); const float scl = (1.0f / sqrtf(ss + EPS)) * (r < 64 ? 0.08838834764831845f : 1.0f); v = v * scl; *(LAS f32x2*)rowp = v;
            *(LAS unsigned*)((r < 64 ? Qb : Kb) + (r & 63) * 272 + lane * 4) = cvt_pk_bf16(v.x, v.y); }
        if (wave == 0) { const float be = be_pre; float gg = gg_pre;
#pragma unroll
            for (int o = 1; o < 64; o <<= 1) { const float y = __shfl_up(gg, o); if (lane >= o) gg += y; }
            betaL[lane] = be; gcL[lane] = gg; gcum[(size_t)u * 64 + lane] = gg; }
        __syncthreads();
        {
            const int mat = wave >> 2, rb = wave & 3; const LAS unsigned char* Xb = mat ? Qb : Kb;
            bf16x8 af[4];
#pragma unroll
            for (int ks = 0; ks < 4; ++ks) af[ks] = *(const LAS bf16x8*)(Xb + (16 * rb + i16) * 272 + (32 * ks + 8 * quad) * 2);
            float gr[4], br[4];
#pragma unroll
            for (int jj = 0; jj < 4; ++jj) { gr[jj] = gcL[16 * rb + 4 * quad + jj]; br[jj] = betaL[16 * rb + 4 * quad + jj]; }
#pragma unroll
            for (int cb = 0; cb < 4; ++cb) {
                f32x4 acc = (f32x4){0.f, 0.f, 0.f, 0.f};
                if (cb <= rb) {
#pragma unroll
                    for (int ks = 0; ks < 4; ++ks) acc = __builtin_amdgcn_mfma_f32_16x16x32_bf16(af[ks], *(const LAS bf16x8*)(Kb + (16 * cb + i16) * 272 + (32 * ks + 8 * quad) * 2), acc, 0, 0, 0); }
                const int j = 16 * cb + i16; const float gj = gcL[j];
                const int pj = 32 * (cb >> 1) + 8 * (i16 >> 2) + 4 * (cb & 1) + (i16 & 3);
#pragma unroll
                for (int jj = 0; jj < 4; ++jj) { const int r = 16 * rb + 4 * quad + jj; const float dec = (j <= r) ? __expf(gr[jj] - gj) : 0.f;
                    if (mat == 0) AL[r * 68 + j] = (j < r) ? acc[jj] * br[jj] * dec : 0.f;
                    else *(LAS bf16_t*)(lds + 154112 + ((((r >> 4) * 2 + (pj >> 5)) * 64 + ((pj >> 3) & 3) * 16 + (r & 15)) * 8 + (pj & 7)) * 2) = f2bf((j <= r) ? acc[jj] * dec : 0.f); }
            }
        }
        __syncthreads();
        *(u32x4*)(attn + (size_t)u * 4096 + tid * 8) = *(const LAS u32x4*)(lds + 154112 + tid * 16);
#pragma unroll
        for (int k = 0; k < 2; ++k) { const int pi = tid + 512 * k, l_ = pi & 63, i_ = l_ & 15, q_ = l_ >> 4;
            { const int rb_ = pi >> 8, ks_ = (pi >> 6) & 3;
              *(u32x4*)(projw + (size_t)(pi >> 4) * 4096 + h * HD + (pi & 15) * 8) = *(const LAS u32x4*)(Qb + (16 * rb_ + i_) * 272 + (32 * ks_ + 8 * q_) * 2); }
            { const int w_ = pi >> 7, ks_ = (pi >> 6) & 1, dk = 16 * w_ + i_, p0 = 32 * ks_ + 8 * q_; float kv[8];
#pragma unroll
              for (int e = 0; e < 8; ++e) { const int tok = 16 * (2 * (p0 >> 5) + (e >> 2)) + 4 * ((p0 >> 3) & 3) + (e & 3); kv[e] = kL[tok * 132 + dk]; }
              u32x4 w; w.x = cvt_pk_bf16(kv[0], kv[1]); w.y = cvt_pk_bf16(kv[2], kv[3]); w.z = cvt_pk_bf16(kv[4], kv[5]); w.w = cvt_pk_bf16(kv[6], kv[7]);
              *(u32x4*)(projw + (size_t)(pi >> 4) * 4096 + DM + h * HD + (pi & 15) * 8) = w; } }
#pragma unroll
        for (int it = 0; it < 8; ++it) { const int p = tid + 512 * it, row = p >> 6, d = (p & 63) * 2;
            const f32x2 kv = *(LAS f32x2*)(kL + row * 132 + d), vv = *(LAS f32x2*)(vL + row * 132 + d);
            const float be = betaL[row], eg = __expf(gcL[row]);
            *(LAS f32x2*)(qL + row * 132 + d) = kv * (be * eg); *(LAS f32x2*)(vL + row * 132 + d) = vv * be; }
        __syncthreads();
        {
            { const int blk = lane >> 4, c = lane & 15; float y[16];
#pragma unroll
              for (int r = 0; r < 16; ++r) y[r] = (r == c) ? 1.0f : 0.0f;
#pragma unroll
              for (int r = 1; r < 16; ++r) { float s = 0.f;
#pragma unroll
                  for (int j4 = 0; j4 <= (r - 1) / 4; ++j4) { const f32x4 a4 = *(const LAS f32x4*)(AL + (16 * blk + r) * 68 + 16 * blk + 4 * j4);
                      s += a4[0] * y[4 * j4] + a4[1] * y[4 * j4 + 1] + a4[2] * y[4 * j4 + 2] + a4[3] * y[4 * j4 + 3]; }
                  y[r] -= s; }
#pragma unroll
              for (int r = 0; r < 16; ++r) DinvL[(16 * blk + r) * 16 + c] = y[r]; }
            LAS float* Xm = (wave < 4 ? vL : qL) + 32 * (wave & 3) + i16;
#pragma unroll 1
            for (int bi = 0; bi < 4; ++bi)
#pragma unroll 1
                for (int cbl = 0; cbl < 2; ++cbl) {
                    LAS float* Xc = Xm + 16 * cbl; f32x4 acc;
#pragma unroll
                    for (int jj = 0; jj < 4; ++jj) acc[jj] = Xc[(16 * bi + 4 * quad + jj) * 132];
#pragma unroll 1
                    for (int k = 0; k < bi; ++k)
#pragma unroll
                        for (int ks = 0; ks < 4; ++ks) acc = __builtin_amdgcn_mfma_f32_16x16x4f32(-AL[(16 * bi + i16) * 68 + 16 * k + 4 * ks + quad], Xc[(16 * k + 4 * ks + quad) * 132], acc, 0, 0, 0);
#pragma unroll
                    for (int jj = 0; jj < 4; ++jj) Xc[(16 * bi + 4 * quad + jj) * 132] = acc[jj];
                    f32x4 acc2 = (f32x4){0.f, 0.f, 0.f, 0.f};
#pragma unroll
                    for (int ks = 0; ks < 4; ++ks) acc2 = __builtin_amdgcn_mfma_f32_16x16x4f32(DinvL[(16 * bi + i16) * 16 + 4 * ks + quad], Xc[(16 * bi + 4 * ks + quad) * 132], acc2, 0, 0, 0);
#pragma unroll
                    for (int jj = 0; jj < 4; ++jj) Xc[(16 * bi + 4 * quad + jj) * 132] = acc2[jj];
                }
        }
        __syncthreads();
#pragma unroll
        for (int k = 0; k < 2; ++k) { const int pi = tid + 512 * k, q_ = pi & 3, l_ = (pi >> 2) & 63, rb_ = pi >> 8, tok = 16 * rb_ + 4 * (l_ >> 4), col = 32 * q_ + (l_ & 15);
            float uv[8];
#pragma unroll
            for (int e = 0; e < 8; ++e) uv[e] = vL[(tok + (e & 3)) * 132 + col + 16 * (e >> 2)];
            u32x4 w; w.x = cvt_pk_bf16(uv[0], uv[1]); w.y = cvt_pk_bf16(uv[2], uv[3]); w.z = cvt_pk_bf16(uv[4], uv[5]); w.w = cvt_pk_bf16(uv[6], uv[7]);
            *(u32x4*)(projw + (size_t)(pi >> 4) * 4096 + 2 * DM + h * HD + (pi & 15) * 8) = w; }
#pragma unroll
        for (int k = 0; k < 2; ++k) { const int pi = tid + 512 * k, l_ = pi & 63, rb_ = pi >> 8, ks_ = (pi >> 6) & 3;
            const LAS f32x4* wp = (const LAS f32x4*)(qL + (16 * rb_ + (l_ & 15)) * 132 + 32 * ks_ + 8 * (l_ >> 4)); const f32x4 a = wp[0], c = wp[1];
            u32x4 w; w.x = cvt_pk_bf16(a[0], a[1]); w.y = cvt_pk_bf16(a[2], a[3]); w.z = cvt_pk_bf16(c[0], c[1]); w.w = cvt_pk_bf16(c[2], c[3]);
            *(u32x4*)(wbuf + (t0 + (pi >> 4)) * DM + h * HD + (pi & 15) * 8) = w; }
    }
}
constexpr size_t DO_GP = 64 * MiB, DO_GQ = 72 * MiB, DO_GS = 88 * MiB;
#define GS_BAR() do { asm volatile("s_waitcnt lgkmcnt(0)" ::: "memory"); __builtin_amdgcn_s_barrier(); asm volatile("" ::: "memory"); } while (0)
__device__ __forceinline__ u32x2 packsoft4(f32x4 v) { u32x2 w; w.x = (unsigned)f2bf(v[0]) | ((unsigned)f2bf(v[1]) << 16); w.y = (unsigned)f2bf(v[2]) | ((unsigned)f2bf(v[3]) << 16); return w; }
__device__ __forceinline__ void phase_gdn_scanA(const Params& P, LAS unsigned char* lds, int wg, int G) {
    const bf16_t* proj = (const bf16_t*)(P.ws + WS_S + S_GDN_PROJ); const float* gcum = (const float*)(P.ws + WS_S + S_GDN_GC); const bf16_t* wbuf = (const bf16_t*)P.out;
    bf16_t* GP = (bf16_t*)((unsigned char*)P.out + DO_GP); float* GQ = (float*)((unsigned char*)P.out + DO_GQ);
    const int tid = opaque_tid(), lane = tid & 63, wave = __builtin_amdgcn_readfirstlane(tid >> 6), i16 = lane & 15, quad = lane >> 4, rb = wave & 3, hf = wave >> 2;
    LAS unsigned char* ST = lds; LAS unsigned char* VN2 = lds + 69632;
    const int p0 = 32 * (rb >> 1) + 8 * quad + 4 * (rb & 1);
    for (int task = wg; task < 256; task += G) {
        const int bh = task >> 4, g = task & 15, b = bh >> 3, h = bh & 7; const size_t t0 = (size_t)b * SEQ + (size_t)g * 1024, u0 = (size_t)bh * 256 + (size_t)g * 16;
        f32x4 sacc[16]; int dgo = i16 - 4 * quad; asm volatile("" : "+v"(dgo));
#pragma unroll
        for (int cb = 0; cb < 16; ++cb)
#pragma unroll
            for (int jj = 0; jj < 4; ++jj) sacc[cb][jj] = (cb < 8 && cb == wave && dgo == jj) ? 1.0f : 0.0f;
        __syncthreads();
#pragma unroll
        for (int cb = 0; cb < 16; ++cb) *(LAS u32x2*)(ST + (16 * cb + i16) * 272 + (16 * wave + 4 * quad) * 2) = pack4(sacc[cb]);
        const char* pA = (const char*)(wbuf + (t0 + 16 * rb + quad) * DM + h * HD + 8 * i16);
        const char* pK = (const char*)(proj + (t0 + 8 * wave + quad) * 4096 + DM + h * HD + 8 * i16);
        const char* pU = (const char*)(proj + (t0 + 16 * rb + (lane >> 2)) * 4096 + 2 * DM + h * HD + (lane & 3) * 32);
        const char* pG = (const char*)(gcum + u0 * 64 + 16 * rb + 4 * quad); const char* pGl = (const char*)(gcum + u0 * 64 + 63);
        bf16x8 fa[2][4], fk[2][2]; u32x4 uu[2][4]; f32x4 g4[2]; float gl[2];
#define GA_LOAD_A(S) do { _Pragma("unroll") for (int ks_ = 0; ks_ < 4; ++ks_) fa[S][ks_] = *(const bf16x8*)(pA + (size_t)ks_ * (4 * DM * 2)); \
        if (hf) { _Pragma("unroll") for (int q_ = 0; q_ < 4; ++q_) uu[S][q_] = *(const u32x4*)(pU + q_ * 16); } \
        g4[S] = *(const f32x4*)pG; gl[S] = *(const float*)pGl; pA += 64 * DM * 2; pU += 64 * 8192; pG += 256; pGl += 256; } while (0)
#define GA_LOAD_B(S) do { _Pragma("unroll") for (int ks_ = 0; ks_ < 2; ++ks_) fk[S][ks_] = *(const bf16x8*)(pK + (size_t)ks_ * 32768); pK += 64 * 8192; } while (0)
#pragma unroll
        for (int s_ = 0; s_ < 2; ++s_)
#pragma unroll
            for (int q_ = 0; q_ < 4; ++q_) uu[s_][q_] = (u32x4){0u, 0u, 0u, 0u};
        GA_LOAD_A(0); GA_LOAD_B(0); GA_LOAD_A(1); GA_LOAD_B(1);
        GS_BAR();
#define GA_STEP(nn, S) do { \
        const float glast_ = gl[S]; f32x4 ed_; \
        _Pragma("unroll") for (int jj_ = 0; jj_ < 4; ++jj_) ed_[jj_] = __expf(glast_ - g4[S][jj_]); \
        _Pragma("unroll") for (int c4_ = 0; c4_ < 8; c4_ += 4) { f32x4 acc1[4];        \
            _Pragma("unroll") for (int c_ = 0; c_ < 4; ++c_) { acc1[c_] = (f32x4){0.f, 0.f, 0.f, 0.f}; \
                _Pragma("unroll") for (int ks_ = 0; ks_ < 4; ++ks_) acc1[c_] = __builtin_amdgcn_mfma_f32_16x16x32_bf16(fa[S][ks_], *(const LAS bf16x8*)(ST + (16 * (8 * hf + c4_ + c_) + i16) * 272 + (32 * ks_ + 8 * quad) * 2), acc1[c_], 0, 0, 0); } \
            _Pragma("unroll") for (int c_ = 0; c_ < 4; ++c_) { const int cc_ = c4_ + c_; const unsigned ua_ = uu[S][cc_ >> 1][2 * (cc_ & 1)], ub_ = uu[S][cc_ >> 1][2 * (cc_ & 1) + 1]; f32x4 vn2_; \
                vn2_[0] = (bf_lo(ua_) - acc1[c_][0]) * ed_[0]; vn2_[1] = (bf_hi(ua_) - acc1[c_][1]) * ed_[1]; vn2_[2] = (bf_lo(ub_) - acc1[c_][2]) * ed_[2]; vn2_[3] = (bf_hi(ub_) - acc1[c_][3]) * ed_[3]; \
                *(LAS u32x2*)(VN2 + (16 * (8 * hf + cc_) + i16) * 144 + p0 * 2) = pack4(vn2_); } \
            asm volatile("" ::: "memory"); } \
        if ((nn) + 2 < 16) GA_LOAD_A(S); \
        GS_BAR(); \
        const float eg_ = __expf(glast_); \
        _Pragma("unroll") for (int cb_ = 0; cb_ < 16; ++cb_) { f32x4 acc_ = sacc[cb_] * eg_; \
            _Pragma("unroll") for (int ks_ = 0; ks_ < 2; ++ks_) acc_ = __builtin_amdgcn_mfma_f32_16x16x32_bf16(fk[S][ks_], *(const LAS bf16x8*)(VN2 + (16 * cb_ + i16) * 144 + (32 * ks_ + 8 * quad) * 2), acc_, 0, 0, 0); \
            sacc[cb_] = acc_; *(LAS u32x2*)(ST + (16 * cb_ + i16) * 272 + (16 * wave + 4 * quad) * 2) = packsoft4(acc_); \
            if ((cb_ & 3) == 3) asm volatile("" ::: "memory"); } \
        if ((nn) + 2 < 16) GA_LOAD_B(S); \
        GS_BAR(); } while (0)
#pragma unroll 1
        for (int n = 0; n < 16; n += 2) { GA_STEP(n, 0); GA_STEP(n + 1, 1); }
#undef GA_STEP
#undef GA_LOAD_A
#undef GA_LOAD_B
#pragma unroll
        for (int cb = 0; cb < 8; ++cb)
#pragma unroll
            for (int jj = 0; jj < 4; ++jj) GP[(size_t)task * 16384 + (16 * wave + 4 * quad + jj) * 128 + 16 * cb + i16] = f2bf(sacc[cb][jj]);
#pragma unroll
        for (int cb = 0; cb < 8; ++cb) *(f32x4*)(GQ + (((size_t)task * 8 + wave) * 64 + lane) * 32 + cb * 4) = sacc[8 + cb];
    }
}
__device__ __forceinline__ void phase_gdn_scanB(const Params& P, LAS unsigned char* lds, int wg, int G) {
    const int bh = (G % 8 == 0 && G >= 16) ? (wg >> 3) + 2 * (wg & 7) : wg;
    if ((G % 8 == 0 && G >= 16) ? (wg >> 3) >= 2 : wg >= 16) return;
    const bf16_t* GP = (const bf16_t*)((const unsigned char*)P.out + DO_GP); const float* GQ = (const float*)((const unsigned char*)P.out + DO_GQ); float* GS = (float*)((unsigned char*)P.out + DO_GS);
    const int tid = opaque_tid(), lane = tid & 63, wave = __builtin_amdgcn_readfirstlane(tid >> 6), i16 = lane & 15, quad = lane >> 4;
    LAS unsigned char* ST = lds;
    f32x4 sacc[8];
#pragma unroll
    for (int cb = 0; cb < 8; ++cb) sacc[cb] = (f32x4){0.f, 0.f, 0.f, 0.f};
    bf16x8 fp[2][4]; f32x4 qg[2][8];
#define GB_LOAD(S, gg) do { const size_t tk_ = (size_t)bh * 16 + (gg); \
        _Pragma("unroll") for (int ks_ = 0; ks_ < 4; ++ks_) fp[S][ks_] = *(const bf16x8*)(GP + tk_ * 16384 + (16 * wave + i16) * 128 + 32 * ks_ + 8 * quad); \
        _Pragma("unroll") for (int cb_ = 0; cb_ < 8; ++cb_) qg[S][cb_] = *(const f32x4*)(GQ + ((tk_ * 8 + wave) * 64 + lane) * 32 + cb_ * 4); } while (0)
    GB_LOAD(0, 0); GB_LOAD(1, 1);
    __syncthreads();
#define GB_STEP(g, S) do { const size_t task = (size_t)bh * 16 + (g); \
        _Pragma("unroll") for (int cb_ = 0; cb_ < 8; ++cb_) *(f32x4*)(GS + ((task * 8 + wave) * 64 + lane) * 32 + cb_ * 4) = sacc[cb_];          \
        if ((g) < 15) { \
            _Pragma("unroll") for (int cb_ = 0; cb_ < 8; ++cb_) *(LAS u32x2*)(ST + (16 * cb_ + i16) * 272 + (16 * wave + 4 * quad) * 2) = pack4(sacc[cb_] + (f32x4){0.f, 0.f, 0.f, 0.f}); \
            GS_BAR(); \
            _Pragma("unroll") for (int cb_ = 0; cb_ < 8; ++cb_) { f32x4 acc_ = qg[S][cb_]; \
                _Pragma("unroll") for (int ks_ = 0; ks_ < 4; ++ks_) acc_ = __builtin_amdgcn_mfma_f32_16x16x32_bf16(fp[S][ks_], *(const LAS bf16x8*)(ST + (16 * cb_ + i16) * 272 + (32 * ks_ + 8 * quad) * 2), acc_, 0, 0, 0); \
                sacc[cb_] = acc_; } \
            if ((g) + 2 < 15) GB_LOAD(S, (g) + 2); \
            GS_BAR(); } } while (0)
#pragma unroll 1
    for (int g = 0; g < 16; g += 2) { GB_STEP(g, 0); GB_STEP(g + 1, 1); }
#undef GB_STEP
#undef GB_LOAD
}
__device__ __forceinline__ void phase_gdn_scanC(const Params& P, LAS unsigned char* lds, int wg, int G) {
    bf16_t* proj = (bf16_t*)(P.ws + WS_S + S_GDN_PROJ); const bf16_t* attn = (const bf16_t*)(P.ws + WS_S + S_GDN_ATTN); const float* gcum = (const float*)(P.ws + WS_S + S_GDN_GC); const bf16_t* wbuf = (const bf16_t*)P.out;
    const float* GS = (const float*)((const unsigned char*)P.out + DO_GS);
    const int tid = opaque_tid(), lane = tid & 63, wave = __builtin_amdgcn_readfirstlane(tid >> 6), i16 = lane & 15, quad = lane >> 4, rb = wave & 3;
    LAS unsigned char* ST = lds; LAS unsigned char* VN = lds + 34816; LAS unsigned char* VN2 = lds + 53248; LAS unsigned char* OL = lds + 71680; LAS float* WN = (LAS float*)(lds + 89088);
    const int p0 = 32 * (rb >> 1) + 8 * quad + 4 * (rb & 1);
    for (int task = wg; task < 256; task += G) {
        const int bh = task >> 4, g = task & 15, b = bh >> 3, h = bh & 7; const size_t t0 = (size_t)b * SEQ + (size_t)g * 1024, u0 = (size_t)bh * 256 + (size_t)g * 16;
        f32x4 sacc[8];
#pragma unroll
        for (int cb = 0; cb < 8; ++cb) sacc[cb] = *(const f32x4*)(GS + (((size_t)task * 8 + wave) * 64 + lane) * 32 + cb * 4);
        __syncthreads();
#pragma unroll
        for (int cb = 0; cb < 8; ++cb) *(LAS u32x2*)(ST + (16 * cb + i16) * 272 + (16 * wave + 4 * quad) * 2) = pack4(sacc[cb] + (f32x4){0.f, 0.f, 0.f, 0.f});
        const char* pA = (wave < 4) ? (const char*)(wbuf + (t0 + 16 * rb + quad) * DM + h * HD + 8 * i16) : (const char*)(proj + (t0 + 16 * rb + quad) * 4096 + h * HD + 8 * i16);
        const size_t ksA = (wave < 4) ? (size_t)4 * DM * 2 : (size_t)4 * 4096 * 2, stA = (wave < 4) ? (size_t)64 * DM * 2 : (size_t)64 * 4096 * 2;
        const char* pK = (const char*)(proj + (t0 + 8 * wave + quad) * 4096 + DM + h * HD + 8 * i16);
        const char* pU = (const char*)(proj + (t0 + 16 * rb + (lane >> 2)) * 4096 + 2 * DM + h * HD + (lane & 3) * 32);
        const char* pT = (const char*)(attn + u0 * 4096 + (size_t)(rb * 128 + lane) * 8);
        const char* pG = (const char*)(gcum + u0 * 64 + 16 * rb + 4 * quad); const char* pGl = (const char*)(gcum + u0 * 64 + 63);
        bf16_t* pO = proj + (t0 + (tid >> 4)) * 4096 + 2 * DM + h * HD + (tid & 15) * 8;
        bf16x8 fa[2][4], fk[2][2], ft[2][2]; u32x4 uu[2][4], zr[2]; f32x4 g4[2]; float gl[2];
        if (tid < 128) WN[tid] = P.in[IN_GDN_NORM][tid];
#define GC_LOAD_A(S) do { _Pragma("unroll") for (int ks_ = 0; ks_ < 4; ++ks_) fa[S][ks_] = *(const bf16x8*)(pA + (size_t)ks_ * ksA); \
        if (wave < 4) { _Pragma("unroll") for (int q_ = 0; q_ < 4; ++q_) uu[S][q_] = *(const u32x4*)(pU + q_ * 16); } \
        g4[S] = *(const f32x4*)pG; gl[S] = *(const float*)pGl; pA += stA; pU += 64 * 8192; pG += 256; pGl += 256; } while (0)
#define GC_LOAD_B(S) do { _Pragma("unroll") for (int ks_ = 0; ks_ < 2; ++ks_) fk[S][ks_] = *(const bf16x8*)(pK + (size_t)ks_ * 32768); \
        if (wave >= 4) { _Pragma("unroll") for (int ks_ = 0; ks_ < 2; ++ks_) ft[S][ks_] = *(const bf16x8*)(pT + ks_ * 1024); } \
        pK += 64 * 8192; pT += 8192; } while (0)
#pragma unroll
        for (int s_ = 0; s_ < 2; ++s_) {
#pragma unroll
            for (int q_ = 0; q_ < 4; ++q_) uu[s_][q_] = (u32x4){0u, 0u, 0u, 0u};
#pragma unroll
            for (int q_ = 0; q_ < 2; ++q_) ft[s_][q_] = (bf16x8){0, 0, 0, 0, 0, 0, 0, 0}; }
        GC_LOAD_A(0); GC_LOAD_B(0); GC_LOAD_A(1); GC_LOAD_B(1);
        GS_BAR();
#define GC_ZLOAD(nn) do { _Pragma("unroll") for (int k_ = 0; k_ < 2; ++k_) zr[k_] = *(const u32x4*)(pO + DM + ((size_t)(nn) * 64 + 32 * k_) * 4096); } while (0)
#define GC_OSTORE(nn) do { _Pragma("unroll") for (int k_ = 0; k_ < 2; ++k_) { const u32x4 ov_ = *(const LAS u32x4*)(OL + ((tid >> 4) + 32 * k_) * 272 + (tid & 15) * 16); const u32x4 zv_ = zr[k_]; \
            float o_[8], z_[8]; _Pragma("unroll") for (int e_ = 0; e_ < 4; ++e_) { o_[2 * e_] = bf_lo(ov_[e_]); o_[2 * e_ + 1] = bf_hi(ov_[e_]); z_[2 * e_] = bf_lo(zv_[e_]); z_[2 * e_ + 1] = bf_hi(zv_[e_]); } \
            float ss_ = 0.f; _Pragma("unroll") for (int e_ = 0; e_ < 8; ++e_) ss_ += o_[e_] * o_[e_]; \
            ss_ += __shfl_xor(ss_, 1); ss_ += __shfl_xor(ss_, 2); ss_ += __shfl_xor(ss_, 4); ss_ += __shfl_xor(ss_, 8); \
            const float r_ = 1.0f / sqrtf(ss_ * (1.0f / HD) + EPS); const f32x4 wa_ = *(const LAS f32x4*)(WN + (tid & 15) * 8), wb_ = *(const LAS f32x4*)(WN + (tid & 15) * 8 + 4); \
            u32x4 w_; w_.x = cvt_pk_bf16(o_[0] * r_ * wa_[0] * silu_f(z_[0]), o_[1] * r_ * wa_[1] * silu_f(z_[1])); w_.y = cvt_pk_bf16(o_[2] * r_ * wa_[2] * silu_f(z_[2]), o_[3] * r_ * wa_[3] * silu_f(z_[3])); \
            w_.z = cvt_pk_bf16(o_[4] * r_ * wb_[0] * silu_f(z_[4]), o_[5] * r_ * wb_[1] * silu_f(z_[5])); w_.w = cvt_pk_bf16(o_[6] * r_ * wb_[2] * silu_f(z_[6]), o_[7] * r_ * wb_[3] * silu_f(z_[7])); \
            *(u32x4*)(pO + ((size_t)(nn) * 64 + 32 * k_) * 4096) = w_; } } while (0)
#define GC_STEP(nn, S) do { \
        if ((nn) > 0) GC_OSTORE((nn) - 1); \
        GC_ZLOAD(nn); \
        f32x4 acc1[8]; \
        _Pragma("unroll") for (int c_ = 0; c_ < 8; ++c_) { acc1[c_] = (f32x4){0.f, 0.f, 0.f, 0.f}; \
            _Pragma("unroll") for (int ks_ = 0; ks_ < 4; ++ks_) acc1[c_] = __builtin_amdgcn_mfma_f32_16x16x32_bf16(fa[S][ks_], *(const LAS bf16x8*)(ST + (16 * c_ + i16) * 272 + (32 * ks_ + 8 * quad) * 2), acc1[c_], 0, 0, 0); } \
        const float glast_ = gl[S]; const f32x4 gv_ = g4[S]; \
        if (wave < 4) { f32x4 ed_; \
            _Pragma("unroll") for (int jj_ = 0; jj_ < 4; ++jj_) ed_[jj_] = __expf(glast_ - gv_[jj_]); \
            _Pragma("unroll") for (int c_ = 0; c_ < 8; ++c_) { const unsigned ua_ = uu[S][c_ >> 1][2 * (c_ & 1)], ub_ = uu[S][c_ >> 1][2 * (c_ & 1) + 1]; f32x4 vn_; \
                vn_[0] = bf_lo(ua_) - acc1[c_][0]; vn_[1] = bf_hi(ua_) - acc1[c_][1]; vn_[2] = bf_lo(ub_) - acc1[c_][2]; vn_[3] = bf_hi(ub_) - acc1[c_][3]; \
                *(LAS u32x2*)(VN + (16 * c_ + i16) * 144 + p0 * 2) = pack4(vn_); *(LAS u32x2*)(VN2 + (16 * c_ + i16) * 144 + p0 * 2) = pack4(vn_ * ed_); } } \
        if ((nn) + 2 < 16) GC_LOAD_A(S); \
        GS_BAR(); \
        if (wave >= 4) { f32x4 eg4_; \
            _Pragma("unroll") for (int jj_ = 0; jj_ < 4; ++jj_) eg4_[jj_] = __expf(gv_[jj_]); \
            _Pragma("unroll") for (int c_ = 0; c_ < 8; ++c_) { f32x4 acco_ = acc1[c_] * eg4_; \
                _Pragma("unroll") for (int ks_ = 0; ks_ < 2; ++ks_) acco_ = __builtin_amdgcn_mfma_f32_16x16x32_bf16(ft[S][ks_], *(const LAS bf16x8*)(VN + (16 * c_ + i16) * 144 + (32 * ks_ + 8 * quad) * 2), acco_, 0, 0, 0); \
                _Pragma("unroll") for (int jj_ = 0; jj_ < 4; ++jj_) *(LAS bf16_t*)(OL + (16 * rb + 4 * quad + jj_) * 272 + (16 * c_ + i16) * 2) = f2bf(acco_[jj_]); } } \
        { const float eg_ = __expf(glast_); \
          _Pragma("unroll") for (int cb_ = 0; cb_ < 8; ++cb_) { f32x4 acc_ = sacc[cb_] * eg_; \
              _Pragma("unroll") for (int ks_ = 0; ks_ < 2; ++ks_) acc_ = __builtin_amdgcn_mfma_f32_16x16x32_bf16(fk[S][ks_], *(const LAS bf16x8*)(VN2 + (16 * cb_ + i16) * 144 + (32 * ks_ + 8 * quad) * 2), acc_, 0, 0, 0); \
              sacc[cb_] = acc_; *(LAS u32x2*)(ST + (16 * cb_ + i16) * 272 + (16 * wave + 4 * quad) * 2) = packsoft4(acc_); } } \
        if ((nn) + 2 < 16) GC_LOAD_B(S); \
        GS_BAR(); } while (0)
#pragma unroll 1
        for (int n = 0; n < 16; n += 2) { GC_STEP(n, 0); GC_STEP(n + 1, 1); }
        GC_OSTORE(15);
#undef GC_STEP
#undef GC_OSTORE
#undef GC_ZLOAD
#undef GC_LOAD_A
#undef GC_LOAD_B
    }
}

constexpr int NPHASES = 39;
__global__ void __launch_bounds__(512, 2) fwd_kernel(Params P0) {
    extern __shared__ __attribute__((aligned(16))) unsigned char lds_raw[];
    LAS unsigned char* lds = (LAS unsigned char*)lds_raw;
    const int tid = threadIdx.x, wg = blockIdx.x, G = gridDim.x;
    volatile LAS unsigned* bw = (volatile LAS unsigned*)(lds + LDS_BARW);
    if (tid < 4) bw[tid] = 0u;
    __syncthreads();
    const int lo = P0.ph_lo, hi = P0.ph_hi;
    XcdBarrier bar; bar.bar = (unsigned*)(P0.ws + WS_CTL); bar.x = 0; bar.st = bw;
    if (hi - lo > 1) bar = xcd_barrier_post((unsigned*)(P0.ws + WS_CTL), bw);
    u64_t* ssq_base = (u64_t*)(P0.ws + WS_SSQ);
    bf16_t* xb = (bf16_t*)(P0.ws + WS_XB);
    const bf16_t* Wb = (const bf16_t*)(P0.ws + WS_W);
    int ph = 0;
#define PH_BEGIN if (ph >= lo && ph < hi) { const Params& P = P0;
#define PH_END if (ph + 1 < hi) xcd_barrier(bar); } ++ph;
    PH_BEGIN phase_prologue(P, lds, wg, G); PH_END
    for (int it = 0; it < 8; ++it) {
        const int L = it >> 1, sub = it & 1, kind = L % 3, mj = L / 3;
        if (sub == 0) {
            PH_BEGIN
                pg8::Gemm g; pg8::EpiIn E; g.A = xb; g.M = T_TOK; g.K = DM; g.lda = DM; E.ssq = ssq_base + (size_t)(2 * L) * T_TOK; E.halo = nullptr;
                if (kind == 0) { g.Bt = (const bf16_t*)((const unsigned char*)Wb + (mj == 0 ? W_MOBA_QKV0 : W_MOBA_QKV1)); g.N = 3072; E.O = (bf16_t*)(P.ws + WS_S + S_MOBA_QKV); E.ldc = 3072; }
                else if (kind == 1) { g.Bt = (const bf16_t*)((const unsigned char*)Wb + W_SC_IN); g.N = 3072; E.O = (bf16_t*)(P.ws + WS_S + S_SC_PROJ); E.ldc = 3072; }
                else { g.Bt = (const bf16_t*)((const unsigned char*)Wb + W_GDN_IN); g.N = 4096; E.O = (bf16_t*)(P.ws + WS_S + S_GDN_PROJ); E.ldc = 4096; E.halo = (bf16_t*)(P.ws + WS_S + S_GDN_HALO); }
                pg8::StaticOrder S; S.init(g.M, g.N, G, wg);
                pg8::gemm_phase<pg8::EpiIn, false>(lds, g, S, E);
                if (kind == 2) phase_gdn_bg(P, wg, G);
            PH_END
            if (kind == 0) {
                PH_BEGIN phase_moba_kmean_vt(P, lds, wg, G); PH_END
                PH_BEGIN phase_moba_gate2(P, lds, mj, wg, G); PH_END
                for (int b = 0; b < 2; ++b) {
                    PH_BEGIN phase_moba_gather(P, lds, mj, b, wg, G); PH_END
                    PH_BEGIN phase_moba_own(P, lds, b, wg, G); PH_END
                }
            } else if (kind == 1) {
                PH_BEGIN phase_sconv(P, wg, G); PH_END
            } else {
                PH_BEGIN phase_gdn_chunk2(P, lds, wg, G); PH_END
                PH_BEGIN phase_gdn_scanA(P, lds, wg, G); PH_END
                PH_BEGIN phase_gdn_scanB(P, lds, wg, G); PH_END
                PH_BEGIN phase_gdn_scanC(P, lds, wg, G); PH_END
            }
        } else {
            PH_BEGIN
                pg8::Gemm g; g.A = xb; g.Bt = (const bf16_t*)((const unsigned char*)Wb + W_FFN_UP + (size_t)L * W_FFN_UP_STRIDE); g.M = T_TOK; g.N = 2 * FFD; g.K = DM; g.lda = DM;
                pg8::EpiUp E; E.ACT = (bf16_t*)(P.ws + WS_S + S_FFN_ACT); E.halo = (float*)(P.ws + WS_S + S_FFN_HALO); E.cw = P.in[IN_FFN_CONV] + (size_t)L * 3 * (2 * FFD); E.ssq = ssq_base + (size_t)(2 * L + 1) * T_TOK;
                pg8::StaticOrder S; S.init(g.M, g.N, G, wg);
                pg8::gemm_phase<pg8::EpiUp, true>(lds, g, S, E);
            PH_END
            PH_BEGIN phase_ffn_fix(P, L, wg, G); PH_END
        }
        PH_BEGIN
            pg8::Gemm g; g.M = T_TOK; g.N = DM;
            if (sub == 1) { g.A = (const bf16_t*)(P.ws + WS_S + S_FFN_ACT); g.lda = FFD; g.K = FFD; g.Bt = (const bf16_t*)((const unsigned char*)Wb + W_FFN_DN + (size_t)L * W_FFN_DN_STRIDE); }
            else if (kind == 0) { g.A = (const bf16_t*)(P.ws + WS_S + S_MOBA_QKV); g.lda = 3072; g.K = DM; g.Bt = (const bf16_t*)((const unsigned char*)Wb + (mj == 0 ? W_MOBA_O0 : W_MOBA_O1)); }
            else if (kind == 1) { g.A = (const bf16_t*)(P.ws + WS_S + S_SC_Y); g.lda = DM; g.K = DM; g.Bt = (const bf16_t*)((const unsigned char*)Wb + W_SC_OUT); }
            else { g.A = (const bf16_t*)(P.ws + WS_S + S_GDN_PROJ) + 2 * DM; g.lda = 4096; g.K = DM; g.Bt = (const bf16_t*)((const unsigned char*)Wb + W_GDN_O); }
            pg8::EpiOut E; E.XB = xb; E.ssq_next = ssq_base + (size_t)(2 * L + 1 + sub) * T_TOK; E.ts = (LAS float*)(lds + 131072);
            pg8::StaticOrder S; S.init(g.M, g.N, G, wg);
            pg8::gemm_phase<pg8::EpiOut, false>(lds, g, S, E);
        PH_END
    }
    PH_BEGIN phase_final(P, wg, G); PH_END
#undef PH_BEGIN
#undef PH_END
}

extern "C" void kernel_launch(void* const* d_in, const int* in_sizes, int n_in, void* d_out, int out_size, void* d_ws, size_t ws_size, hipStream_t stream) {
    static int grid = 0;
    if (grid == 0) {
        if (n_in != 18 || out_size != T_TOK * DM || ws_size < WS_END) { fprintf(stderr, "kernel_launch: unexpected problem (n_in %d, out %d, ws %zu)\n", n_in, out_size, ws_size); grid = -1; return; }
        int dev = 0, cus = 0, per_cu = 0;
        if (hipGetDevice(&dev) != hipSuccess || hipDeviceGetAttribute(&cus, hipDeviceAttributeMultiprocessorCount, dev) != hipSuccess) { grid = -1; return; }
        if (hipFuncSetAttribute((const void*)fwd_kernel, hipFuncAttributeMaxDynamicSharedMemorySize, LDS_BYTES) != hipSuccess) { fprintf(stderr, "kernel_launch: hipFuncSetAttribute failed\n"); grid = -1; return; }
        if (hipOccupancyMaxActiveBlocksPerMultiprocessor(&per_cu, (const void*)fwd_kernel, 512, LDS_BYTES) != hipSuccess || per_cu < 1) { fprintf(stderr, "kernel_launch: occupancy query says %d blocks per CU\n", per_cu); (void)hipGetLastError(); }
        grid = cus;
    }
    if (grid < 0) return;
    (void)in_sizes;
    hipMemsetAsync((char*)d_ws + WS_CTL, 0, CTL_ZERO_BYTES, stream);
    Params p; memset(&p, 0, sizeof(p));
    for (int i = 0; i < 18; ++i) p.in[i] = (const float*)d_in[i];
    p.out = (float*)d_out; p.ws = (unsigned char*)d_ws;
#if MK_N_LAUNCHES == 1
    p.ph_lo = 0; p.ph_hi = NPHASES;
    hipLaunchKernelGGL(fwd_kernel, dim3(grid), dim3(512), LDS_BYTES, stream, p);
#else
    for (int li = 0; li < NPHASES; ++li) { p.ph_lo = li; p.ph_hi = li + 1; hipLaunchKernelGGL(fwd_kernel, dim3(grid), dim3(512), LDS_BYTES, stream, p); }
#endif
}
```

```cpp
#include <hip/hip_runtime.h>
#include <stdio.h>
#include <string.h>

#ifndef MK_N_LAUNCHES
#define MK_N_LAUNCHES 1
#endif

#define LAS __attribute__((address_space(3)))
typedef unsigned short bf16_t;
typedef short bf16x8 __attribute__((ext_vector_type(8)));
typedef float f32x4 __attribute__((ext_vector_type(4)));
typedef float f32x2 __attribute__((ext_vector_type(2)));
typedef unsigned u32x4 __attribute__((ext_vector_type(4)));
typedef unsigned u32x2 __attribute__((ext_vector_type(2)));

constexpr int T_TOK = 32768, SEQ = 16384, DM = 1024, FFD = 2816, NH = 8, HD = 128, NBLK = 64, BLK = 256;
constexpr float EPS = 1e-6f;
constexpr float LOG2E = 1.4426950408889634f, LN2 = 0.6931471805599453f;

constexpr size_t MiB = 1u << 20;
constexpr size_t WS_CTL = 0, CTL_ZERO_BYTES = 4 * MiB;
constexpr size_t CTL_CNT = 512 * 1024;
constexpr size_t WS_SSQ = 1 * MiB;
constexpr size_t WS_MISC = 6 * MiB;
constexpr size_t MISC_KMEAN = 0, MISC_BGW = 512 * 1024;
constexpr size_t WS_W = 7 * MiB;
constexpr size_t WS_XB = 107 * MiB;
constexpr size_t WS_S = 171 * MiB;
constexpr size_t WS_END = 512 * MiB;
constexpr size_t W_MOBA_QKV0 = 0, W_MOBA_QKV1 = 6 * MiB, W_MOBA_O0 = 12 * MiB, W_MOBA_O1 = 14 * MiB, W_SC_IN = 16 * MiB, W_SC_OUT = 22 * MiB,
                 W_GDN_IN = 24 * MiB, W_GDN_O = 32 * MiB, W_FFN_UP = 34 * MiB, W_FFN_UP_STRIDE = 11 * MiB, W_FFN_DN = 78 * MiB, W_FFN_DN_STRIDE = 5767168;
constexpr size_t S_MOBA_KN = 322 * MiB, S_MOBA_KMAX = 323 * MiB, S_MOBA_MASK = 324 * MiB;
constexpr size_t S_MOBA_QKV = 0, S_MOBA_PO = 192 * MiB, S_MOBA_LIST = 288 * MiB, S_MOBA_LSE = 320 * MiB;
constexpr size_t S_SC_PROJ = 0, S_SC_Y = 192 * MiB;
constexpr size_t S_GDN_PROJ = 0, S_GDN_ATTN = 256 * MiB, S_GDN_BG = 288 * MiB, S_GDN_HALO = 290 * MiB, S_GDN_GC = 300 * MiB;
constexpr size_t S_FFN_ACT = 0, S_FFN_HALO = 176 * MiB;

constexpr int LDS_BYTES = 163840;
constexpr int LDS_BARW = 163840 - 64;

__device__ __forceinline__ unsigned cvt_pk_bf16(float lo, float hi) { unsigned r; asm volatile("v_cvt_pk_bf16_f32 %0, %1, %2" : "=v"(r) : "v"(lo), "v"(hi)); return r; }
__device__ __forceinline__ float bf_lo(unsigned u) { return __builtin_bit_cast(float, u << 16); }
__device__ __forceinline__ float bf_hi(unsigned u) { return __builtin_bit_cast(float, u & 0xffff0000u); }
__device__ __forceinline__ f32x4 bf4(u32x2 w) { return (f32x4){bf_lo(w.x), bf_hi(w.x), bf_lo(w.y), bf_hi(w.y)}; }
__device__ __forceinline__ float bf2f(bf16_t b) { return __builtin_bit_cast(float, (unsigned)b << 16); }
__device__ __forceinline__ bf16_t f2bf(float f) { unsigned u = __builtin_bit_cast(unsigned, f); return (bf16_t)((u + 0x7fffu + ((u >> 16) & 1u)) >> 16); }
__device__ __forceinline__ float fast_exp2(float x) { return __builtin_amdgcn_exp2f(x); }
__device__ __forceinline__ float fast_rcp(float x) { return __builtin_amdgcn_rcpf(x); }
__device__ __forceinline__ float silu_f(float x) { return x * fast_rcp(1.0f + fast_exp2(-x * LOG2E)); }
__device__ __forceinline__ int opaque_tid() { int t = threadIdx.x; asm volatile("" : "+v"(t)); return t; }
typedef unsigned long long u64_t;
constexpr float SSQ_SCALE = 4294967296.0f, SSQ_INV = 1.0f / 4294967296.0f;
__device__ __forceinline__ u64_t ssq_fix(float s) { return (u64_t)(s * SSQ_SCALE); }
__device__ __forceinline__ float ssq_rs(u64_t v) { return __builtin_amdgcn_rsqf((float)v * (SSQ_INV / DM) + EPS); }
__device__ __forceinline__ float wave_sum(float v) {
#pragma unroll
    for (int o = 1; o < 64; o <<= 1) v += __shfl_xor(v, o);
    return v;
}
__device__ __forceinline__ float dpp_shr1(float v) {
    return __builtin_bit_cast(float, __builtin_amdgcn_update_dpp(0, __builtin_bit_cast(int, v), 0x111, 0xf, 0xf, false));
}
__device__ __forceinline__ bf16x8 pack8(f32x4 a, f32x4 b) {
    u32x4 p;
    asm volatile("v_cvt_pk_bf16_f32 %0, %4, %5\n\tv_cvt_pk_bf16_f32 %1, %6, %7\n\tv_cvt_pk_bf16_f32 %2, %8, %9\n\tv_cvt_pk_bf16_f32 %3, %10, %11\n\ts_nop 1"
                 : "=&v"(p[0]), "=&v"(p[1]), "=&v"(p[2]), "=&v"(p[3])
                 : "v"(a[0]), "v"(a[1]), "v"(a[2]), "v"(a[3]), "v"(b[0]), "v"(b[1]), "v"(b[2]), "v"(b[3]));
    return __builtin_bit_cast(bf16x8, p);
}

#define XB_TMO      128
#define XB_XCNT(j)  (256  + 64 * (j))
#define XB_XSUB(j)  (1280 + 64 * (j))
#define XB_XGEN(j)  (2304 + 64 * (j))
#define XB_TOP      3328
#define XB_TOPGEN   3392
#define XCD_BAR_WORDS 3456
#define XB_SPIN_CAP (1u << 18)
__device__ __forceinline__ unsigned xb_ld(unsigned* p)              { return __hip_atomic_load(p, __ATOMIC_RELAXED, __HIP_MEMORY_SCOPE_AGENT); }
__device__ __forceinline__ unsigned xb_add(unsigned* p, unsigned v) { return __hip_atomic_fetch_add(p, v, __ATOMIC_RELAXED, __HIP_MEMORY_SCOPE_AGENT); }
__device__ __forceinline__ unsigned xb_xcc_id() { return (unsigned)__builtin_amdgcn_s_getreg((3 << 11) | 20) & 0xFu; }
#define XB_SPIN(cond, bar) do { unsigned _sp = 0; while (cond) { __builtin_amdgcn_s_sleep(1); \
    if ((++_sp & 255u) == 0u) { if (xb_ld(&(bar)[XB_TMO])) break; if (_sp > XB_SPIN_CAP) { atomicAdd(&(bar)[XB_TMO], 1u); break; } } } } while (0)
struct XcdBarrier { unsigned* bar; unsigned x; volatile LAS unsigned* st; };
__device__ __forceinline__ XcdBarrier xcd_barrier_post(unsigned* bar, volatile LAS unsigned* st) {
    XcdBarrier b; b.bar = bar; b.x = xb_xcc_id(); b.st = st;
    if (threadIdx.x == 0) (void)xb_add(&bar[XB_XCNT(b.x)], 1u);
    return b;
}
__device__ __forceinline__ void xcd_barrier_complete(unsigned* bar, unsigned x, unsigned& nloc, unsigned& nx) {
    const unsigned G = gridDim.x * gridDim.y * gridDim.z;
    unsigned sum, cnt, mine, sp = 0u;
    for (;;) {
        sum = 0u; cnt = 0u; mine = 0u;
#pragma unroll
        for (unsigned j = 0; j < 16; ++j) { const unsigned c = xb_ld(&bar[XB_XCNT(j)]); sum += c; cnt += (c > 0u) ? 1u : 0u; mine = (j == x) ? c : mine; }
        if (sum == G) break;
        __builtin_amdgcn_s_sleep(1);
        if ((++sp & 255u) == 0u) { if (xb_ld(&bar[XB_TMO])) break; if (sp > XB_SPIN_CAP) { atomicAdd(&bar[XB_TMO], 1u); break; } }
    }
    nloc = mine > 0u ? mine : 1u; nx = cnt > 0u ? cnt : 1u;
}
__device__ __forceinline__ void xcd_barrier(const XcdBarrier& b) {
    asm volatile("s_waitcnt vmcnt(0)" ::: "memory");
    __syncthreads();
    if (threadIdx.x == 0) {
        unsigned* bar = b.bar;
        __builtin_amdgcn_s_waitcnt(0);
        unsigned nloc = b.st[0], nx = b.st[1];
        if (nloc == 0u) { xcd_barrier_complete(bar, b.x, nloc, nx); b.st[0] = nloc; b.st[1] = nx; }
        const unsigned old = xb_add(&bar[XB_XSUB(b.x)], 1u);
        const unsigned gen = old / nloc;
        if (old + 1u == (gen + 1u) * nloc) {
            __builtin_amdgcn_fence(__ATOMIC_RELEASE, "agent");
            asm volatile("s_waitcnt vmcnt(0)" ::: "memory");
            const unsigned og = xb_add(&bar[XB_TOP], 1u);
            const unsigned tg = og / nx;
            if (og + 1u == (tg + 1u) * nx) xb_add(&bar[XB_TOPGEN], 1u);
            else XB_SPIN(xb_ld(&bar[XB_TOPGEN]) == tg, bar);
            __builtin_amdgcn_fence(__ATOMIC_ACQUIRE, "agent");
            xb_add(&bar[XB_XGEN(b.x)], 1u);
            asm volatile("s_waitcnt vmcnt(0)" ::: "memory");
        } else {
            XB_SPIN(xb_ld(&bar[XB_XGEN(b.x)]) == gen, bar);
            __builtin_amdgcn_fence(__ATOMIC_ACQUIRE, "agent");
            asm volatile("s_waitcnt vmcnt(0)" ::: "memory");
        }
    }
    __syncthreads();
}

namespace pg8 {
constexpr int BM = 256, BK = 64, HALF = 128, HTB = HALF * BK * 2, STAGE_BYTES = 8 * HTB, NXCD = 8, WGM = 8;
__host__ __device__ __forceinline__ int lds_byte(int r, int c) { const int st = (r >> 4) * 2 + (c >> 5), rr = r & 15, cc = c & 31, ob = rr * 64 + cc * 2; return st * 1024 + (ob ^ (((ob >> 9) & 1) << 5)); }
__host__ __device__ __forceinline__ void stage_rc(int b, int& R, int& C) { const int st = b / 1024, sb = b % 1024, swz = sb ^ (((sb >> 9) & 1) << 5); R = (st >> 1) * 16 + swz / 64; C = (st & 1) * 32 + (swz % 64) / 2; }
__host__ __device__ __forceinline__ int perm32(int rho) { const int n = rho >> 4, i = rho & 15; return 8 * (i >> 2) + 4 * n + (i & 3); }
struct Unit { int pm, pn; };
struct Gemm { const bf16_t* A; const bf16_t* Bt; int M, N, K, lda; };
struct StaticOrder {
    int nM, nN, nwg, G, c;
    __host__ __device__ void init(int M, int N, int G_, int c_) { nM = M / BM; nN = N / BM; nwg = nM * nN; G = G_; c = c_; }
    __host__ __device__ bool next(int i, Unit& u) const {
        const long L = (long)i * G + c; if (L >= nwg) return false;
        int wgid = (int)L; { const int q = nwg / NXCD, r = nwg % NXCD, xcd = wgid % NXCD, off = wgid / NXCD; wgid = (xcd < r ? xcd * (q + 1) : r * (q + 1) + (xcd - r) * q) + off; }
        const int nig = WGM * nN, gid = wgid / nig, fm = gid * WGM, gsz = (nM - fm) < WGM ? (nM - fm) : WGM;
        u.pm = fm + ((wgid % nig) % gsz); u.pn = (wgid % nig) / gsz; return true;
    }
};
template <class Epi, bool TOKPERM>
__device__ __forceinline__ void gemm_phase(LAS unsigned char* lds, const Gemm g, const StaticOrder& S, const Epi& E) {
    const int tid = opaque_tid(), wid = __builtin_amdgcn_readfirstlane(tid >> 6), lane = tid & 63, wr = wid >> 2, wc = wid & 3, fr = lane & 15, fq = lane >> 4;
    const int K = g.K, nt = K / BK, lda = g.lda;
    unsigned voffA[2], voffB[2];
#pragma unroll
    for (int i = 0; i < 2; ++i) { int R, C; stage_rc(tid * 16 + i * 8192, R, C); const int Rb = (R & ~31) + perm32(R & 31);
        const int Ra = TOKPERM ? (128 * (R >> 6) + 8 * (R & 15) + ((R >> 4) & 3)) : R;
        voffA[i] = (unsigned)(Ra * lda + C) * 2u; voffB[i] = (unsigned)(Rb * K + C) * 2u; }
    const size_t kstep = (size_t)(BK * 2);
    const size_t hstepA = TOKPERM ? (size_t)4 * lda * 2 : (size_t)HALF * lda * 2, hstepB = (size_t)HALF * K * 2;
    const size_t tstepA = (size_t)BM * lda * 2, tstepB = (size_t)BM * K * 2;
    const unsigned ldsw = (unsigned)wid * 1024u;
    const int aoff = lds_byte(wr * 64 + fr, fq * 8), boff = lds_byte(wc * 32 + fr, fq * 8);
#define PG8_SA(b, h) (((b) * 2 + (h)) * HTB)
#define PG8_SB(b, h) ((4 + (b) * 2 + (h)) * HTB)
#define PG8_STAGE(bufoff, gbase, voff) do { _Pragma("unroll") for (int _i = 0; _i < 2; ++_i) \
        __builtin_amdgcn_global_load_lds((const unsigned*)((const char*)(gbase) + (voff)[_i]), (LAS unsigned*)(lds + (bufoff) + ldsw + _i * 8192), 16, 0, 0); } while (0)
#define PG8_LDA(dst, b, h) do { _Pragma("unroll") for (int m = 0; m < 4; ++m) _Pragma("unroll") for (int k = 0; k < 2; ++k) dst[m][k] = *(const LAS bf16x8*)(lds + PG8_SA(b, h) + aoff + m * 2048 + k * 1024); } while (0)
#define PG8_LDB(dst, b, h) do { _Pragma("unroll") for (int n = 0; n < 2; ++n) _Pragma("unroll") for (int k = 0; k < 2; ++k) dst[n][k] = *(const LAS bf16x8*)(lds + PG8_SB(b, h) + boff + n * 2048 + k * 1024); } while (0)
#define PG8_MMA(ai, bj, At, Bt) do { __builtin_amdgcn_s_setprio(1); _Pragma("unroll") for (int m = 0; m < 4; ++m) _Pragma("unroll") for (int n = 0; n < 2; ++n) _Pragma("unroll") for (int k = 0; k < 2; ++k) \
        acc[ai][bj][m][n] = __builtin_amdgcn_mfma_f32_16x16x32_bf16(Bt[n][k], At[m][k], acc[ai][bj][m][n], 0, 0, 0); __builtin_amdgcn_s_setprio(0); } while (0)
#define PG8_WAIT_V(n) asm volatile("s_waitcnt vmcnt(" #n ")" ::: "memory")
#define PG8_WAIT_L(n) asm volatile("s_waitcnt lgkmcnt(" #n ")" ::: "memory")
#define PG8_BAR __builtin_amdgcn_s_barrier()
#define PG8_SCHED __builtin_amdgcn_sched_barrier(0)
    Unit cur, nxt; int ui = 0;
    if (!S.next(0, cur)) return;
    f32x4 acc[2][2][4][2];
#pragma unroll
    for (int a = 0; a < 2; ++a)
#pragma unroll
        for (int b = 0; b < 2; ++b)
#pragma unroll
            for (int m = 0; m < 4; ++m)
#pragma unroll
                for (int n = 0; n < 2; ++n) acc[a][b][m][n] = (f32x4){0.f, 0.f, 0.f, 0.f};
    bf16x8 At[4][2], B0[2][2], B1[2][2];
    const char* cA = (const char*)g.A + (size_t)cur.pm * tstepA; const char* cB = (const char*)g.Bt + (size_t)cur.pn * tstepB;
    PG8_STAGE(PG8_SB(0, 0), cB, voffB); PG8_STAGE(PG8_SB(0, 1), cB + hstepB, voffB); PG8_STAGE(PG8_SA(0, 0), cA, voffA); PG8_STAGE(PG8_SA(0, 1), cA + hstepA, voffA);
    if (wr == 1) PG8_BAR;
    PG8_WAIT_V(2); PG8_BAR;
    PG8_STAGE(PG8_SB(1, 0), cB + kstep, voffB); PG8_STAGE(PG8_SA(1, 0), cA + kstep, voffA); PG8_STAGE(PG8_SB(1, 1), cB + hstepB + kstep, voffB);
    PG8_WAIT_V(6); PG8_BAR;
    for (;;) {
        const bool has_next = S.next(ui + 1, nxt);
        const char* nA = has_next ? (const char*)g.A + (size_t)nxt.pm * tstepA : cA; const char* nB = has_next ? (const char*)g.Bt + (size_t)nxt.pn * tstepB : cB;
        for (int t = 0; t < nt; t += 2) {
            const bool last = (t == nt - 2);
            const char* a1 = cA + (size_t)(t + 1) * kstep;
            const char* a2 = last ? nA : cA + (size_t)(t + 2) * kstep; const char* b2 = last ? nB : cB + (size_t)(t + 2) * kstep;
            const char* a3 = a2 + kstep; const char* b3 = b2 + kstep;
            PG8_LDB(B0, 0, 0); PG8_LDB(B1, 0, 1); PG8_SCHED; PG8_LDA(At, 0, 0); PG8_STAGE(PG8_SA(1, 1), a1 + hstepA, voffA);
            PG8_WAIT_V(8); PG8_WAIT_L(0); PG8_BAR; PG8_MMA(0, 0, At, B0); PG8_MMA(0, 1, At, B1); PG8_BAR; PG8_SCHED;
            PG8_LDA(At, 0, 1); PG8_STAGE(PG8_SB(0, 0), b2, voffB); PG8_STAGE(PG8_SB(0, 1), b2 + hstepB, voffB); PG8_STAGE(PG8_SA(0, 0), a2, voffA);
            PG8_WAIT_V(8); PG8_WAIT_L(0); PG8_BAR; PG8_MMA(1, 0, At, B0); PG8_MMA(1, 1, At, B1); PG8_BAR; PG8_SCHED;
            PG8_LDB(B0, 1, 0); PG8_LDB(B1, 1, 1); PG8_SCHED; PG8_LDA(At, 1, 0); PG8_STAGE(PG8_SA(0, 1), a2 + hstepA, voffA);
            PG8_WAIT_V(8); PG8_WAIT_L(0); PG8_BAR; PG8_MMA(0, 0, At, B0); PG8_MMA(0, 1, At, B1); PG8_BAR; PG8_SCHED;
            PG8_LDA(At, 1, 1); PG8_STAGE(PG8_SB(1, 0), b3, voffB); PG8_STAGE(PG8_SB(1, 1), b3 + hstepB, voffB); PG8_STAGE(PG8_SA(1, 0), a3, voffA);
            PG8_WAIT_V(8); PG8_WAIT_L(0); PG8_BAR; PG8_MMA(1, 0, At, B0); PG8_MMA(1, 1, At, B1); PG8_BAR; PG8_SCHED;
        }
        if (wr == 0) PG8_BAR;
        E(acc, cur, wr, wc, fr, fq);
        if (!has_next) break;
#pragma unroll
        for (int a = 0; a < 2; ++a)
#pragma unroll
            for (int b = 0; b < 2; ++b)
#pragma unroll
                for (int m = 0; m < 4; ++m)
#pragma unroll
                    for (int n = 0; n < 2; ++n) acc[a][b][m][n] = (f32x4){0.f, 0.f, 0.f, 0.f};
        cur = nxt; cA = nA; cB = nB; ++ui;
        if (wr == 1) PG8_BAR;
    }
    PG8_WAIT_V(0);
    PG8_BAR;
#undef PG8_SA
#undef PG8_SB
#undef PG8_STAGE
#undef PG8_LDA
#undef PG8_LDB
#undef PG8_MMA
#undef PG8_WAIT_V
#undef PG8_WAIT_L
#undef PG8_BAR
#undef PG8_SCHED
}

struct EpiIn {
    bf16_t* O; int ldc; const u64_t* ssq; bf16_t* halo;
    __device__ __forceinline__ void operator()(const f32x4 (&acc)[2][2][4][2], const Unit& u, int wr, int wc, int fr, int fq) const {
        const int row0 = u.pm * BM + wr * 64 + fr, col0 = u.pn * BM + wc * 32 + 8 * fq;
        u64_t sq[2][4];
#pragma unroll
        for (int ai = 0; ai < 2; ++ai)
#pragma unroll
            for (int m = 0; m < 4; ++m) sq[ai][m] = ssq[row0 + ai * HALF + m * 16];
        __builtin_amdgcn_sched_barrier(0);
#pragma unroll
        for (int ai = 0; ai < 2; ++ai)
#pragma unroll
            for (int m = 0; m < 4; ++m) { const int t = row0 + ai * HALF + m * 16; const float rs = ssq_rs(sq[ai][m]);
                bf16_t* rowp = O + (size_t)t * ldc + col0;
#pragma unroll
                for (int bj = 0; bj < 2; ++bj) { const f32x4 v0 = acc[ai][bj][m][0] * rs, v1 = acc[ai][bj][m][1] * rs;
                    u32x4 w; w.x = cvt_pk_bf16(v0[0], v0[1]); w.y = cvt_pk_bf16(v0[2], v0[3]); w.z = cvt_pk_bf16(v1[0], v1[1]); w.w = cvt_pk_bf16(v1[2], v1[3]);
                    *(u32x4*)(rowp + bj * HALF) = w;
                    if (halo != nullptr && m == 3 && fr >= 13 && (col0 + bj * HALF) < 3072) *(u32x4*)(halo + ((size_t)(t >> 6) * 3 + (fr - 13)) * 3072 + col0 + bj * HALF) = w; } }
    }
};
struct EpiOut {
    bf16_t* XB; u64_t* ssq_next; LAS float* ts;
    __device__ __forceinline__ void operator()(const f32x4 (&acc)[2][2][4][2], const Unit& u, int wr, int wc, int fr, int fq) const {
        const int row0 = u.pm * BM + wr * 64 + fr, col0 = u.pn * BM + wc * 32 + 8 * fq;
        u32x4 xin[2][4][2];
#pragma unroll
        for (int ai = 0; ai < 2; ++ai)
#pragma unroll
            for (int m = 0; m < 4; ++m)
#pragma unroll
                for (int bj = 0; bj < 2; ++bj) xin[ai][m][bj] = *(const u32x4*)(XB + (size_t)(row0 + ai * HALF + m * 16) * DM + col0 + bj * HALF);
        __builtin_amdgcn_sched_barrier(0);
#pragma unroll
        for (int ai = 0; ai < 2; ++ai)
#pragma unroll
            for (int m = 0; m < 4; ++m) { const int t = row0 + ai * HALF + m * 16; float ss = 0.f;
#pragma unroll
                for (int bj = 0; bj < 2; ++bj) { const u32x4 xi = xin[ai][m][bj];
                    f32x4 v0, v1; v0[0] = bf_lo(xi.x); v0[1] = bf_hi(xi.x); v0[2] = bf_lo(xi.y); v0[3] = bf_hi(xi.y); v1[0] = bf_lo(xi.z); v1[1] = bf_hi(xi.z); v1[2] = bf_lo(xi.w); v1[3] = bf_hi(xi.w);
                    v0 = v0 + acc[ai][bj][m][0]; v1 = v1 + acc[ai][bj][m][1];
                    u32x4 w; w.x = cvt_pk_bf16(v0[0], v0[1]); w.y = cvt_pk_bf16(v0[2], v0[3]); w.z = cvt_pk_bf16(v1[0], v1[1]); w.w = cvt_pk_bf16(v1[2], v1[3]);
                    *(u32x4*)(XB + (size_t)t * DM + col0 + bj * HALF) = w;
                    ss += (v0[0] * v0[0] + v0[1] * v0[1]) + (v0[2] * v0[2] + v0[3] * v0[3]) + (v1[0] * v1[0] + v1[1] * v1[1]) + (v1[2] * v1[2] + v1[3] * v1[3]); }
                ss += __shfl_xor(ss, 16); ss += __shfl_xor(ss, 32);
                if (fq == 0) ts[(wr * 64 + fr + ai * HALF + m * 16) * 4 + wc] = ss; }
        asm volatile("s_waitcnt lgkmcnt(0)" ::: "memory"); __builtin_amdgcn_s_barrier(); asm volatile("" ::: "memory");
        const int tid = opaque_tid();
        if (tid < 256) { const f32x4 p = *(const LAS f32x4*)(ts + tid * 4); atomicAdd(ssq_next + u.pm * BM + tid, ssq_fix((p[0] + p[1]) + (p[2] + p[3]))); }
    }
};
struct EpiUp {
    bf16_t* ACT; float* halo; const float* cw; const u64_t* ssq;
    __device__ __forceinline__ void operator()(f32x4 (&acc)[2][2][4][2], const Unit& u, int wr, int wc, int fr, int fq) const {
        asm volatile("" : "+v"(fr), "+v"(fq));
        const int tbase = u.pm * BM + 128 * wr + 8 * fr, ch0 = u.pn * 128 + wc * 32 + 8 * fq;
#pragma unroll
        for (int ai = 0; ai < 2; ++ai)
#pragma unroll
            for (int m = 0; m < 4; ++m) { const float rs = ssq_rs(ssq[tbase + 4 * ai + m]);
#pragma unroll
                for (int bj = 0; bj < 2; ++bj)
#pragma unroll
                    for (int n = 0; n < 2; ++n) acc[ai][bj][m][n] = acc[ai][bj][m][n] * rs; }
        if (fr == 0 || fr == 15) {
            float* hb = halo + ((size_t)(tbase >> 7) * 4 + (fr == 0 ? 0 : 2)) * (2 * FFD) + ch0;
#pragma unroll
            for (int jj = 0; jj < 2; ++jj)
#pragma unroll
                for (int n = 0; n < 2; ++n) {
                    const f32x4 g0 = (fr == 0) ? acc[0][0][jj][n] : acc[1][0][2 + jj][n], u0 = (fr == 0) ? acc[0][1][jj][n] : acc[1][1][2 + jj][n];
                    *(f32x4*)(hb + (size_t)jj * (2 * FFD) + 4 * n) = g0; *(f32x4*)(hb + (size_t)jj * (2 * FFD) + FFD + 4 * n) = u0; }
        }
#pragma unroll
        for (int n = 0; n < 2; ++n) {
#pragma unroll
            for (int half = 1; half >= 0; --half) {
                f32x4 w[3];
#pragma unroll
                for (int k = 0; k < 3; ++k) w[k] = *(const f32x4*)(cw + (size_t)k * (2 * FFD) + half * FFD + ch0 + 4 * n);
                f32x4 p6, p7;
#pragma unroll
                for (int e = 0; e < 4; ++e) { p6[e] = dpp_shr1(acc[1][half][2][n][e]); p7[e] = dpp_shr1(acc[1][half][3][n][e]); }
#pragma unroll
                for (int j = 7; j >= 0; --j) {
                    const int j1 = j >= 1 ? j - 1 : 0, j2 = j >= 2 ? j - 2 : 0;
                    const f32x4 x0 = acc[j >> 2][half][j & 3][n];
                    const f32x4 x1 = (j >= 1) ? acc[j1 >> 2][half][j1 & 3][n] : p7;
                    const f32x4 x2 = (j >= 2) ? acc[j2 >> 2][half][j2 & 3][n] : (j == 1 ? p7 : p6);
                    const f32x4 cv = w[2] * x0 + w[1] * x1 + w[0] * x2;
                    if (half == 1) acc[j >> 2][1][j & 3][n] = cv;
                    else { f32x4 a; const f32x4 up = acc[j >> 2][1][j & 3][n];
#pragma unroll
                        for (int e = 0; e < 4; ++e) a[e] = silu_f(cv[e]) * up[e];
                        acc[j >> 2][0][j & 3][n] = a; }
                }
                asm volatile("" ::: "memory");
            }
        }
#pragma unroll
        for (int j = 0; j < 8; ++j) {
            if (fr == 0 && j < 2) continue;
            const f32x4 v0 = acc[j >> 2][0][j & 3][0], v1 = acc[j >> 2][0][j & 3][1];
            u32x4 w; w.x = cvt_pk_bf16(v0[0], v0[1]); w.y = cvt_pk_bf16(v0[2], v0[3]); w.z = cvt_pk_bf16(v1[0], v1[1]); w.w = cvt_pk_bf16(v1[2], v1[3]);
            *(u32x4*)(ACT + (size_t)(tbase + j) * FFD + ch0) = w;
        }
    }
};
}

struct Params { const float* in[18]; float* out; unsigned char* ws; int ph_lo, ph_hi; };
enum { IN_X = 0, IN_MIXN, IN_FFNN, IN_FINN, IN_MOBA_QKV, IN_MOBA_O, IN_SC_IN, IN_SC_CONV, IN_SC_OUT, IN_GDN_IN, IN_GDN_CONV, IN_GDN_ALOG, IN_GDN_DTB, IN_GDN_NORM, IN_GDN_O, IN_FFN_UP, IN_FFN_CONV, IN_FFN_DN };

__device__ __forceinline__ void transpose_item(const float* W, int ldw, int K, int srccol0, const float* gain, bf16_t* WT, int dstrow0, int k0, LAS float* scr, int lane) {
    float wv[32];
    { const float* wp = W + (size_t)(k0 + (lane >> 5)) * ldw + srccol0 + (lane & 31); unsigned off = 0;
#pragma unroll
      for (int i = 0; i < 32; ++i) { wv[i] = wp[off]; off += 2 * ldw; asm volatile("" : "+v"(off)); }
      __builtin_amdgcn_sched_barrier(0); }
#pragma unroll
    for (int i = 0; i < 32; ++i) { const int kk = 2 * i + (lane >> 5); float v = wv[i]; if (gain) v *= gain[k0 + kk]; scr[kk * 33 + (lane & 31)] = v; }
    asm volatile("s_waitcnt lgkmcnt(0)" ::: "memory");
    const int c = lane & 7;
#pragma unroll
    for (int j = 0; j < 4; ++j) { const int n = (lane >> 3) + 8 * j; const LAS float* s = scr + (8 * c) * 33 + n;
        u32x4 o; o.x = cvt_pk_bf16(s[0 * 33], s[1 * 33]); o.y = cvt_pk_bf16(s[2 * 33], s[3 * 33]); o.z = cvt_pk_bf16(s[4 * 33], s[5 * 33]); o.w = cvt_pk_bf16(s[6 * 33], s[7 * 33]);
        *(u32x4*)(WT + (size_t)(dstrow0 + n) * K + k0 + 8 * c) = o; }
    asm volatile("s_waitcnt lgkmcnt(0)" ::: "memory");
}
__device__ __forceinline__ void phase_prologue(const Params& P, LAS unsigned char* lds, int wg, int G) {
    const int tid = opaque_tid(), lane = tid & 63, wave = tid >> 6;
    LAS float* scr = (LAS float*)(lds + wave * 16384);
    const int gw = wg * 8 + wave, NGW = G * 8;
    bf16_t* Wb = (bf16_t*)(P.ws + WS_W);
    constexpr int NITEMS = 3072 + 1024 + 1536 + 512 + 2048 + 512 + 4 * 2816 + 4 * 1408;
    for (int it = gw; it < NITEMS; it += NGW) {
        int r = it; const float* src; int ldw, K, N; const float* gain; size_t doff; int map = 0;
        if (r < 3072) { const int j = r / 1536; r -= j * 1536; src = P.in[IN_MOBA_QKV] + (size_t)j * DM * 3072; ldw = 3072; K = DM; N = 3072; gain = P.in[IN_MIXN] + (j == 0 ? 0 : 3) * DM; doff = j == 0 ? W_MOBA_QKV0 : W_MOBA_QKV1; }
        else if ((r -= 3072) < 1024) { const int j = r / 512; r -= j * 512; src = P.in[IN_MOBA_O] + (size_t)j * DM * DM; ldw = DM; K = DM; N = DM; gain = nullptr; doff = j == 0 ? W_MOBA_O0 : W_MOBA_O1; }
        else if ((r -= 1024) < 1536) { src = P.in[IN_SC_IN]; ldw = 3072; K = DM; N = 3072; gain = P.in[IN_MIXN] + 1 * DM; doff = W_SC_IN; }
        else if ((r -= 1536) < 512) { src = P.in[IN_SC_OUT]; ldw = DM; K = DM; N = DM; gain = nullptr; doff = W_SC_OUT; }
        else if ((r -= 512) < 2048) { src = P.in[IN_GDN_IN]; ldw = 4112; K = DM; N = 4096; gain = P.in[IN_MIXN] + 2 * DM; doff = W_GDN_IN; }
        else if ((r -= 2048) < 512) { src = P.in[IN_GDN_O]; ldw = DM; K = DM; N = DM; gain = nullptr; doff = W_GDN_O; }
        else if ((r -= 512) < 4 * 2816) { const int j = r / 2816; r -= j * 2816; src = P.in[IN_FFN_UP] + (size_t)j * DM * (2 * FFD); ldw = 2 * FFD; K = DM; N = 2 * FFD; gain = P.in[IN_FFNN] + j * DM; doff = W_FFN_UP + j * W_FFN_UP_STRIDE; map = 1; }
        else { r -= 4 * 2816; const int j = r / 1408; r -= j * 1408; src = P.in[IN_FFN_DN] + (size_t)j * FFD * DM; ldw = DM; K = FFD; N = DM; gain = nullptr; doff = W_FFN_DN + j * W_FFN_DN_STRIDE; }
        const int nblk = N / 32, kb = r / nblk, nb = r % nblk, n0 = 32 * nb;
        int sc0 = n0;
        if (map == 1) { const int tile = n0 >> 8, w = n0 & 255; sc0 = (w < 128) ? tile * 128 + w : FFD + tile * 128 + (w - 128); }
        transpose_item(src, ldw, K, sc0, gain, (bf16_t*)((unsigned char*)Wb + doff), n0, 64 * kb, scr, lane);
    }
    { float* bgw = (float*)(P.ws + WS_MISC + MISC_BGW); const float* src = P.in[IN_GDN_IN]; const float* gain = P.in[IN_MIXN] + 2 * DM;
      for (int i = wg * 512 + tid; i < 16 * DM; i += G * 512) { const int c = i >> 10, k = i & 1023; bgw[i] = src[(size_t)k * 4112 + 4096 + c] * gain[k]; } }
    { const float* x = P.in[IN_X]; bf16_t* xb = (bf16_t*)(P.ws + WS_XB); u64_t* ssq = (u64_t*)(P.ws + WS_SSQ);
      for (int t0 = gw; t0 < T_TOK; t0 += 4 * NGW) {
          f32x4 v[4][4];
#pragma unroll
          for (int r = 0; r < 4; ++r) { const f32x4* xr = (const f32x4*)(x + (size_t)(t0 + r * NGW) * DM) + lane;
#pragma unroll
              for (int j = 0; j < 4; ++j) v[r][j] = xr[64 * j]; }
#pragma unroll
          for (int r = 0; r < 4; ++r) { const int t = t0 + r * NGW; u32x2* brow = (u32x2*)(xb + (size_t)t * DM) + lane; float s = 0.f;
#pragma unroll
              for (int j = 0; j < 4; ++j) { const f32x4 q = v[r][j]; u32x2 w; w.x = cvt_pk_bf16(q[0], q[1]); w.y = cvt_pk_bf16(q[2], q[3]); brow[64 * j] = w; s += (q[0] * q[0] + q[1] * q[1]) + (q[2] * q[2] + q[3] * q[3]); }
              s = wave_sum(s); if (lane == 0) ssq[t] = ssq_fix(s); } } }
}

__device__ __forceinline__ void phase_final(const Params& P, int wg, int G) {
    const int tid = opaque_tid(), lane = tid & 63, wave = tid >> 6, gw = wg * 8 + wave, NGW = G * 8;
    const u64_t* ssq = (const u64_t*)(P.ws + WS_SSQ) + (size_t)8 * T_TOK; const f32x4* gn = (const f32x4*)P.in[IN_FINN] + lane; const bf16_t* xb = (const bf16_t*)(P.ws + WS_XB);
    const f32x4 g0 = gn[0], g1 = gn[64], g2 = gn[128], g3 = gn[192];
    for (int t0 = gw; t0 < T_TOK; t0 += 4 * NGW) {
        u32x2 v[4][4]; float rs[4];
#pragma unroll
        for (int r = 0; r < 4; ++r) { const int t = t0 + r * NGW; rs[r] = ssq_rs(ssq[t]); const u32x2* xr = (const u32x2*)(xb + (size_t)t * DM) + lane;
#pragma unroll
            for (int j = 0; j < 4; ++j) v[r][j] = xr[64 * j]; }
#pragma unroll
        for (int r = 0; r < 4; ++r) { const int t = t0 + r * NGW; f32x4* xo = (f32x4*)(P.out + (size_t)t * DM) + lane;
            xo[0] = bf4(v[r][0]) * rs[r] * g0; xo[64] = bf4(v[r][1]) * rs[r] * g1; xo[128] = bf4(v[r][2]) * rs[r] * g2; xo[192] = bf4(v[r][3]) * rs[r] * g3; }
    }
}

__device__ __forceinline__ void phase_ffn_fix(const Params& P, int layer, int wg, int G) {
    const float* halo = (const float*)(P.ws + WS_S + S_FFN_HALO); bf16_t* act = (bf16_t*)(P.ws + WS_S + S_FFN_ACT); const float* cw = P.in[IN_FFN_CONV] + (size_t)layer * 3 * (2 * FFD);
    const int tid = opaque_tid();
    for (int i = wg * 512 + tid; i < 512 * FFD; i += G * 512) {
        const int row = i / FFD, c = i - row * FFD, g = row >> 1, tau = row & 1, t = 128 * g + tau, s = t & (SEQ - 1);
        const float* hg = halo + (size_t)g * 4 * (2 * FFD); const float* hp = hg - 4 * (2 * FFD);
        float g0, g1, g2, u0, u1, u2;
        if (tau == 0) { g0 = hg[c]; u0 = hg[FFD + c]; if (s >= 2) { g1 = hp[3 * (2 * FFD) + c]; u1 = hp[3 * (2 * FFD) + FFD + c]; g2 = hp[2 * (2 * FFD) + c]; u2 = hp[2 * (2 * FFD) + FFD + c]; } else { g1 = g2 = u1 = u2 = 0.f; } }
        else { g0 = hg[(2 * FFD) + c]; u0 = hg[(2 * FFD) + FFD + c]; g1 = hg[c]; u1 = hg[FFD + c]; if (s >= 2) { g2 = hp[3 * (2 * FFD) + c]; u2 = hp[3 * (2 * FFD) + FFD + c]; } else { g2 = u2 = 0.f; } }
        const float gc = cw[2 * (2 * FFD) + c] * g0 + cw[(2 * FFD) + c] * g1 + cw[c] * g2;
        const float uc = cw[2 * (2 * FFD) + FFD + c] * u0 + cw[(2 * FFD) + FFD + c] * u1 + cw[FFD + c] * u2;
        act[(size_t)t * FFD + c] = f2bf(silu_f(gc) * uc);
    }
}

__device__ __forceinline__ void phase_sconv(const Params& P, int wg, int G) {
    const bf16_t* proj = (const bf16_t*)(P.ws + WS_S + S_SC_PROJ); bf16_t* y = (bf16_t*)(P.ws + WS_S + S_SC_Y); const float* cw = P.in[IN_SC_CONV];
    const int c = 2 * opaque_tid();
    const float w00 = cw[c], w01 = cw[c + 1], w10 = cw[DM + c], w11 = cw[DM + c + 1], w20 = cw[2 * DM + c], w21 = cw[2 * DM + c + 1];
    for (int ch = wg; ch < T_TOK / 64; ch += G) {
        const int t0 = ch * 64, s0 = t0 & (SEQ - 1);
        float p1a = 0.f, p1b = 0.f, p2a = 0.f, p2b = 0.f;
        if (s0 != 0) {
            const unsigned c1 = *(const unsigned*)(proj + (size_t)(t0 - 1) * 3072 + DM + c), x1 = *(const unsigned*)(proj + (size_t)(t0 - 1) * 3072 + 2 * DM + c);
            const unsigned c2 = *(const unsigned*)(proj + (size_t)(t0 - 2) * 3072 + DM + c), x2 = *(const unsigned*)(proj + (size_t)(t0 - 2) * 3072 + 2 * DM + c);
            p1a = bf_lo(c1) * bf_lo(x1); p1b = bf_hi(c1) * bf_hi(x1); p2a = bf_lo(c2) * bf_lo(x2); p2b = bf_hi(c2) * bf_hi(x2);
        }
#pragma unroll 1
        for (int i0 = 0; i0 < 64; i0 += 16) {
            unsigned bb[16], cc[16], xx[16];
#pragma unroll
            for (int i = 0; i < 16; ++i) { const bf16_t* r = proj + (size_t)(t0 + i0 + i) * 3072; bb[i] = *(const unsigned*)(r + c); cc[i] = *(const unsigned*)(r + DM + c); xx[i] = *(const unsigned*)(r + 2 * DM + c); }
#pragma unroll
            for (int i = 0; i < 16; ++i) {
                const float pa = bf_lo(cc[i]) * bf_lo(xx[i]), pb = bf_hi(cc[i]) * bf_hi(xx[i]);
                const float ya = bf_lo(bb[i]) * (w20 * pa + w10 * p1a + w00 * p2a), yb = bf_hi(bb[i]) * (w21 * pb + w11 * p1b + w01 * p2b);
                *(unsigned*)(y + (size_t)(t0 + i0 + i) * DM + c) = cvt_pk_bf16(ya, yb);
                p2a = p1a; p2b = p1b; p1a = pa; p1b = pb; }
        }
    }
}

__device__ __forceinline__ void phase_moba_kmean_vt(const Params& P, LAS unsigned char* lds, int wg, int G) {
    const bf16_t* qkv = (const bf16_t*)(P.ws + WS_S + S_MOBA_QKV); bf16_t* kmh = (bf16_t*)(P.ws + WS_MISC + MISC_KMEAN); bf16_t* kml = kmh + 1024 * 128;
    const int tid = opaque_tid();
    LAS float* red = (LAS float*)lds;
    for (int u = wg; u < 1024; u += G) {
        const int b = u >> 9, h = (u >> 6) & 7, blk = u & 63; const size_t row0 = (size_t)b * SEQ + (size_t)blk * BLK;
        __syncthreads();
        { const int d2 = tid & 63, part = tid >> 6; float s0 = 0.f, s1 = 0.f; const bf16_t* kp = qkv + (row0 + part * 32) * 3072 + DM + h * HD + 2 * d2;
          unsigned kq[32];
#pragma unroll
          for (int i = 0; i < 32; ++i) kq[i] = *(const unsigned*)(kp + (size_t)i * 3072);
#pragma unroll
          for (int i = 0; i < 32; ++i) { s0 += bf_lo(kq[i]); s1 += bf_hi(kq[i]); }
          red[part * 128 + 2 * d2] = s0; red[part * 128 + 2 * d2 + 1] = s1; }
        {
            float* kn = (float*)(P.ws + WS_S + S_MOBA_KN); const int lane_ = tid & 63, w_ = tid >> 6; float mxn = 0.f; unsigned kv[32];
            const bf16_t* kp = qkv + (row0 + w_ * 32) * 3072 + DM + h * HD + 2 * lane_;
#pragma unroll
            for (int i = 0; i < 32; ++i) kv[i] = *(const unsigned*)(kp + (size_t)i * 3072);
#pragma unroll
            for (int i = 0; i < 32; ++i) { const float a = bf_lo(kv[i]), c = bf_hi(kv[i]); const float nn = sqrtf(wave_sum(a * a + c * c)); mxn = fmaxf(mxn, nn); if (lane_ == 0) kn[(row0 + w_ * 32 + i) * NH + h] = nn; }
            if (lane_ == 0) red[1024 + w_] = mxn; }
        __syncthreads();
        if (tid == 0) { float m = 0.f;
#pragma unroll
            for (int w = 0; w < 8; ++w) m = fmaxf(m, red[1024 + w]);
            ((float*)(P.ws + WS_S + S_MOBA_KMAX))[u] = m; }
        if (tid < 128) { float s = 0.f;
#pragma unroll
            for (int p = 0; p < 8; ++p) s += red[p * 128 + tid];
            const float m = s * (1.0f / BLK); const bf16_t hi = f2bf(m); kmh[(size_t)u * 128 + tid] = hi; kml[(size_t)u * 128 + tid] = f2bf(m - bf2f(hi)); }
    }
}


__device__ __forceinline__ void phase_moba_gate2(const Params& P, LAS unsigned char* lds, int mj, int wg, int G) {
    const bf16_t* qkv = (const bf16_t*)(P.ws + WS_S + S_MOBA_QKV); const bf16_t* kmh = (const bf16_t*)(P.ws + WS_MISC + MISC_KMEAN); const bf16_t* kml = kmh + 1024 * 128;
    int* cnt = (int*)(P.ws + WS_CTL + CTL_CNT) + mj * 1024; unsigned short* list = (unsigned short*)(P.ws + WS_S + S_MOBA_LIST);
    const int tid = opaque_tid(), lane = tid & 63, wave = __builtin_amdgcn_readfirstlane(tid >> 6), i16 = lane & 15, quad = lane >> 4;
    LAS float* SC = (LAS float*)(lds + 34816); LAS int* cntL = (LAS int*)(lds + 34816 + 66560); LAS int* baseL = cntL + 64; LAS float* qnL = (LAS float*)(baseL + 64); LAS float* kmxL = qnL + 256;
    for (int u = wg; u < 63 * 16; u += G) {
        const int own = 63 - u / 16, bh = u & 15, b = bh >> 3, h = bh & 7, nnb = (own + 15) >> 4;
        __syncthreads();
        if (tid < 64) cntL[tid] = 0;
        for (int c = tid; c < nnb * 256; c += 512) { const int row = c >> 4, pc = c & 15;
            *(LAS u32x4*)(lds + row * 272 + pc * 16) = *(const u32x4*)(kmh + (size_t)(bh * NBLK + row) * 128 + pc * 8);
            *(LAS u32x4*)(lds + 17408 + row * 272 + pc * 16) = *(const u32x4*)(kml + (size_t)(bh * NBLK + row) * 128 + pc * 8); }
        bf16x8 qf[2][4];
#pragma unroll
        for (int q2 = 0; q2 < 2; ++q2) { const bf16_t* qp = qkv + ((size_t)b * SEQ + own * BLK + 16 * (2 * wave + q2) + i16) * 3072 + h * HD + 8 * quad;
#pragma unroll
            for (int ks = 0; ks < 4; ++ks) qf[q2][ks] = *(const bf16x8*)(qp + 32 * ks);
            float s2 = 0.f;
#pragma unroll
            for (int ks = 0; ks < 4; ++ks) { const u32x4 w4 = __builtin_bit_cast(u32x4, qf[q2][ks]);
#pragma unroll
                for (int e = 0; e < 4; ++e) { const float a = bf_lo(w4[e]), c = bf_hi(w4[e]); s2 += a * a + c * c; } }
            s2 += __shfl_xor(s2, 16); s2 += __shfl_xor(s2, 32);
            if (quad == 0) qnL[16 * (2 * wave + q2) + i16] = s2; }
        if (tid < 64) kmxL[tid] = ((const float*)(P.ws + WS_S + S_MOBA_KMAX))[bh * NBLK + tid];
        __syncthreads();
#pragma unroll
        for (int q2 = 0; q2 < 2; ++q2)
#pragma unroll 1
            for (int nb = 0; nb < nnb; ++nb) { f32x4 acc = (f32x4){0.f, 0.f, 0.f, 0.f};
#pragma unroll
                for (int ks = 0; ks < 4; ++ks) { acc = __builtin_amdgcn_mfma_f32_16x16x32_bf16(qf[q2][ks], *(const LAS bf16x8*)(lds + 17408 + (16 * nb + i16) * 272 + (32 * ks + 8 * quad) * 2), acc, 0, 0, 0);
                                                 acc = __builtin_amdgcn_mfma_f32_16x16x32_bf16(qf[q2][ks], *(const LAS bf16x8*)(lds + (16 * nb + i16) * 272 + (32 * ks + 8 * quad) * 2), acc, 0, 0, 0); }
#pragma unroll
                for (int jj = 0; jj < 4; ++jj) SC[(16 * (2 * wave + q2) + 4 * quad + jj) * 65 + 16 * nb + i16] = acc[jj]; }
        __syncthreads();
        int sel[3] = {-1, -1, -1}, lp[3] = {0, 0, 0};
        if (tid < 256) { const LAS float* sr = SC + tid * 65;
            float v0 = -3.0e38f, v1 = -3.0e38f, v2 = -3.0e38f; int i0 = -1, i1 = -1, i2 = -1;
            for (int n = 0; n < own; ++n) { const float s = sr[n];
                if (s > v0) { v2 = v1; i2 = i1; v1 = v0; i1 = i0; v0 = s; i0 = n; } else if (s > v1) { v2 = v1; i2 = i1; v1 = s; i1 = n; } else if (s > v2) { v2 = s; i2 = n; } }
            sel[0] = i0; sel[1] = i1; sel[2] = i2;
            const int tl_ = own * BLK + tid; const float qn = sqrtf(qnL[tid]) * 0.08838834764831845f, kself = ((const float*)(P.ws + WS_S + S_MOBA_KN))[((size_t)b * SEQ + tl_) * NH + h], slope = exp2f(-(float)(h + 1));
            unsigned mbits = 0u;
#pragma unroll
            for (int s = 0; s < 3; ++s) if (sel[s] >= 0) { const float bound = qn * (kmxL[sel[s]] + kself) - slope * (float)(tl_ - (sel[s] * BLK + BLK - 1));
                if (bound < -110.0f) sel[s] = -1; else mbits |= 1u << s; }
            ((unsigned char*)(P.ws + WS_S + S_MOBA_MASK))[((size_t)b * SEQ + tl_) * NH + h] = (unsigned char)mbits;
#pragma unroll
            for (int s = 0; s < 3; ++s) lp[s] = (sel[s] >= 0) ? __hip_atomic_fetch_add(cntL + sel[s], 1, __ATOMIC_RELAXED, __HIP_MEMORY_SCOPE_WORKGROUP) : 0;
        }
        __syncthreads();
        if (tid < 64) { const int c = cntL[tid]; baseL[tid] = (c > 0) ? atomicAdd(cnt + (b * NH + h) * NBLK + tid, c) : 0; }
        __syncthreads();
        if (tid < 256) { const int tl = own * BLK + tid;
#pragma unroll
            for (int s = 0; s < 3; ++s) if (sel[s] >= 0) list[(size_t)((b * NH + h) * NBLK + sel[s]) * SEQ + baseL[sel[s]] + lp[s]] = (unsigned short)((tl << 2) | s); }
    }
}

constexpr int AT_KSTRIDE = 272, AT_VS = 256 * 272, AT_VSTRIDE = 288, AT_PREF = AT_VS + 256 * 288;
typedef short s16x4 __attribute__((ext_vector_type(4)));
struct AtRegs { u32x4 p[8]; bf16x8 q[4]; unsigned mbits; float ls[3]; };
#define AT_BAR() do { asm volatile("s_waitcnt lgkmcnt(0)" ::: "memory"); __builtin_amdgcn_s_barrier(); asm volatile("" ::: "memory"); } while (0)
template <bool OWN>
__device__ __forceinline__ void attn_issue_kq(const Params& P, int b, int h, int j, int tl, int tid, AtRegs& R) {
    const bf16_t* qkvb = (const bf16_t*)(P.ws + WS_S + S_MOBA_QKV) + (size_t)b * SEQ * 3072;
    const int piece = tid & 15, r0 = tid >> 4, quad = (tid & 63) >> 4;
    const char* kp = (const char*)(qkvb + (size_t)(j * BLK + 8 * ((r0 & 15) >> 2) + 4 * (r0 >> 4) + (r0 & 3)) * 3072 + DM + h * HD + piece * 8);
#pragma unroll
    for (int it = 0; it < 8; ++it) R.p[it] = *(const u32x4*)(kp + (size_t)it * (32 * 3072 * 2));
    const bf16_t* qp = qkvb + (size_t)tl * 3072 + h * HD + quad * 8;
#pragma unroll
    for (int ks = 0; ks < 4; ++ks) R.q[ks] = *(const bf16x8*)(qp + 32 * ks);
    if (OWN) { R.mbits = (j != 0) ? (unsigned)((const unsigned char*)(P.ws + WS_S + S_MOBA_MASK))[((size_t)b * SEQ + tl) * NH + h] : 0u;
        const float* plse = (const float*)(P.ws + WS_S + S_MOBA_LSE) + ((size_t)tl * NH + h) * 3;
#pragma unroll
        for (int s = 0; s < 3; ++s) R.ls[s] = plse[s]; }
}
template <bool OWN, int nkb>
__device__ __forceinline__ void attn_tile(const Params& P, LAS unsigned char* lds, int b, int h, int j, int tl, bool valid, int slot, AtRegs& R, bool hasN, int hN, int jN, int tlN) {
    const int tid = opaque_tid(), lane = tid & 63, i = lane & 15, quad = lane >> 4, piece = tid & 15, r0 = tid >> 4;
    bf16_t* qkvb = (bf16_t*)(P.ws + WS_S + S_MOBA_QKV) + (size_t)b * SEQ * 3072;
    AT_BAR();
#pragma unroll
    for (int it = 0; it < 8; ++it) *(LAS u32x4*)(lds + (r0 + 32 * it) * AT_KSTRIDE + piece * 16) = R.p[it];
    bf16x8 qf[4]; unsigned mbits = 0u; float ls[3] = {0.f, 0.f, 0.f};
#pragma unroll
    for (int ks = 0; ks < 4; ++ks) qf[ks] = R.q[ks];
    if (OWN) { mbits = R.mbits;
#pragma unroll
        for (int s = 0; s < 3; ++s) ls[s] = R.ls[s]; }
    AT_BAR();
    bf16_t* op = qkvb + (size_t)tl * 3072 + h * HD + 4 * quad;
    u32x2 pv[3][8];
    if (OWN) { const bf16_t* ppo = (const bf16_t*)(P.ws + WS_S + S_MOBA_PO) + ((size_t)tl * NH + h) * 3 * HD + 4 * quad;
#pragma unroll
        for (int s = 0; s < 3; ++s) { const bf16_t* src = ((mbits >> s) & 1u) ? ppo + (size_t)s * HD : op;
#pragma unroll
            for (int db = 0; db < 8; ++db) pv[s][db] = *(const u32x2*)(src + 16 * db); } }
    { const char* vp = (const char*)(qkvb + (size_t)(j * BLK + r0) * 3072 + 2 * DM + h * HD + piece * 8);
#pragma unroll
      for (int it = 0; it < 8; ++it) R.p[it] = *(const u32x4*)(vp + (size_t)it * (32 * 3072 * 2)); }
    f32x4 sc[16];
#pragma unroll
    for (int kb = 0; kb < 16; ++kb) {
        sc[kb] = (f32x4){0.f, 0.f, 0.f, 0.f};
        if (kb < nkb) {
#pragma unroll
            for (int ks = 0; ks < 4; ++ks) { const bf16x8 kf = *(const LAS bf16x8*)(lds + (16 * kb + i) * AT_KSTRIDE + (32 * ks + 8 * quad) * 2);
                sc[kb] = __builtin_amdgcn_mfma_f32_16x16x32_bf16(kf, qf[ks], sc[kb], 0, 0, 0); }
        }
    }
    const float slope = exp2f(-(float)(h + 1)) * LOG2E, scale = 0.08838834764831845f * LOG2E;
    float mx = -3.0e38f;
    const int rq = tl - j * BLK - 8 * quad; const float c0 = -slope * (float)rq;
#pragma unroll
    for (int kb = 0; kb < 16; ++kb) if (kb < nkb) {
#pragma unroll
        for (int jj = 0; jj < 4; ++jj) { const int K = 32 * (kb >> 1) + 4 * (kb & 1) + jj;
            float s = fmaf(sc[kb][jj], scale, fmaf(slope, (float)K, c0)); if (OWN && K > rq) s = -1.0e30f; sc[kb][jj] = s; mx = fmaxf(mx, s); }
    }
    mx = fmaxf(mx, __shfl_xor(mx, 16)); mx = fmaxf(mx, __shfl_xor(mx, 32));
    float l = 0.f;
#pragma unroll
    for (int kb = 0; kb < 16; ++kb) if (kb < nkb) {
#pragma unroll
        for (int jj = 0; jj < 4; ++jj) { const float p = fast_exp2(sc[kb][jj] - mx); sc[kb][jj] = p; l += p; }
    }
    l += __shfl_xor(l, 16); l += __shfl_xor(l, 32);
    const float lse = (mx + __log2f(l)) * LN2;
    f32x4 oacc[8];
    if (OWN) {
        float M = lse;
#pragma unroll
        for (int s = 0; s < 3; ++s) { ls[s] = ((mbits >> s) & 1u) ? ls[s] : -3.0e38f; M = fmaxf(M, ls[s]); }
        const float wown = __expf(lse - M); float wsl[3]; float den = wown;
#pragma unroll
        for (int s = 0; s < 3; ++s) { wsl[s] = ((mbits >> s) & 1u) ? __expf(ls[s] - M) : 0.f; den += wsl[s]; }
        const float rden = fast_rcp(den), wo = wown * fast_rcp(l) * rden;
#pragma unroll
        for (int s = 0; s < 3; ++s) wsl[s] *= rden;
#pragma unroll
        for (int kb = 0; kb < 16; ++kb) if (kb < nkb) sc[kb] = sc[kb] * wo;
#pragma unroll
        for (int db = 0; db < 8; ++db) { f32x4 o = (f32x4){0.f, 0.f, 0.f, 0.f};
#pragma unroll
            for (int s = 0; s < 3; ++s) { const u32x2 q = pv[s][db]; const float ww = wsl[s];
                o[0] += ww * bf_lo(q.x); o[1] += ww * bf_hi(q.x); o[2] += ww * bf_lo(q.y); o[3] += ww * bf_hi(q.y); }
            oacc[db] = o; }
    } else {
#pragma unroll
        for (int db = 0; db < 8; ++db) oacc[db] = (f32x4){0.f, 0.f, 0.f, 0.f};
    }
    bf16x8 pf[8];
#pragma unroll
    for (int s = 0; s < 8; ++s) if (2 * s < nkb) pf[s] = pack8(sc[2 * s], sc[2 * s + 1]);
#pragma unroll
    for (int it = 0; it < 8; ++it) *(LAS u32x4*)(lds + AT_VS + (r0 + 32 * it) * AT_VSTRIDE + piece * 16) = R.p[it];
    AT_BAR();
    if (hasN) attn_issue_kq<OWN>(P, b, hN, jN, tlN, tid, R);
#pragma unroll
    for (int s = 0; s < 8; ++s) if (2 * s < nkb) {
#pragma unroll
        for (int db = 0; db < 8; ++db) {
            const LAS unsigned char* vp = lds + AT_VS + (32 * s + 8 * quad + (i >> 2)) * AT_VSTRIDE + (16 * db + 4 * (i & 3)) * 2;
            const s16x4 lo = __builtin_amdgcn_ds_read_tr16_b64_v4i16((LAS s16x4*)vp), hi = __builtin_amdgcn_ds_read_tr16_b64_v4i16((LAS s16x4*)(vp + 4 * AT_VSTRIDE));
            const bf16x8 vf = __builtin_shufflevector(lo, hi, 0, 1, 2, 3, 4, 5, 6, 7);
            oacc[db] = __builtin_amdgcn_mfma_f32_16x16x32_bf16(vf, pf[s], oacc[db], 0, 0, 0); }
    }
    if (!OWN) {
        if (valid) {
            const float inv = fast_rcp(l); const size_t pr = ((size_t)tl * NH + h) * 3 + slot;
            bf16_t* po = (bf16_t*)(P.ws + WS_S + S_MOBA_PO) + pr * HD + 4 * quad;
#pragma unroll
            for (int db = 0; db < 8; ++db) { u32x2 w; w.x = cvt_pk_bf16(oacc[db][0] * inv, oacc[db][1] * inv); w.y = cvt_pk_bf16(oacc[db][2] * inv, oacc[db][3] * inv); *(u32x2*)(po + 16 * db) = w; }
            if (quad == 0) ((float*)(P.ws + WS_S + S_MOBA_LSE))[pr] = lse;
        }
    } else {
#pragma unroll
        for (int db = 0; db < 8; ++db) { u32x2 w; w.x = cvt_pk_bf16(oacc[db][0], oacc[db][1]); w.y = cvt_pk_bf16(oacc[db][2], oacc[db][3]); *(u32x2*)(op + 16 * db) = w; }
    }
}

__device__ __forceinline__ void phase_moba_gather(const Params& P, LAS unsigned char* lds, int mj, int b, int wg, int G) {
    const int* cnt = (const int*)(P.ws + WS_CTL + CTL_CNT) + mj * 1024 + b * 512;
    const unsigned short* list = (const unsigned short*)(P.ws + WS_S + S_MOBA_LIST) + (size_t)b * 512 * SEQ;
    const int tid = opaque_tid(), lane = tid & 63, wid = tid >> 6;
    LAS int* pref = (LAS int*)(lds + AT_PREF); LAS int* cl = pref + 520; LAS int* wtot = cl + 512;
    __syncthreads();
    { const int c = cnt[tid]; int v = (c + 127) >> 7; cl[tid] = c;
#pragma unroll
      for (int o = 1; o < 64; o <<= 1) { const int y = __shfl_up(v, o); if (lane >= o) v += y; }
      if (lane == 63) wtot[wid] = v;
      __syncthreads();
      int base = 0; for (int w = 0; w < wid; ++w) base += wtot[w];
      pref[tid + 1] = base + v; if (tid == 0) pref[0] = 0; }
    __syncthreads();
    const int total = pref[512];
    const int nx = G >> 3, xr = (G & 7) ? 0 : 1;
    int item = xr ? (wg & 7) * nx + (wg >> 3) : wg;
    if (item >= total) return;
#define AT_DECODE(it_, hj_, va_, ad_) do { int lo_ = 0, hi_ = 512; while (hi_ - lo_ > 1) { const int mid_ = (lo_ + hi_) >> 1; if (pref[mid_] <= (it_)) lo_ = mid_; else hi_ = mid_; } \
        hj_ = lo_; const int c_ = cl[lo_], e_ = ((it_) - pref[lo_]) * 128 + 16 * wid + (lane & 15); va_ = e_ < c_; ad_ = list + (size_t)lo_ * SEQ + (va_ ? e_ : c_ - 1); } while (0)
    int hjA, hjB = 0, hjC = 0; bool vaA, vaB = false, vaC = false; const unsigned short* ad; unsigned eA, eB = 0, eC = 0;
    AT_DECODE(item, hjA, vaA, ad); eA = *ad;
    bool hasB = item + G < total;
    if (hasB) { AT_DECODE(item + G, hjB, vaB, ad); eB = *ad; }
    AtRegs R;
    attn_issue_kq<false>(P, b, hjA >> 6, hjA & 63, (int)(eA >> 2), tid, R);
    for (;;) {
        const bool hasC = item + 2 * G < total;
        if (hasC) { AT_DECODE(item + 2 * G, hjC, vaC, ad); eC = *ad; }
        attn_tile<false, 16>(P, lds, b, hjA >> 6, hjA & 63, (int)(eA >> 2), vaA, (int)(eA & 3), R, hasB, hjB >> 6, hjB & 63, (int)(eB >> 2));
        if (!hasB) break;
        hjA = hjB; vaA = vaB; eA = eB; hjB = hjC; vaB = vaC; eB = eC; hasB = hasC; item += G;
    }
#undef AT_DECODE
}
__device__ __forceinline__ void phase_moba_own(const Params& P, LAS unsigned char* lds, int b, int wg, int G) {
    const int tid = opaque_tid(), lane = tid & 63, wid = tid >> 6;
    const int nx = G >> 3, xr = (G & 7) ? 0 : 1;
    int it = xr ? (wg & 7) * nx + (wg >> 3) : wg;
    if (it >= 1024) return;
#define AT_OWN(it_, h_, j_, c_, tl_) do { const int hj_ = (it_) >> 1; c_ = (((it_) >> 8) ^ (it_)) & 1; h_ = hj_ >> 6; j_ = hj_ & 63; tl_ = j_ * BLK + 128 * c_ + 16 * wid + (lane & 15); } while (0)
    int hA, jA, cA, tlA, hB = 0, jB = 0, cB = 0, tlB = 0;
    AT_OWN(it, hA, jA, cA, tlA);
    AtRegs R;
    attn_issue_kq<true>(P, b, hA, jA, tlA, tid, R);
    for (;;) {
        const bool hasB = it + G < 1024;
        if (hasB) AT_OWN(it + G, hB, jB, cB, tlB);
        if (cA) attn_tile<true, 16>(P, lds, b, hA, jA, tlA, true, 0, R, hasB, hB, jB, tlB); else attn_tile<true, 8>(P, lds, b, hA, jA, tlA, true, 0, R, hasB, hB, jB, tlB);
        if (!hasB) break;
        hA = hB; jA = jB; cA = cB; tlA = tlB; it += G;
    }
#undef AT_OWN
}
__device__ __forceinline__ void phase_gdn_bg(const Params& P, int wg, int G) {
    const int tid = opaque_tid(), lane = tid & 63, wave = tid >> 6, gw = wg * 8 + wave, NGW = G * 8;
    const bf16_t* X = (const bf16_t*)(P.ws + WS_XB); const u64_t* ssq = (const u64_t*)(P.ws + WS_SSQ) + (size_t)4 * T_TOK; const float* bgw = (const float*)(P.ws + WS_MISC + MISC_BGW);
    float* bg = (float*)(P.ws + WS_S + S_GDN_BG); const float* alog = P.in[IN_GDN_ALOG]; const float* dtb = P.in[IN_GDN_DTB];
    for (int t = gw; t < T_TOK; t += NGW) {
        const u32x2* xr = (const u32x2*)(X + (size_t)t * DM) + lane; f32x4 x4[4];
#pragma unroll
        for (int jj = 0; jj < 4; ++jj) x4[jj] = bf4(xr[64 * jj]);
        float mine = 0.f;
#pragma unroll
        for (int c = 0; c < 16; ++c) { const f32x4* wr_ = (const f32x4*)(bgw + (size_t)c * DM) + lane; float a = 0.f;
#pragma unroll
            for (int jj = 0; jj < 4; ++jj) { const f32x4 w4 = wr_[64 * jj]; a += (x4[jj][0] * w4[0] + x4[jj][1] * w4[1]) + (x4[jj][2] * w4[2] + x4[jj][3] * w4[3]); }
            a = wave_sum(a); if (lane == c) mine = a; }
        if (lane < 16) { const float raw = mine * ssq_rs(ssq[t]); float o;
            if (lane < 8) o = 1.0f / (1.0f + __expf(-raw));
            else { const int hh = lane - 8; const float xx = raw + dtb[hh]; const float sp = fmaxf(xx, 0.f) + __logf(1.0f + __expf(-fabsf(xx))); o = -__expf(alog[hh]) * sp; }
            bg[(size_t)t * 16 + lane] = o; }
    }
}
__device__ __forceinline__ u32x2 pack4(f32x4 v) { u32x2 w; w.x = cvt_pk_bf16(v[0], v[1]); w.y = cvt_pk_bf16(v[2], v[3]); return w; }
__device__ __forceinline__ void phase_gdn_chunk2(const Params& P, LAS unsigned char* lds, int wg, int G) {
    bf16_t* proj = (bf16_t*)(P.ws + WS_S + S_GDN_PROJ); bf16_t* attn = (bf16_t*)(P.ws + WS_S + S_GDN_ATTN); const float* bg = (const float*)(P.ws + WS_S + S_GDN_BG);
    const bf16_t* halo = (const bf16_t*)(P.ws + WS_S + S_GDN_HALO); float* gcum = (float*)(P.ws + WS_S + S_GDN_GC); bf16_t* wbuf = (bf16_t*)P.out; const float* cw = P.in[IN_GDN_CONV];
    LAS float* qL = (LAS float*)lds; LAS float* kL = qL + 64 * 132; LAS float* vL = kL + 64 * 132; LAS float* AL = vL + 64 * 132;
    LAS unsigned char* Qb = lds + 118784; LAS unsigned char* Kb = lds + 136192; LAS float* betaL = (LAS float*)(lds + 153600); LAS float* gcL = betaL + 64; LAS float* DinvL = (LAS float*)(lds + 154112);
    const int tid = opaque_tid(), lane = tid & 63, wave = __builtin_amdgcn_readfirstlane(tid >> 6), i16 = lane & 15, quad = lane >> 4;
    for (int u = wg; u < 4096; u += G) {
        const int b = u >> 11, h = (u >> 8) & 7, n = u & 255; const size_t t0 = (size_t)b * SEQ + (size_t)n * 64;
        bf16_t* projw = proj + t0 * 4096;
        __syncthreads();
        float be_pre = 0.f, gg_pre = 0.f;
        if (wave == 0) { const float* bgp = bg + (t0 + lane) * 16; be_pre = bgp[h]; gg_pre = bgp[8 + h]; }
        if (tid < 384) { const int mat = tid >> 7, d = tid & 127, col = mat * DM + h * HD + d;
            const float w0 = cw[col], w1 = cw[3072 + col], w2 = cw[2 * 3072 + col], w3 = cw[3 * 3072 + col];
            float x3 = 0.f, x2 = 0.f, x1 = 0.f;
            if (n > 0) { const bf16_t* hp = halo + ((t0 >> 6) - 1) * 3 * 3072 + col; x3 = bf2f(hp[0]); x2 = bf2f(hp[3072]); x1 = bf2f(hp[2 * 3072]); }
            const bf16_t* src = proj + t0 * 4096 + col; unsigned off = 0; bf16_t raw[64];
#pragma unroll
            for (int i = 0; i < 64; ++i) { raw[i] = src[off]; off += 4096; asm volatile("" : "+v"(off)); }
            __builtin_amdgcn_sched_barrier(0);
            LAS float* dst = (mat == 0 ? qL : (mat == 1 ? kL : vL)) + d;
#pragma unroll
            for (int i = 0; i < 64; ++i) { const float x0 = bf2f(raw[i]); dst[i * 132] = silu_f(w3 * x0 + w2 * x1 + w1 * x2 + w0 * x3); x3 = x2; x2 = x1; x1 = x0; } }
        __syncthreads();
#pragma unroll 4
        for (int rr = 0; rr < 16; ++rr) { const int r = wave * 16 + rr; LAS float* rowp = (r < 64 ? qL + r * 132 : kL + (r - 64) * 132) + 2 * lane;
            f32x2 v = *(LAS f32x2*)rowp; const float ss = wave_sum(v.x * v.x + v.y * v.y); const float scl = __builtin_amdgcn_rsqf(ss + EPS) * (r < 64 ? 0.08838834764831845f : 1.0f); v = v * scl; *(LAS f32x2*)rowp = v;
            *(LAS unsigned*)((r < 64 ? Qb : Kb) + (r & 63) * 272 + lane * 4) = cvt_pk_bf16(v.x, v.y); }
        if (wave == 0) { const float be = be_pre; float gg = gg_pre;
#pragma unroll
            for (int o = 1; o < 64; o <<= 1) { const float y = __shfl_up(gg, o); if (lane >= o) gg += y; }
            betaL[lane] = be; gcL[lane] = gg; gcum[(size_t)u * 64 + lane] = gg; }
        __syncthreads();
        {
            const int mat = wave >> 2, rb = wave & 3; const LAS unsigned char* Xb = mat ? Qb : Kb;
            bf16x8 af[4];
#pragma unroll
            for (int ks = 0; ks < 4; ++ks) af[ks] = *(const LAS bf16x8*)(Xb + (16 * rb + i16) * 272 + (32 * ks + 8 * quad) * 2);
            float gr[4], br[4];
#pragma unroll
            for (int jj = 0; jj < 4; ++jj) { gr[jj] = gcL[16 * rb + 4 * quad + jj]; br[jj] = betaL[16 * rb + 4 * quad + jj]; }
#pragma unroll
            for (int cb = 0; cb < 4; ++cb) {
                f32x4 acc = (f32x4){0.f, 0.f, 0.f, 0.f};
                if (cb <= rb) {
#pragma unroll
                    for (int ks = 0; ks < 4; ++ks) acc = __builtin_amdgcn_mfma_f32_16x16x32_bf16(af[ks], *(const LAS bf16x8*)(Kb + (16 * cb + i16) * 272 + (32 * ks + 8 * quad) * 2), acc, 0, 0, 0); }
                const int j = 16 * cb + i16; const float gj = gcL[j];
                const int pj = 32 * (cb >> 1) + 8 * (i16 >> 2) + 4 * (cb & 1) + (i16 & 3);
#pragma unroll
                for (int jj = 0; jj < 4; ++jj) { const int r = 16 * rb + 4 * quad + jj; const float dec = (j <= r) ? __expf(gr[jj] - gj) : 0.f;
                    if (mat == 0) AL[r * 68 + j] = (j < r) ? acc[jj] * br[jj] * dec : 0.f;
                    else *(LAS bf16_t*)(lds + 154112 + ((((r >> 4) * 2 + (pj >> 5)) * 64 + ((pj >> 3) & 3) * 16 + (r & 15)) * 8 + (pj & 7)) * 2) = f2bf((j <= r) ? acc[jj] * dec : 0.f); }
            }
        }
        __syncthreads();
        *(u32x4*)(attn + (size_t)u * 4096 + tid * 8) = *(const LAS u32x4*)(lds + 154112 + tid * 16);
#pragma unroll
        for (int k = 0; k < 2; ++k) { const int pi = tid + 512 * k, l_ = pi & 63, i_ = l_ & 15, q_ = l_ >> 4;
            { const int rb_ = pi >> 8, ks_ = (pi >> 6) & 3;
              *(u32x4*)(projw + (size_t)(pi >> 4) * 4096 + h * HD + (pi & 15) * 8) = *(const LAS u32x4*)(Qb + (16 * rb_ + i_) * 272 + (32 * ks_ + 8 * q_) * 2); }
            { const int w_ = pi >> 7, ks_ = (pi >> 6) & 1, dk = 16 * w_ + i_, p0 = 32 * ks_ + 8 * q_; float kv[8];
#pragma unroll
              for (int e = 0; e < 8; ++e) { const int tok = 16 * (2 * (p0 >> 5) + (e >> 2)) + 4 * ((p0 >> 3) & 3) + (e & 3); kv[e] = kL[tok * 132 + dk]; }
              u32x4 w; w.x = cvt_pk_bf16(kv[0], kv[1]); w.y = cvt_pk_bf16(kv[2], kv[3]); w.z = cvt_pk_bf16(kv[4], kv[5]); w.w = cvt_pk_bf16(kv[6], kv[7]);
              *(u32x4*)(projw + (size_t)(pi >> 4) * 4096 + DM + h * HD + (pi & 15) * 8) = w; } }
#pragma unroll
        for (int it = 0; it < 8; ++it) { const int p = tid + 512 * it, row = p >> 6, d = (p & 63) * 2;
            const f32x2 kv = *(LAS f32x2*)(kL + row * 132 + d), vv = *(LAS f32x2*)(vL + row * 132 + d);
            const float be = betaL[row], eg = __expf(gcL[row]);
            *(LAS f32x2*)(qL + row * 132 + d) = kv * (be * eg); *(LAS f32x2*)(vL + row * 132 + d) = vv * be; }
        __syncthreads();
        {
            { const int blk = lane >> 4, c = lane & 15; float y[16];
#pragma unroll
              for (int r = 0; r < 16; ++r) y[r] = (r == c) ? 1.0f : 0.0f;
#pragma unroll
              for (int r = 1; r < 16; ++r) { float s = 0.f;
#pragma unroll
                  for (int j4 = 0; j4 <= (r - 1) / 4; ++j4) { const f32x4 a4 = *(const LAS f32x4*)(AL + (16 * blk + r) * 68 + 16 * blk + 4 * j4);
                      s += a4[0] * y[4 * j4] + a4[1] * y[4 * j4 + 1] + a4[2] * y[4 * j4 + 2] + a4[3] * y[4 * j4 + 3]; }
                  y[r] -= s; }
#pragma unroll
              for (int r = 0; r < 16; ++r) DinvL[(16 * blk + r) * 16 + c] = y[r]; }
            LAS float* Xm = (wave < 4 ? vL : qL) + 32 * (wave & 3) + i16;
#pragma unroll 1
            for (int bi = 0; bi < 4; ++bi)
#pragma unroll 1
                for (int cbl = 0; cbl < 2; ++cbl) {
                    LAS float* Xc = Xm + 16 * cbl; f32x4 acc;
#pragma unroll
                    for (int jj = 0; jj < 4; ++jj) acc[jj] = Xc[(16 * bi + 4 * quad + jj) * 132];
#pragma unroll 1
                    for (int k = 0; k < bi; ++k)
#pragma unroll
                        for (int ks = 0; ks < 4; ++ks) acc = __builtin_amdgcn_mfma_f32_16x16x4f32(-AL[(16 * bi + i16) * 68 + 16 * k + 4 * ks + quad], Xc[(16 * k + 4 * ks + quad) * 132], acc, 0, 0, 0);
#pragma unroll
                    for (int jj = 0; jj < 4; ++jj) Xc[(16 * bi + 4 * quad + jj) * 132] = acc[jj];
                    f32x4 acc2 = (f32x4){0.f, 0.f, 0.f, 0.f};
#pragma unroll
                    for (int ks = 0; ks < 4; ++ks) acc2 = __builtin_amdgcn_mfma_f32_16x16x4f32(DinvL[(16 * bi + i16) * 16 + 4 * ks + quad], Xc[(16 * bi + 4 * ks + quad) * 132], acc2, 0, 0, 0);
#pragma unroll
                    for (int jj = 0; jj < 4; ++jj) Xc[(16 * bi + 4 * quad + jj) * 132] = acc2[jj];
                }
        }
        __syncthreads();
#pragma unroll
        for (int k = 0; k < 2; ++k) { const int pi = tid + 512 * k, q_ = pi & 3, l_ = (pi >> 2) & 63, rb_ = pi >> 8, tok = 16 * rb_ + 4 * (l_ >> 4), col = 32 * q_ + (l_ & 15);
            float uv[8];
#pragma unroll
            for (int e = 0; e < 8; ++e) uv[e] = vL[(tok + (e & 3)) * 132 + col + 16 * (e >> 2)];
            u32x4 w; w.x = cvt_pk_bf16(uv[0], uv[1]); w.y = cvt_pk_bf16(uv[2], uv[3]); w.z = cvt_pk_bf16(uv[4], uv[5]); w.w = cvt_pk_bf16(uv[6], uv[7]);
            *(u32x4*)(projw + (size_t)(pi >> 4) * 4096 + 2 * DM + h * HD + (pi & 15) * 8) = w; }
#pragma unroll
        for (int k = 0; k < 2; ++k) { const int pi = tid + 512 * k, l_ = pi & 63, rb_ = pi >> 8, ks_ = (pi >> 6) & 3;
            const LAS f32x4* wp = (const LAS f32x4*)(qL + (16 * rb_ + (l_ & 15)) * 132 + 32 * ks_ + 8 * (l_ >> 4)); const f32x4 a = wp[0], c = wp[1];
            u32x4 w; w.x = cvt_pk_bf16(a[0], a[1]); w.y = cvt_pk_bf16(a[2], a[3]); w.z = cvt_pk_bf16(c[0], c[1]); w.w = cvt_pk_bf16(c[2], c[3]);
            *(u32x4*)(wbuf + (t0 + (pi >> 4)) * DM + h * HD + (pi & 15) * 8) = w; }
    }
}
constexpr size_t DO_GP = 64 * MiB, DO_GQ = 72 * MiB, DO_GS = 88 * MiB;
#define GS_BAR() do { asm volatile("s_waitcnt lgkmcnt(0)" ::: "memory"); __builtin_amdgcn_s_barrier(); asm volatile("" ::: "memory"); } while (0)
__device__ __forceinline__ u32x2 packsoft4(f32x4 v) { u32x2 w; w.x = (unsigned)f2bf(v[0]) | ((unsigned)f2bf(v[1]) << 16); w.y = (unsigned)f2bf(v[2]) | ((unsigned)f2bf(v[3]) << 16); return w; }
__device__ __forceinline__ void phase_gdn_scanA(const Params& P, LAS unsigned char* lds, int wg, int G) {
    const bf16_t* proj = (const bf16_t*)(P.ws + WS_S + S_GDN_PROJ); const float* gcum = (const float*)(P.ws + WS_S + S_GDN_GC); const bf16_t* wbuf = (const bf16_t*)P.out;
    bf16_t* GP = (bf16_t*)((unsigned char*)P.out + DO_GP); float* GQ = (float*)((unsigned char*)P.out + DO_GQ);
    const int tid = opaque_tid(), lane = tid & 63, wave = __builtin_amdgcn_readfirstlane(tid >> 6), i16 = lane & 15, quad = lane >> 4, rb = wave & 3, hf = wave >> 2;
    LAS unsigned char* ST = lds; LAS unsigned char* VN2 = lds + 69632;
    const int p0 = 32 * (rb >> 1) + 8 * quad + 4 * (rb & 1);
    for (int task = wg; task < 256; task += G) {
        const int bh = task >> 4, g = task & 15, b = bh >> 3, h = bh & 7; const size_t t0 = (size_t)b * SEQ + (size_t)g * 1024, u0 = (size_t)bh * 256 + (size_t)g * 16;
        f32x4 sacc[16]; int dgo = i16 - 4 * quad; asm volatile("" : "+v"(dgo));
#pragma unroll
        for (int cb = 0; cb < 16; ++cb)
#pragma unroll
            for (int jj = 0; jj < 4; ++jj) sacc[cb][jj] = (cb < 8 && cb == wave && dgo == jj) ? 1.0f : 0.0f;
        __syncthreads();
#pragma unroll
        for (int cb = 0; cb < 16; ++cb) *(LAS u32x2*)(ST + (16 * cb + i16) * 272 + (16 * wave + 4 * quad) * 2) = pack4(sacc[cb]);
        const char* pA = (const char*)(wbuf + (t0 + 16 * rb + quad) * DM + h * HD + 8 * i16);
        const char* pK = (const char*)(proj + (t0 + 8 * wave + quad) * 4096 + DM + h * HD + 8 * i16);
        const char* pU = (const char*)(proj + (t0 + 16 * rb + (lane >> 2)) * 4096 + 2 * DM + h * HD + (lane & 3) * 32);
        const char* pG = (const char*)(gcum + u0 * 64 + 16 * rb + 4 * quad); const char* pGl = (const char*)(gcum + u0 * 64 + 63);
        bf16x8 fa[2][4], fk[2][2]; u32x4 uu[2][4]; f32x4 g4[2]; float gl[2];
#define GA_LOAD_A(S) do { _Pragma("unroll") for (int ks_ = 0; ks_ < 4; ++ks_) fa[S][ks_] = *(const bf16x8*)(pA + (size_t)ks_ * (4 * DM * 2)); \
        if (hf) { _Pragma("unroll") for (int q_ = 0; q_ < 4; ++q_) uu[S][q_] = *(const u32x4*)(pU + q_ * 16); } \
        g4[S] = *(const f32x4*)pG; gl[S] = *(const float*)pGl; pA += 64 * DM * 2; pU += 64 * 8192; pG += 256; pGl += 256; } while (0)
#define GA_LOAD_B(S) do { _Pragma("unroll") for (int ks_ = 0; ks_ < 2; ++ks_) fk[S][ks_] = *(const bf16x8*)(pK + (size_t)ks_ * 32768); pK += 64 * 8192; } while (0)
#pragma unroll
        for (int s_ = 0; s_ < 2; ++s_)
#pragma unroll
            for (int q_ = 0; q_ < 4; ++q_) uu[s_][q_] = (u32x4){0u, 0u, 0u, 0u};
        GA_LOAD_A(0); GA_LOAD_B(0); GA_LOAD_A(1); GA_LOAD_B(1);
        GS_BAR();
#define GA_STEP(nn, S) do { \
        const float glast_ = gl[S]; f32x4 ed_; \
        _Pragma("unroll") for (int jj_ = 0; jj_ < 4; ++jj_) ed_[jj_] = __expf(glast_ - g4[S][jj_]); \
        _Pragma("unroll") for (int c4_ = 0; c4_ < 8; c4_ += 4) { f32x4 acc1[4];        \
            _Pragma("unroll") for (int c_ = 0; c_ < 4; ++c_) { acc1[c_] = (f32x4){0.f, 0.f, 0.f, 0.f}; \
                _Pragma("unroll") for (int ks_ = 0; ks_ < 4; ++ks_) acc1[c_] = __builtin_amdgcn_mfma_f32_16x16x32_bf16(fa[S][ks_], *(const LAS bf16x8*)(ST + (16 * (8 * hf + c4_ + c_) + i16) * 272 + (32 * ks_ + 8 * quad) * 2), acc1[c_], 0, 0, 0); } \
            _Pragma("unroll") for (int c_ = 0; c_ < 4; ++c_) { const int cc_ = c4_ + c_; const unsigned ua_ = uu[S][cc_ >> 1][2 * (cc_ & 1)], ub_ = uu[S][cc_ >> 1][2 * (cc_ & 1) + 1]; f32x4 vn2_; \
                vn2_[0] = (bf_lo(ua_) - acc1[c_][0]) * ed_[0]; vn2_[1] = (bf_hi(ua_) - acc1[c_][1]) * ed_[1]; vn2_[2] = (bf_lo(ub_) - acc1[c_][2]) * ed_[2]; vn2_[3] = (bf_hi(ub_) - acc1[c_][3]) * ed_[3]; \
                *(LAS u32x2*)(VN2 + (16 * (8 * hf + cc_) + i16) * 144 + p0 * 2) = pack4(vn2_); } \
            asm volatile("" ::: "memory"); } \
        if ((nn) + 2 < 16) GA_LOAD_A(S); \
        GS_BAR(); \
        const float eg_ = __expf(glast_); \
        _Pragma("unroll") for (int cb_ = 0; cb_ < 16; ++cb_) { f32x4 acc_ = sacc[cb_] * eg_; \
            _Pragma("unroll") for (int ks_ = 0; ks_ < 2; ++ks_) acc_ = __builtin_amdgcn_mfma_f32_16x16x32_bf16(fk[S][ks_], *(const LAS bf16x8*)(VN2 + (16 * cb_ + i16) * 144 + (32 * ks_ + 8 * quad) * 2), acc_, 0, 0, 0); \
            sacc[cb_] = acc_; *(LAS u32x2*)(ST + (16 * cb_ + i16) * 272 + (16 * wave + 4 * quad) * 2) = packsoft4(acc_); \
            if ((cb_ & 3) == 3) asm volatile("" ::: "memory"); } \
        if ((nn) + 2 < 16) GA_LOAD_B(S); \
        GS_BAR(); } while (0)
#pragma unroll 1
        for (int n = 0; n < 16; n += 2) { GA_STEP(n, 0); GA_STEP(n + 1, 1); }
#undef GA_STEP
#undef GA_LOAD_A
#undef GA_LOAD_B
#pragma unroll
        for (int cb = 0; cb < 8; ++cb)
#pragma unroll
            for (int jj = 0; jj < 4; ++jj) GP[(size_t)task * 16384 + (16 * wave + 4 * quad + jj) * 128 + 16 * cb + i16] = f2bf(sacc[cb][jj]);
#pragma unroll
        for (int cb = 0; cb < 8; ++cb) *(f32x4*)(GQ + (((size_t)task * 8 + wave) * 64 + lane) * 32 + cb * 4) = sacc[8 + cb];
    }
}
__device__ __forceinline__ void phase_gdn_scanB(const Params& P, LAS unsigned char* lds, int wg, int G) {
    const int bh = (G % 8 == 0 && G >= 16) ? (wg >> 3) + 2 * (wg & 7) : wg;
    if ((G % 8 == 0 && G >= 16) ? (wg >> 3) >= 2 : wg >= 16) return;
    const bf16_t* GP = (const bf16_t*)((const unsigned char*)P.out + DO_GP); const float* GQ = (const float*)((const unsigned char*)P.out + DO_GQ); float* GS = (float*)((unsigned char*)P.out + DO_GS);
    const int tid = opaque_tid(), lane = tid & 63, wave = __builtin_amdgcn_readfirstlane(tid >> 6), i16 = lane & 15, quad = lane >> 4;
    LAS unsigned char* ST = lds;
    f32x4 sacc[8];
#pragma unroll
    for (int cb = 0; cb < 8; ++cb) sacc[cb] = (f32x4){0.f, 0.f, 0.f, 0.f};
    bf16x8 fp[2][4]; f32x4 qg[2][8];
#define GB_LOAD(S, gg) do { const size_t tk_ = (size_t)bh * 16 + (gg); \
        _Pragma("unroll") for (int ks_ = 0; ks_ < 4; ++ks_) fp[S][ks_] = *(const bf16x8*)(GP + tk_ * 16384 + (16 * wave + i16) * 128 + 32 * ks_ + 8 * quad); \
        _Pragma("unroll") for (int cb_ = 0; cb_ < 8; ++cb_) qg[S][cb_] = *(const f32x4*)(GQ + ((tk_ * 8 + wave) * 64 + lane) * 32 + cb_ * 4); } while (0)
    GB_LOAD(0, 0); GB_LOAD(1, 1);
    __syncthreads();
#define GB_STEP(g, S) do { const size_t task = (size_t)bh * 16 + (g); \
        _Pragma("unroll") for (int cb_ = 0; cb_ < 8; ++cb_) *(f32x4*)(GS + ((task * 8 + wave) * 64 + lane) * 32 + cb_ * 4) = sacc[cb_];          \
        if ((g) < 15) { \
            _Pragma("unroll") for (int cb_ = 0; cb_ < 8; ++cb_) *(LAS u32x2*)(ST + (16 * cb_ + i16) * 272 + (16 * wave + 4 * quad) * 2) = pack4(sacc[cb_] + (f32x4){0.f, 0.f, 0.f, 0.f}); \
            GS_BAR(); \
            _Pragma("unroll") for (int cb_ = 0; cb_ < 8; ++cb_) { f32x4 acc_ = qg[S][cb_]; \
                _Pragma("unroll") for (int ks_ = 0; ks_ < 4; ++ks_) acc_ = __builtin_amdgcn_mfma_f32_16x16x32_bf16(fp[S][ks_], *(const LAS bf16x8*)(ST + (16 * cb_ + i16) * 272 + (32 * ks_ + 8 * quad) * 2), acc_, 0, 0, 0); \
                sacc[cb_] = acc_; } \
            if ((g) + 2 < 15) GB_LOAD(S, (g) + 2); \
            GS_BAR(); } } while (0)
#pragma unroll 1
    for (int g = 0; g < 16; g += 2) { GB_STEP(g, 0); GB_STEP(g + 1, 1); }
#undef GB_STEP
#undef GB_LOAD
}
__device__ __forceinline__ void phase_gdn_scanC(const Params& P, LAS unsigned char* lds, int wg, int G) {
    bf16_t* proj = (bf16_t*)(P.ws + WS_S + S_GDN_PROJ); const bf16_t* attn = (const bf16_t*)(P.ws + WS_S + S_GDN_ATTN); const float* gcum = (const float*)(P.ws + WS_S + S_GDN_GC); const bf16_t* wbuf = (const bf16_t*)P.out;
    const float* GS = (const float*)((const unsigned char*)P.out + DO_GS);
    const int tid = opaque_tid(), lane = tid & 63, wave = __builtin_amdgcn_readfirstlane(tid >> 6), i16 = lane & 15, quad = lane >> 4, rb = wave & 3;
    LAS unsigned char* ST = lds; LAS unsigned char* VN = lds + 34816; LAS unsigned char* VN2 = lds + 53248; LAS unsigned char* OL = lds + 71680; LAS float* WN = (LAS float*)(lds + 89088);
    const int p0 = 32 * (rb >> 1) + 8 * quad + 4 * (rb & 1);
    for (int task = wg; task < 256; task += G) {
        const int bh = task >> 4, g = task & 15, b = bh >> 3, h = bh & 7; const size_t t0 = (size_t)b * SEQ + (size_t)g * 1024, u0 = (size_t)bh * 256 + (size_t)g * 16;
        f32x4 sacc[8];
#pragma unroll
        for (int cb = 0; cb < 8; ++cb) sacc[cb] = *(const f32x4*)(GS + (((size_t)task * 8 + wave) * 64 + lane) * 32 + cb * 4);
        __syncthreads();
#pragma unroll
        for (int cb = 0; cb < 8; ++cb) *(LAS u32x2*)(ST + (16 * cb + i16) * 272 + (16 * wave + 4 * quad) * 2) = pack4(sacc[cb] + (f32x4){0.f, 0.f, 0.f, 0.f});
        const char* pA = (wave < 4) ? (const char*)(wbuf + (t0 + 16 * rb + quad) * DM + h * HD + 8 * i16) : (const char*)(proj + (t0 + 16 * rb + quad) * 4096 + h * HD + 8 * i16);
        const size_t ksA = (wave < 4) ? (size_t)4 * DM * 2 : (size_t)4 * 4096 * 2, stA = (wave < 4) ? (size_t)64 * DM * 2 : (size_t)64 * 4096 * 2;
        const char* pK = (const char*)(proj + (t0 + 8 * wave + quad) * 4096 + DM + h * HD + 8 * i16);
        const char* pU = (const char*)(proj + (t0 + 16 * rb + (lane >> 2)) * 4096 + 2 * DM + h * HD + (lane & 3) * 32);
        const char* pT = (const char*)(attn + u0 * 4096 + (size_t)(rb * 128 + lane) * 8);
        const char* pG = (const char*)(gcum + u0 * 64 + 16 * rb + 4 * quad); const char* pGl = (const char*)(gcum + u0 * 64 + 63);
        bf16_t* pO = proj + (t0 + (tid >> 4)) * 4096 + 2 * DM + h * HD + (tid & 15) * 8;
        bf16x8 fa[2][4], fk[2][2], ft[2][2]; u32x4 uu[2][4], zr[2]; f32x4 g4[2]; float gl[2];
        if (tid < 128) WN[tid] = P.in[IN_GDN_NORM][tid];
#define GC_LOAD_A(S) do { _Pragma("unroll") for (int ks_ = 0; ks_ < 4; ++ks_) fa[S][ks_] = *(const bf16x8*)(pA + (size_t)ks_ * ksA); \
        if (wave < 4) { _Pragma("unroll") for (int q_ = 0; q_ < 4; ++q_) uu[S][q_] = *(const u32x4*)(pU + q_ * 16); } \
        g4[S] = *(const f32x4*)pG; gl[S] = *(const float*)pGl; pA += stA; pU += 64 * 8192; pG += 256; pGl += 256; } while (0)
#define GC_LOAD_B(S) do { _Pragma("unroll") for (int ks_ = 0; ks_ < 2; ++ks_) fk[S][ks_] = *(const bf16x8*)(pK + (size_t)ks_ * 32768); \
        if (wave >= 4) { _Pragma("unroll") for (int ks_ = 0; ks_ < 2; ++ks_) ft[S][ks_] = *(const bf16x8*)(pT + ks_ * 1024); } \
        pK += 64 * 8192; pT += 8192; } while (0)
#pragma unroll
        for (int s_ = 0; s_ < 2; ++s_) {
#pragma unroll
            for (int q_ = 0; q_ < 4; ++q_) uu[s_][q_] = (u32x4){0u, 0u, 0u, 0u};
#pragma unroll
            for (int q_ = 0; q_ < 2; ++q_) ft[s_][q_] = (bf16x8){0, 0, 0, 0, 0, 0, 0, 0}; }
        GC_LOAD_A(0); GC_LOAD_B(0); GC_LOAD_A(1); GC_LOAD_B(1);
        GS_BAR();
#define GC_ZLOAD(nn) do { _Pragma("unroll") for (int k_ = 0; k_ < 2; ++k_) zr[k_] = *(const u32x4*)(pO + DM + ((size_t)(nn) * 64 + 32 * k_) * 4096); } while (0)
#define GC_OSTORE(nn) do { _Pragma("unroll") for (int k_ = 0; k_ < 2; ++k_) { const u32x4 ov_ = *(const LAS u32x4*)(OL + ((tid >> 4) + 32 * k_) * 272 + (tid & 15) * 16); const u32x4 zv_ = zr[k_]; \
            float o_[8], z_[8]; _Pragma("unroll") for (int e_ = 0; e_ < 4; ++e_) { o_[2 * e_] = bf_lo(ov_[e_]); o_[2 * e_ + 1] = bf_hi(ov_[e_]); z_[2 * e_] = bf_lo(zv_[e_]); z_[2 * e_ + 1] = bf_hi(zv_[e_]); } \
            float ss_ = 0.f; _Pragma("unroll") for (int e_ = 0; e_ < 8; ++e_) ss_ += o_[e_] * o_[e_]; \
            ss_ += __shfl_xor(ss_, 1); ss_ += __shfl_xor(ss_, 2); ss_ += __shfl_xor(ss_, 4); ss_ += __shfl_xor(ss_, 8); \
            const float r_ = __builtin_amdgcn_rsqf(ss_ * (1.0f / HD) + EPS); const f32x4 wa_ = *(const LAS f32x4*)(WN + (tid & 15) * 8), wb_ = *(const LAS f32x4*)(WN + (tid & 15) * 8 + 4); \
            u32x4 w_; w_.x = cvt_pk_bf16(o_[0] * r_ * wa_[0] * silu_f(z_[0]), o_[1] * r_ * wa_[1] * silu_f(z_[1])); w_.y = cvt_pk_bf16(o_[2] * r_ * wa_[2] * silu_f(z_[2]), o_[3] * r_ * wa_[3] * silu_f(z_[3])); \
            w_.z = cvt_pk_bf16(o_[4] * r_ * wb_[0] * silu_f(z_[4]), o_[5] * r_ * wb_[1] * silu_f(z_[5])); w_.w = cvt_pk_bf16(o_[6] * r_ * wb_[2] * silu_f(z_[6]), o_[7] * r_ * wb_[3] * silu_f(z_[7])); \
            *(u32x4*)(pO + ((size_t)(nn) * 64 + 32 * k_) * 4096) = w_; } } while (0)
#define GC_STEP(nn, S) do { \
        if ((nn) > 0) GC_OSTORE((nn) - 1); \
        GC_ZLOAD(nn); \
        f32x4 acc1[8]; \
        _Pragma("unroll") for (int c_ = 0; c_ < 8; ++c_) { acc1[c_] = (f32x4){0.f, 0.f, 0.f, 0.f}; \
            _Pragma("unroll") for (int ks_ = 0; ks_ < 4; ++ks_) acc1[c_] = __builtin_amdgcn_mfma_f32_16x16x32_bf16(fa[S][ks_], *(const LAS bf16x8*)(ST + (16 * c_ + i16) * 272 + (32 * ks_ + 8 * quad) * 2), acc1[c_], 0, 0, 0); } \
        const float glast_ = gl[S]; const f32x4 gv_ = g4[S]; \
        if (wave < 4) { f32x4 ed_; \
            _Pragma("unroll") for (int jj_ = 0; jj_ < 4; ++jj_) ed_[jj_] = __expf(glast_ - gv_[jj_]); \
            _Pragma("unroll") for (int c_ = 0; c_ < 8; ++c_) { const unsigned ua_ = uu[S][c_ >> 1][2 * (c_ & 1)], ub_ = uu[S][c_ >> 1][2 * (c_ & 1) + 1]; f32x4 vn_; \
                vn_[0] = bf_lo(ua_) - acc1[c_][0]; vn_[1] = bf_hi(ua_) - acc1[c_][1]; vn_[2] = bf_lo(ub_) - acc1[c_][2]; vn_[3] = bf_hi(ub_) - acc1[c_][3]; \
                *(LAS u32x2*)(VN + (16 * c_ + i16) * 144 + p0 * 2) = pack4(vn_); *(LAS u32x2*)(VN2 + (16 * c_ + i16) * 144 + p0 * 2) = pack4(vn_ * ed_); } } \
        if ((nn) + 2 < 16) GC_LOAD_A(S); \
        GS_BAR(); \
        if (wave >= 4) { f32x4 eg4_; \
            _Pragma("unroll") for (int jj_ = 0; jj_ < 4; ++jj_) eg4_[jj_] = __expf(gv_[jj_]); \
            _Pragma("unroll") for (int c_ = 0; c_ < 8; ++c_) { f32x4 acco_ = acc1[c_] * eg4_; \
                _Pragma("unroll") for (int ks_ = 0; ks_ < 2; ++ks_) acco_ = __builtin_amdgcn_mfma_f32_16x16x32_bf16(ft[S][ks_], *(const LAS bf16x8*)(VN + (16 * c_ + i16) * 144 + (32 * ks_ + 8 * quad) * 2), acco_, 0, 0, 0); \
                _Pragma("unroll") for (int jj_ = 0; jj_ < 4; ++jj_) *(LAS bf16_t*)(OL + (16 * rb + 4 * quad + jj_) * 272 + (16 * c_ + i16) * 2) = f2bf(acco_[jj_]); } } \
        { const float eg_ = __expf(glast_); \
          _Pragma("unroll") for (int cb_ = 0; cb_ < 8; ++cb_) { f32x4 acc_ = sacc[cb_] * eg_; \
              _Pragma("unroll") for (int ks_ = 0; ks_ < 2; ++ks_) acc_ = __builtin_amdgcn_mfma_f32_16x16x32_bf16(fk[S][ks_], *(const LAS bf16x8*)(VN2 + (16 * cb_ + i16) * 144 + (32 * ks_ + 8 * quad) * 2), acc_, 0, 0, 0); \
              sacc[cb_] = acc_; *(LAS u32x2*)(ST + (16 * cb_ + i16) * 272 + (16 * wave + 4 * quad) * 2) = packsoft4(acc_); } } \
        if ((nn) + 2 < 16) GC_LOAD_B(S); \
        GS_BAR(); } while (0)
#pragma unroll 1
        for (int n = 0; n < 16; n += 2) { GC_STEP(n, 0); GC_STEP(n + 1, 1); }
        GC_OSTORE(15);
#undef GC_STEP
#undef GC_OSTORE
#undef GC_ZLOAD
#undef GC_LOAD_A
#undef GC_LOAD_B
    }
}

constexpr int NPHASES = 39;
__global__ void __launch_bounds__(512, 2) fwd_kernel(Params P0) {
    extern __shared__ __attribute__((aligned(16))) unsigned char lds_raw[];
    LAS unsigned char* lds = (LAS unsigned char*)lds_raw;
    const int tid = threadIdx.x, wg = blockIdx.x, G = gridDim.x;
    volatile LAS unsigned* bw = (volatile LAS unsigned*)(lds + LDS_BARW);
    if (tid < 4) bw[tid] = 0u;
    __syncthreads();
    const int lo = P0.ph_lo, hi = P0.ph_hi;
    XcdBarrier bar; bar.bar = (unsigned*)(P0.ws + WS_CTL); bar.x = 0; bar.st = bw;
    if (hi - lo > 1) bar = xcd_barrier_post((unsigned*)(P0.ws + WS_CTL), bw);
    u64_t* ssq_base = (u64_t*)(P0.ws + WS_SSQ);
    bf16_t* xb = (bf16_t*)(P0.ws + WS_XB);
    const bf16_t* Wb = (const bf16_t*)(P0.ws + WS_W);
    int ph = 0;
#define PH_BEGIN if (ph >= lo && ph < hi) { const Params& P = P0;
#define PH_END if (ph + 1 < hi) xcd_barrier(bar); } ++ph;
    PH_BEGIN phase_prologue(P, lds, wg, G); PH_END
    for (int it = 0; it < 8; ++it) {
        const int L = it >> 1, sub = it & 1, kind = L % 3, mj = L / 3;
        if (sub == 0) {
            PH_BEGIN
                pg8::Gemm g; pg8::EpiIn E; g.A = xb; g.M = T_TOK; g.K = DM; g.lda = DM; E.ssq = ssq_base + (size_t)(2 * L) * T_TOK; E.halo = nullptr;
                if (kind == 0) { g.Bt = (const bf16_t*)((const unsigned char*)Wb + (mj == 0 ? W_MOBA_QKV0 : W_MOBA_QKV1)); g.N = 3072; E.O = (bf16_t*)(P.ws + WS_S + S_MOBA_QKV); E.ldc = 3072; }
                else if (kind == 1) { g.Bt = (const bf16_t*)((const unsigned char*)Wb + W_SC_IN); g.N = 3072; E.O = (bf16_t*)(P.ws + WS_S + S_SC_PROJ); E.ldc = 3072; }
                else { g.Bt = (const bf16_t*)((const unsigned char*)Wb + W_GDN_IN); g.N = 4096; E.O = (bf16_t*)(P.ws + WS_S + S_GDN_PROJ); E.ldc = 4096; E.halo = (bf16_t*)(P.ws + WS_S + S_GDN_HALO); }
                pg8::StaticOrder S; S.init(g.M, g.N, G, wg);
                pg8::gemm_phase<pg8::EpiIn, false>(lds, g, S, E);
                if (kind == 2) phase_gdn_bg(P, wg, G);
            PH_END
            if (kind == 0) {
                PH_BEGIN phase_moba_kmean_vt(P, lds, wg, G); PH_END
                PH_BEGIN phase_moba_gate2(P, lds, mj, wg, G); PH_END
                for (int b = 0; b < 2; ++b) {
                    PH_BEGIN phase_moba_gather(P, lds, mj, b, wg, G); PH_END
                    PH_BEGIN phase_moba_own(P, lds, b, wg, G); PH_END
                }
            } else if (kind == 1) {
                PH_BEGIN phase_sconv(P, wg, G); PH_END
            } else {
                PH_BEGIN phase_gdn_chunk2(P, lds, wg, G); PH_END
                PH_BEGIN phase_gdn_scanA(P, lds, wg, G); PH_END
                PH_BEGIN phase_gdn_scanB(P, lds, wg, G); PH_END
                PH_BEGIN phase_gdn_scanC(P, lds, wg, G); PH_END
            }
        } else {
            PH_BEGIN
                pg8::Gemm g; g.A = xb; g.Bt = (const bf16_t*)((const unsigned char*)Wb + W_FFN_UP + (size_t)L * W_FFN_UP_STRIDE); g.M = T_TOK; g.N = 2 * FFD; g.K = DM; g.lda = DM;
                pg8::EpiUp E; E.ACT = (bf16_t*)(P.ws + WS_S + S_FFN_ACT); E.halo = (float*)(P.ws + WS_S + S_FFN_HALO); E.cw = P.in[IN_FFN_CONV] + (size_t)L * 3 * (2 * FFD); E.ssq = ssq_base + (size_t)(2 * L + 1) * T_TOK;
                pg8::StaticOrder S; S.init(g.M, g.N, G, wg);
                pg8::gemm_phase<pg8::EpiUp, true>(lds, g, S, E);
            PH_END
            PH_BEGIN phase_ffn_fix(P, L, wg, G); PH_END
        }
        PH_BEGIN
            pg8::Gemm g; g.M = T_TOK; g.N = DM;
            if (sub == 1) { g.A = (const bf16_t*)(P.ws + WS_S + S_FFN_ACT); g.lda = FFD; g.K = FFD; g.Bt = (const bf16_t*)((const unsigned char*)Wb + W_FFN_DN + (size_t)L * W_FFN_DN_STRIDE); }
            else if (kind == 0) { g.A = (const bf16_t*)(P.ws + WS_S + S_MOBA_QKV); g.lda = 3072; g.K = DM; g.Bt = (const bf16_t*)((const unsigned char*)Wb + (mj == 0 ? W_MOBA_O0 : W_MOBA_O1)); }
            else if (kind == 1) { g.A = (const bf16_t*)(P.ws + WS_S + S_SC_Y); g.lda = DM; g.K = DM; g.Bt = (const bf16_t*)((const unsigned char*)Wb + W_SC_OUT); }
            else { g.A = (const bf16_t*)(P.ws + WS_S + S_GDN_PROJ) + 2 * DM; g.lda = 4096; g.K = DM; g.Bt = (const bf16_t*)((const unsigned char*)Wb + W_GDN_O); }
            pg8::EpiOut E; E.XB = xb; E.ssq_next = ssq_base + (size_t)(2 * L + 1 + sub) * T_TOK; E.ts = (LAS float*)(lds + 131072);
            pg8::StaticOrder S; S.init(g.M, g.N, G, wg);
            pg8::gemm_phase<pg8::EpiOut, false>(lds, g, S, E);
        PH_END
    }
    PH_BEGIN phase_final(P, wg, G); PH_END
#undef PH_BEGIN
#undef PH_END
}

extern "C" void kernel_launch(void* const* d_in, const int* in_sizes, int n_in, void* d_out, int out_size, void* d_ws, size_t ws_size, hipStream_t stream) {
    static int grid = 0;
    if (grid == 0) {
        if (n_in != 18 || out_size != T_TOK * DM || ws_size < WS_END) { fprintf(stderr, "kernel_launch: unexpected problem (n_in %d, out %d, ws %zu)\n", n_in, out_size, ws_size); grid = -1; return; }
        int dev = 0, cus = 0, per_cu = 0;
        if (hipGetDevice(&dev) != hipSuccess || hipDeviceGetAttribute(&cus, hipDeviceAttributeMultiprocessorCount, dev) != hipSuccess) { grid = -1; return; }
        if (hipFuncSetAttribute((const void*)fwd_kernel, hipFuncAttributeMaxDynamicSharedMemorySize, LDS_BYTES) != hipSuccess) { fprintf(stderr, "kernel_launch: hipFuncSetAttribute failed\n"); grid = -1; return; }
        if (hipOccupancyMaxActiveBlocksPerMultiprocessor(&per_cu, (const void*)fwd_kernel, 512, LDS_BYTES) != hipSuccess || per_cu < 1) { fprintf(stderr, "kernel_launch: occupancy query says %d blocks per CU\n", per_cu); (void)hipGetLastError(); }
        grid = cus;
    }
    if (grid < 0) return;
    (void)in_sizes;
    hipMemsetAsync((char*)d_ws + WS_CTL, 0, CTL_ZERO_BYTES, stream);
    Params p; memset(&p, 0, sizeof(p));
    for (int i = 0; i < 18; ++i) p.in[i] = (const float*)d_in[i];
    p.out = (float*)d_out; p.ws = (unsigned char*)d_ws;
#if MK_N_LAUNCHES == 1
    p.ph_lo = 0; p.ph_hi = NPHASES;
    hipLaunchKernelGGL(fwd_kernel, dim3(grid), dim3(512), LDS_BYTES, stream, p);
#else
    for (int li = 0; li < NPHASES; ++li) { p.ph_lo = li; p.ph_hi = li + 1; hipLaunchKernelGGL(fwd_kernel, dim3(grid), dim3(512), LDS_BYTES, stream, p); }
#endif
}
```

```cpp
#include <hip/hip_runtime.h>
#include <stdio.h>
#include <string.h>

#ifndef MK_N_LAUNCHES
#define MK_N_LAUNCHES 1
#endif

#define LAS __attribute__((address_space(3)))
typedef unsigned short bf16_t;
typedef short bf16x8 __attribute__((ext_vector_type(8)));
typedef float f32x4 __attribute__((ext_vector_type(4)));
typedef float f32x2 __attribute__((ext_vector_type(2)));
typedef unsigned u32x4 __attribute__((ext_vector_type(4)));
typedef unsigned u32x2 __attribute__((ext_vector_type(2)));

constexpr int T_TOK = 32768, SEQ = 16384, DM = 1024, FFD = 2816, NH = 8, HD = 128, NBLK = 64, BLK = 256;
constexpr float EPS = 1e-6f;
constexpr float LOG2E = 1.4426950408889634f, LN2 = 0.6931471805599453f;

constexpr size_t MiB = 1u << 20;
constexpr size_t WS_CTL = 0, CTL_ZERO_BYTES = 4 * MiB;
constexpr size_t CTL_CNT = 512 * 1024;
constexpr size_t WS_SSQ = 1 * MiB;
constexpr size_t WS_MISC = 6 * MiB;
constexpr size_t MISC_KMEAN = 0, MISC_BGW = 512 * 1024;
constexpr size_t WS_W = 7 * MiB;
constexpr size_t WS_XB = 107 * MiB;
constexpr size_t WS_S = 171 * MiB;
constexpr size_t WS_END = 512 * MiB;
constexpr size_t W_MOBA_QKV0 = 0, W_MOBA_QKV1 = 6 * MiB, W_MOBA_O0 = 12 * MiB, W_MOBA_O1 = 14 * MiB, W_SC_IN = 16 * MiB, W_SC_OUT = 22 * MiB,
                 W_GDN_IN = 24 * MiB, W_GDN_O = 32 * MiB, W_FFN_UP = 34 * MiB, W_FFN_UP_STRIDE = 11 * MiB, W_FFN_DN = 78 * MiB, W_FFN_DN_STRIDE = 5767168;
constexpr size_t S_MOBA_KN = 322 * MiB, S_MOBA_KMAX = 323 * MiB, S_MOBA_MASK = 324 * MiB;
constexpr size_t S_MOBA_QKV = 0, S_MOBA_PO = 192 * MiB, S_MOBA_LIST = 288 * MiB, S_MOBA_LSE = 320 * MiB;
constexpr size_t S_SC_PROJ = 0, S_SC_Y = 192 * MiB;
constexpr size_t S_GDN_PROJ = 0, S_GDN_ATTN = 256 * MiB, S_GDN_BG = 288 * MiB, S_GDN_HALO = 290 * MiB, S_GDN_GC = 300 * MiB;
constexpr size_t S_FFN_ACT = 0, S_FFN_HALO = 176 * MiB;

constexpr int LDS_BYTES = 163840;
constexpr int LDS_BARW = 163840 - 64;

typedef __bf16 hbf2 __attribute__((ext_vector_type(2)));
__device__ __forceinline__ unsigned cvt_pk_bf16(float lo, float hi) { return __builtin_bit_cast(unsigned, __builtin_convertvector((f32x2){lo, hi}, hbf2)); }
__device__ __forceinline__ float bf_lo(unsigned u) { return __builtin_bit_cast(float, u << 16); }
__device__ __forceinline__ float bf_hi(unsigned u) { return __builtin_bit_cast(float, u & 0xffff0000u); }
__device__ __forceinline__ f32x4 bf4(u32x2 w) { return (f32x4){bf_lo(w.x), bf_hi(w.x), bf_lo(w.y), bf_hi(w.y)}; }
__device__ __forceinline__ float bf2f(bf16_t b) { return __builtin_bit_cast(float, (unsigned)b << 16); }
__device__ __forceinline__ bf16_t f2bf(float f) { return (bf16_t)(cvt_pk_bf16(f, 0.0f) & 0xffffu); }
__device__ __forceinline__ float fast_exp2(float x) { return __builtin_amdgcn_exp2f(x); }
__device__ __forceinline__ float fast_rcp(float x) { return __builtin_amdgcn_rcpf(x); }
__device__ __forceinline__ float silu_f(float x) { return x * fast_rcp(1.0f + fast_exp2(-x * LOG2E)); }
__device__ __forceinline__ int opaque_tid() { int t = threadIdx.x; asm volatile("" : "+v"(t)); return t; }
typedef unsigned long long u64_t;
constexpr float SSQ_SCALE = 4294967296.0f, SSQ_INV = 1.0f / 4294967296.0f;
__device__ __forceinline__ u64_t ssq_fix(float s) { return (u64_t)(s * SSQ_SCALE); }
__device__ __forceinline__ float ssq_rs(u64_t v) { return __builtin_amdgcn_rsqf((float)v * (SSQ_INV / DM) + EPS); }
__device__ __forceinline__ float wave_sum(float v) {
#pragma unroll
    for (int o = 1; o < 64; o <<= 1) v += __shfl_xor(v, o);
    return v;
}
__device__ __forceinline__ float dpp_shr1(float v) {
    return __builtin_bit_cast(float, __builtin_amdgcn_update_dpp(0, __builtin_bit_cast(int, v), 0x111, 0xf, 0xf, false));
}
__device__ __forceinline__ bf16x8 pack8(f32x4 a, f32x4 b) {
    u32x4 p;
    asm volatile("v_cvt_pk_bf16_f32 %0, %4, %5\n\tv_cvt_pk_bf16_f32 %1, %6, %7\n\tv_cvt_pk_bf16_f32 %2, %8, %9\n\tv_cvt_pk_bf16_f32 %3, %10, %11\n\ts_nop 1"
                 : "=&v"(p[0]), "=&v"(p[1]), "=&v"(p[2]), "=&v"(p[3])
                 : "v"(a[0]), "v"(a[1]), "v"(a[2]), "v"(a[3]), "v"(b[0]), "v"(b[1]), "v"(b[2]), "v"(b[3]));
    return __builtin_bit_cast(bf16x8, p);
}

#define XB_TMO      128
#define XB_XCNT(j)  (256  + 64 * (j))
#define XB_XSUB(j)  (1280 + 64 * (j))
#define XB_XGEN(j)  (2304 + 64 * (j))
#define XB_TOP      3328
#define XB_TOPGEN   3392
#define XCD_BAR_WORDS 3456
#define XB_SPIN_CAP (1u << 18)
__device__ __forceinline__ unsigned xb_ld(unsigned* p)              { return __hip_atomic_load(p, __ATOMIC_RELAXED, __HIP_MEMORY_SCOPE_AGENT); }
__device__ __forceinline__ unsigned xb_add(unsigned* p, unsigned v) { return __hip_atomic_fetch_add(p, v, __ATOMIC_RELAXED, __HIP_MEMORY_SCOPE_AGENT); }
__device__ __forceinline__ unsigned xb_xcc_id() { return (unsigned)__builtin_amdgcn_s_getreg((3 << 11) | 20) & 0xFu; }
#define XB_SPIN(cond, bar) do { unsigned _sp = 0; while (cond) { __builtin_amdgcn_s_sleep(1); \
    if ((++_sp & 255u) == 0u) { if (xb_ld(&(bar)[XB_TMO])) break; if (_sp > XB_SPIN_CAP) { atomicAdd(&(bar)[XB_TMO], 1u); break; } } } } while (0)
struct XcdBarrier { unsigned* bar; unsigned x; volatile LAS unsigned* st; };
__device__ __forceinline__ XcdBarrier xcd_barrier_post(unsigned* bar, volatile LAS unsigned* st) {
    XcdBarrier b; b.bar = bar; b.x = xb_xcc_id(); b.st = st;
    if (threadIdx.x == 0) (void)xb_add(&bar[XB_XCNT(b.x)], 1u);
    return b;
}
__device__ __forceinline__ void xcd_barrier_complete(unsigned* bar, unsigned x, unsigned& nloc, unsigned& nx) {
    const unsigned G = gridDim.x * gridDim.y * gridDim.z;
    unsigned sum, cnt, mine, sp = 0u;
    for (;;) {
        sum = 0u; cnt = 0u; mine = 0u;
#pragma unroll
        for (unsigned j = 0; j < 16; ++j) { const unsigned c = xb_ld(&bar[XB_XCNT(j)]); sum += c; cnt += (c > 0u) ? 1u : 0u; mine = (j == x) ? c : mine; }
        if (sum == G) break;
        __builtin_amdgcn_s_sleep(1);
        if ((++sp & 255u) == 0u) { if (xb_ld(&bar[XB_TMO])) break; if (sp > XB_SPIN_CAP) { atomicAdd(&bar[XB_TMO], 1u); break; } }
    }
    nloc = mine > 0u ? mine : 1u; nx = cnt > 0u ? cnt : 1u;
}
__device__ __forceinline__ void xcd_barrier(const XcdBarrier& b) {
    asm volatile("s_waitcnt vmcnt(0)" ::: "memory");
    __syncthreads();
    if (threadIdx.x == 0) {
        unsigned* bar = b.bar;
        __builtin_amdgcn_s_waitcnt(0);
        unsigned nloc = b.st[0], nx = b.st[1];
        if (nloc == 0u) { xcd_barrier_complete(bar, b.x, nloc, nx); b.st[0] = nloc; b.st[1] = nx; }
        const unsigned old = xb_add(&bar[XB_XSUB(b.x)], 1u);
        const unsigned gen = old / nloc;
        if (old + 1u == (gen + 1u) * nloc) {
            __builtin_amdgcn_fence(__ATOMIC_RELEASE, "agent");
            asm volatile("s_waitcnt vmcnt(0)" ::: "memory");
            const unsigned og = xb_add(&bar[XB_TOP], 1u);
            const unsigned tg = og / nx;
            if (og + 1u == (tg + 1u) * nx) xb_add(&bar[XB_TOPGEN], 1u);
            else XB_SPIN(xb_ld(&bar[XB_TOPGEN]) == tg, bar);
            __builtin_amdgcn_fence(__ATOMIC_ACQUIRE, "agent");
            xb_add(&bar[XB_XGEN(b.x)], 1u);
            asm volatile("s_waitcnt vmcnt(0)" ::: "memory");
        } else {
            XB_SPIN(xb_ld(&bar[XB_XGEN(b.x)]) == gen, bar);
            __builtin_amdgcn_fence(__ATOMIC_ACQUIRE, "agent");
            asm volatile("s_waitcnt vmcnt(0)" ::: "memory");
        }
    }
    __syncthreads();
}

namespace pg8 {
constexpr int BM = 256, BK = 64, HALF = 128, HTB = HALF * BK * 2, STAGE_BYTES = 8 * HTB, NXCD = 8, WGM = 8;
__host__ __device__ __forceinline__ int lds_byte(int r, int c) { const int st = (r >> 4) * 2 + (c >> 5), rr = r & 15, cc = c & 31, ob = rr * 64 + cc * 2; return st * 1024 + (ob ^ (((ob >> 9) & 1) << 5)); }
__host__ __device__ __forceinline__ void stage_rc(int b, int& R, int& C) { const int st = b / 1024, sb = b % 1024, swz = sb ^ (((sb >> 9) & 1) << 5); R = (st >> 1) * 16 + swz / 64; C = (st & 1) * 32 + (swz % 64) / 2; }
__host__ __device__ __forceinline__ int perm32(int rho) { const int n = rho >> 4, i = rho & 15; return 8 * (i >> 2) + 4 * n + (i & 3); }
struct Unit { int pm, pn; };
struct Gemm { const bf16_t* A; const bf16_t* Bt; int M, N, K, lda; };
struct StaticOrder {
    int nM, nN, nwg, G, c;
    __host__ __device__ void init(int M, int N, int G_, int c_) { nM = M / BM; nN = N / BM; nwg = nM * nN; G = G_; c = c_; }
    __host__ __device__ bool next(int i, Unit& u) const {
        const long L = (long)i * G + c; if (L >= nwg) return false;
        int wgid = (int)L; { const int q = nwg / NXCD, r = nwg % NXCD, xcd = wgid % NXCD, off = wgid / NXCD; wgid = (xcd < r ? xcd * (q + 1) : r * (q + 1) + (xcd - r) * q) + off; }
        const int nig = WGM * nN, gid = wgid / nig, fm = gid * WGM, gsz = (nM - fm) < WGM ? (nM - fm) : WGM;
        u.pm = fm + ((wgid % nig) % gsz); u.pn = (wgid % nig) / gsz; return true;
    }
};
template <class Epi, bool TOKPERM>
__device__ __forceinline__ void gemm_phase(LAS unsigned char* lds, const Gemm g, const StaticOrder& S, const Epi& E) {
    const int tid = opaque_tid(), wid = __builtin_amdgcn_readfirstlane(tid >> 6), lane = tid & 63, wr = wid >> 2, wc = wid & 3, fr = lane & 15, fq = lane >> 4;
    const int K = g.K, nt = K / BK, lda = g.lda;
    unsigned voffA[2], voffB[2];
#pragma unroll
    for (int i = 0; i < 2; ++i) { int R, C; stage_rc(tid * 16 + i * 8192, R, C); const int Rb = (R & ~31) + perm32(R & 31);
        const int Ra = TOKPERM ? (128 * (R >> 6) + 8 * (R & 15) + ((R >> 4) & 3)) : R;
        voffA[i] = (unsigned)(Ra * lda + C) * 2u; voffB[i] = (unsigned)(Rb * K + C) * 2u; }
    const size_t kstep = (size_t)(BK * 2);
    const size_t hstepA = TOKPERM ? (size_t)4 * lda * 2 : (size_t)HALF * lda * 2, hstepB = (size_t)HALF * K * 2;
    const size_t tstepA = (size_t)BM * lda * 2, tstepB = (size_t)BM * K * 2;
    const unsigned ldsw = (unsigned)wid * 1024u;
    const int aoff = lds_byte(wr * 64 + fr, fq * 8), boff = lds_byte(wc * 32 + fr, fq * 8);
#define PG8_SA(b, h) (((b) * 2 + (h)) * HTB)
#define PG8_SB(b, h) ((4 + (b) * 2 + (h)) * HTB)
#define PG8_STAGE(bufoff, gbase, voff) do { _Pragma("unroll") for (int _i = 0; _i < 2; ++_i) \
        __builtin_amdgcn_global_load_lds((const unsigned*)((const char*)(gbase) + (voff)[_i]), (LAS unsigned*)(lds + (bufoff) + ldsw + _i * 8192), 16, 0, 0); } while (0)
#define PG8_LDA(dst, b, h) do { _Pragma("unroll") for (int m = 0; m < 4; ++m) _Pragma("unroll") for (int k = 0; k < 2; ++k) dst[m][k] = *(const LAS bf16x8*)(lds + PG8_SA(b, h) + aoff + m * 2048 + k * 1024); } while (0)
#define PG8_LDB(dst, b, h) do { _Pragma("unroll") for (int n = 0; n < 2; ++n) _Pragma("unroll") for (int k = 0; k < 2; ++k) dst[n][k] = *(const LAS bf16x8*)(lds + PG8_SB(b, h) + boff + n * 2048 + k * 1024); } while (0)
#define PG8_MMA(ai, bj, At, Bt) do { __builtin_amdgcn_s_setprio(1); _Pragma("unroll") for (int m = 0; m < 4; ++m) _Pragma("unroll") for (int n = 0; n < 2; ++n) _Pragma("unroll") for (int k = 0; k < 2; ++k) \
        acc[ai][bj][m][n] = __builtin_amdgcn_mfma_f32_16x16x32_bf16(Bt[n][k], At[m][k], acc[ai][bj][m][n], 0, 0, 0); __builtin_amdgcn_s_setprio(0); } while (0)
#define PG8_WAIT_V(n) asm volatile("s_waitcnt vmcnt(" #n ")" ::: "memory")
#define PG8_WAIT_L(n) asm volatile("s_waitcnt lgkmcnt(" #n ")" ::: "memory")
#define PG8_BAR __builtin_amdgcn_s_barrier()
#define PG8_SCHED __builtin_amdgcn_sched_barrier(0)
    Unit cur, nxt; int ui = 0;
    if (!S.next(0, cur)) return;
    f32x4 acc[2][2][4][2];
#pragma unroll
    for (int a = 0; a < 2; ++a)
#pragma unroll
        for (int b = 0; b < 2; ++b)
#pragma unroll
            for (int m = 0; m < 4; ++m)
#pragma unroll
                for (int n = 0; n < 2; ++n) acc[a][b][m][n] = (f32x4){0.f, 0.f, 0.f, 0.f};
    bf16x8 At[4][2], B0[2][2], B1[2][2];
    const char* cA = (const char*)g.A + (size_t)cur.pm * tstepA; const char* cB = (const char*)g.Bt + (size_t)cur.pn * tstepB;
    PG8_STAGE(PG8_SB(0, 0), cB, voffB); PG8_STAGE(PG8_SB(0, 1), cB + hstepB, voffB); PG8_STAGE(PG8_SA(0, 0), cA, voffA); PG8_STAGE(PG8_SA(0, 1), cA + hstepA, voffA);
    if (wr == 1) PG8_BAR;
    PG8_WAIT_V(2); PG8_BAR;
    PG8_STAGE(PG8_SB(1, 0), cB + kstep, voffB); PG8_STAGE(PG8_SA(1, 0), cA + kstep, voffA); PG8_STAGE(PG8_SB(1, 1), cB + hstepB + kstep, voffB);
    PG8_WAIT_V(6); PG8_BAR;
    for (;;) {
        const bool has_next = S.next(ui + 1, nxt);
        const char* nA = has_next ? (const char*)g.A + (size_t)nxt.pm * tstepA : cA; const char* nB = has_next ? (const char*)g.Bt + (size_t)nxt.pn * tstepB : cB;
        for (int t = 0; t < nt; t += 2) {
            const bool last = (t == nt - 2);
            const char* a1 = cA + (size_t)(t + 1) * kstep;
            const char* a2 = last ? nA : cA + (size_t)(t + 2) * kstep; const char* b2 = last ? nB : cB + (size_t)(t + 2) * kstep;
            const char* a3 = a2 + kstep; const char* b3 = b2 + kstep;
            PG8_LDB(B0, 0, 0); PG8_LDB(B1, 0, 1); PG8_SCHED; PG8_LDA(At, 0, 0); PG8_STAGE(PG8_SA(1, 1), a1 + hstepA, voffA);
            PG8_WAIT_V(8); PG8_WAIT_L(0); PG8_BAR; PG8_MMA(0, 0, At, B0); PG8_MMA(0, 1, At, B1); PG8_BAR; PG8_SCHED;
            PG8_LDA(At, 0, 1); PG8_STAGE(PG8_SB(0, 0), b2, voffB); PG8_STAGE(PG8_SB(0, 1), b2 + hstepB, voffB); PG8_STAGE(PG8_SA(0, 0), a2, voffA);
            PG8_WAIT_V(8); PG8_WAIT_L(0); PG8_BAR; PG8_MMA(1, 0, At, B0); PG8_MMA(1, 1, At, B1); PG8_BAR; PG8_SCHED;
            PG8_LDB(B0, 1, 0); PG8_LDB(B1, 1, 1); PG8_SCHED; PG8_LDA(At, 1, 0); PG8_STAGE(PG8_SA(0, 1), a2 + hstepA, voffA);
            PG8_WAIT_V(8); PG8_WAIT_L(0); PG8_BAR; PG8_MMA(0, 0, At, B0); PG8_MMA(0, 1, At, B1); PG8_BAR; PG8_SCHED;
            PG8_LDA(At, 1, 1); PG8_STAGE(PG8_SB(1, 0), b3, voffB); PG8_STAGE(PG8_SB(1, 1), b3 + hstepB, voffB); PG8_STAGE(PG8_SA(1, 0), a3, voffA);
            PG8_WAIT_V(8); PG8_WAIT_L(0); PG8_BAR; PG8_MMA(1, 0, At, B0); PG8_MMA(1, 1, At, B1); PG8_BAR; PG8_SCHED;
        }
        if (wr == 0) PG8_BAR;
        E(acc, cur, wr, wc, fr, fq);
        if (!has_next) break;
#pragma unroll
        for (int a = 0; a < 2; ++a)
#pragma unroll
            for (int b = 0; b < 2; ++b)
#pragma unroll
                for (int m = 0; m < 4; ++m)
#pragma unroll
                    for (int n = 0; n < 2; ++n) acc[a][b][m][n] = (f32x4){0.f, 0.f, 0.f, 0.f};
        cur = nxt; cA = nA; cB = nB; ++ui;
        if (wr == 1) PG8_BAR;
    }
    PG8_WAIT_V(0);
    PG8_BAR;
#undef PG8_SA
#undef PG8_SB
#undef PG8_STAGE
#undef PG8_LDA
#undef PG8_LDB
#undef PG8_MMA
#undef PG8_WAIT_V
#undef PG8_WAIT_L
#undef PG8_BAR
#undef PG8_SCHED
}

struct EpiIn {
    bf16_t* O; int ldc; const u64_t* ssq; bf16_t* halo;
    __device__ __forceinline__ void operator()(const f32x4 (&acc)[2][2][4][2], const Unit& u, int wr, int wc, int fr, int fq) const {
        const int row0 = u.pm * BM + wr * 64 + fr, col0 = u.pn * BM + wc * 32 + 8 * fq;
        u64_t sq[2][4];
#pragma unroll
        for (int ai = 0; ai < 2; ++ai)
#pragma unroll
            for (int m = 0; m < 4; ++m) sq[ai][m] = ssq[row0 + ai * HALF + m * 16];
        __builtin_amdgcn_sched_barrier(0);
#pragma unroll
        for (int ai = 0; ai < 2; ++ai)
#pragma unroll
            for (int m = 0; m < 4; ++m) { const int t = row0 + ai * HALF + m * 16; const float rs = ssq_rs(sq[ai][m]);
                bf16_t* rowp = O + (size_t)t * ldc + col0;
#pragma unroll
                for (int bj = 0; bj < 2; ++bj) { const f32x4 v0 = acc[ai][bj][m][0] * rs, v1 = acc[ai][bj][m][1] * rs;
                    u32x4 w; w.x = cvt_pk_bf16(v0[0], v0[1]); w.y = cvt_pk_bf16(v0[2], v0[3]); w.z = cvt_pk_bf16(v1[0], v1[1]); w.w = cvt_pk_bf16(v1[2], v1[3]);
                    *(u32x4*)(rowp + bj * HALF) = w;
                    if (halo != nullptr && m == 3 && fr >= 13 && (col0 + bj * HALF) < 3072) *(u32x4*)(halo + ((size_t)(t >> 6) * 3 + (fr - 13)) * 3072 + col0 + bj * HALF) = w; } }
    }
};
struct EpiOut {
    bf16_t* XB; u64_t* ssq_next; LAS float* ts;
    __device__ __forceinline__ void operator()(const f32x4 (&acc)[2][2][4][2], const Unit& u, int wr, int wc, int fr, int fq) const {
        const int row0 = u.pm * BM + wr * 64 + fr, col0 = u.pn * BM + wc * 32 + 8 * fq;
        u32x4 xin[2][4][2];
#pragma unroll
        for (int ai = 0; ai < 2; ++ai)
#pragma unroll
            for (int m = 0; m < 4; ++m)
#pragma unroll
                for (int bj = 0; bj < 2; ++bj) xin[ai][m][bj] = *(const u32x4*)(XB + (size_t)(row0 + ai * HALF + m * 16) * DM + col0 + bj * HALF);
        __builtin_amdgcn_sched_barrier(0);
#pragma unroll
        for (int ai = 0; ai < 2; ++ai)
#pragma unroll
            for (int m = 0; m < 4; ++m) { const int t = row0 + ai * HALF + m * 16; float ss = 0.f;
#pragma unroll
                for (int bj = 0; bj < 2; ++bj) { const u32x4 xi = xin[ai][m][bj];
                    f32x4 v0, v1; v0[0] = bf_lo(xi.x); v0[1] = bf_hi(xi.x); v0[2] = bf_lo(xi.y); v0[3] = bf_hi(xi.y); v1[0] = bf_lo(xi.z); v1[1] = bf_hi(xi.z); v1[2] = bf_lo(xi.w); v1[3] = bf_hi(xi.w);
                    v0 = v0 + acc[ai][bj][m][0]; v1 = v1 + acc[ai][bj][m][1];
                    u32x4 w; w.x = cvt_pk_bf16(v0[0], v0[1]); w.y = cvt_pk_bf16(v0[2], v0[3]); w.z = cvt_pk_bf16(v1[0], v1[1]); w.w = cvt_pk_bf16(v1[2], v1[3]);
                    *(u32x4*)(XB + (size_t)t * DM + col0 + bj * HALF) = w;
                    ss += (v0[0] * v0[0] + v0[1] * v0[1]) + (v0[2] * v0[2] + v0[3] * v0[3]) + (v1[0] * v1[0] + v1[1] * v1[1]) + (v1[2] * v1[2] + v1[3] * v1[3]); }
                ss += __shfl_xor(ss, 16); ss += __shfl_xor(ss, 32);
                if (fq == 0) ts[(wr * 64 + fr + ai * HALF + m * 16) * 4 + wc] = ss; }
        asm volatile("s_waitcnt lgkmcnt(0)" ::: "memory"); __builtin_amdgcn_s_barrier(); asm volatile("" ::: "memory");
        const int tid = opaque_tid();
        if (tid < 256) { const f32x4 p = *(const LAS f32x4*)(ts + tid * 4); atomicAdd(ssq_next + u.pm * BM + tid, ssq_fix((p[0] + p[1]) + (p[2] + p[3]))); }
    }
};
struct EpiUp {
    bf16_t* ACT; float* halo; const float* cw; const u64_t* ssq;
    __device__ __forceinline__ void operator()(f32x4 (&acc)[2][2][4][2], const Unit& u, int wr, int wc, int fr, int fq) const {
        asm volatile("" : "+v"(fr), "+v"(fq));
        const int tbase = u.pm * BM + 128 * wr + 8 * fr, ch0 = u.pn * 128 + wc * 32 + 8 * fq;
#pragma unroll
        for (int ai = 0; ai < 2; ++ai)
#pragma unroll
            for (int m = 0; m < 4; ++m) { const float rs = ssq_rs(ssq[tbase + 4 * ai + m]);
#pragma unroll
                for (int bj = 0; bj < 2; ++bj)
#pragma unroll
                    for (int n = 0; n < 2; ++n) acc[ai][bj][m][n] = acc[ai][bj][m][n] * rs; }
        if (fr == 0 || fr == 15) {
            float* hb = halo + ((size_t)(tbase >> 7) * 4 + (fr == 0 ? 0 : 2)) * (2 * FFD) + ch0;
#pragma unroll
            for (int jj = 0; jj < 2; ++jj)
#pragma unroll
                for (int n = 0; n < 2; ++n) {
                    const f32x4 g0 = (fr == 0) ? acc[0][0][jj][n] : acc[1][0][2 + jj][n], u0 = (fr == 0) ? acc[0][1][jj][n] : acc[1][1][2 + jj][n];
                    *(f32x4*)(hb + (size_t)jj * (2 * FFD) + 4 * n) = g0; *(f32x4*)(hb + (size_t)jj * (2 * FFD) + FFD + 4 * n) = u0; }
        }
#pragma unroll
        for (int n = 0; n < 2; ++n) {
#pragma unroll
            for (int half = 1; half >= 0; --half) {
                f32x4 w[3];
#pragma unroll
                for (int k = 0; k < 3; ++k) w[k] = *(const f32x4*)(cw + (size_t)k * (2 * FFD) + half * FFD + ch0 + 4 * n);
                f32x4 p6, p7;
#pragma unroll
                for (int e = 0; e < 4; ++e) { p6[e] = dpp_shr1(acc[1][half][2][n][e]); p7[e] = dpp_shr1(acc[1][half][3][n][e]); }
#pragma unroll
                for (int j = 7; j >= 0; --j) {
                    const int j1 = j >= 1 ? j - 1 : 0, j2 = j >= 2 ? j - 2 : 0;
                    const f32x4 x0 = acc[j >> 2][half][j & 3][n];
                    const f32x4 x1 = (j >= 1) ? acc[j1 >> 2][half][j1 & 3][n] : p7;
                    const f32x4 x2 = (j >= 2) ? acc[j2 >> 2][half][j2 & 3][n] : (j == 1 ? p7 : p6);
                    const f32x4 cv = w[2] * x0 + w[1] * x1 + w[0] * x2;
                    if (half == 1) acc[j >> 2][1][j & 3][n] = cv;
                    else { f32x4 a; const f32x4 up = acc[j >> 2][1][j & 3][n];
#pragma unroll
                        for (int e = 0; e < 4; ++e) a[e] = silu_f(cv[e]) * up[e];
                        acc[j >> 2][0][j & 3][n] = a; }
                }
                asm volatile("" ::: "memory");
            }
        }
#pragma unroll
        for (int j = 0; j < 8; ++j) {
            if (fr == 0 && j < 2) continue;
            const f32x4 v0 = acc[j >> 2][0][j & 3][0], v1 = acc[j >> 2][0][j & 3][1];
            u32x4 w; w.x = cvt_pk_bf16(v0[0], v0[1]); w.y = cvt_pk_bf16(v0[2], v0[3]); w.z = cvt_pk_bf16(v1[0], v1[1]); w.w = cvt_pk_bf16(v1[2], v1[3]);
            *(u32x4*)(ACT + (size_t)(tbase + j) * FFD + ch0) = w;
        }
    }
};
}

struct Params { const float* in[18]; float* out; unsigned char* ws; int ph_lo, ph_hi; };
enum { IN_X = 0, IN_MIXN, IN_FFNN, IN_FINN, IN_MOBA_QKV, IN_MOBA_O, IN_SC_IN, IN_SC_CONV, IN_SC_OUT, IN_GDN_IN, IN_GDN_CONV, IN_GDN_ALOG, IN_GDN_DTB, IN_GDN_NORM, IN_GDN_O, IN_FFN_UP, IN_FFN_CONV, IN_FFN_DN };

__device__ __forceinline__ void transpose_item(const float* W, int ldw, int K, int srccol0, const float* gain, bf16_t* WT, int dstrow0, int k0, LAS float* scr, int lane) {
    float wv[32];
    { const float* wp = W + (size_t)(k0 + (lane >> 5)) * ldw + srccol0 + (lane & 31); unsigned off = 0;
#pragma unroll
      for (int i = 0; i < 32; ++i) { wv[i] = wp[off]; off += 2 * ldw; asm volatile("" : "+v"(off)); }
      __builtin_amdgcn_sched_barrier(0); }
#pragma unroll
    for (int i = 0; i < 32; ++i) { const int kk = 2 * i + (lane >> 5); float v = wv[i]; if (gain) v *= gain[k0 + kk]; scr[kk * 33 + (lane & 31)] = v; }
    asm volatile("s_waitcnt lgkmcnt(0)" ::: "memory");
    const int c = lane & 7;
#pragma unroll
    for (int j = 0; j < 4; ++j) { const int n = (lane >> 3) + 8 * j; const LAS float* s = scr + (8 * c) * 33 + n;
        u32x4 o; o.x = cvt_pk_bf16(s[0 * 33], s[1 * 33]); o.y = cvt_pk_bf16(s[2 * 33], s[3 * 33]); o.z = cvt_pk_bf16(s[4 * 33], s[5 * 33]); o.w = cvt_pk_bf16(s[6 * 33], s[7 * 33]);
        *(u32x4*)(WT + (size_t)(dstrow0 + n) * K + k0 + 8 * c) = o; }
    asm volatile("s_waitcnt lgkmcnt(0)" ::: "memory");
}
__device__ __forceinline__ void phase_prologue(const Params& P, LAS unsigned char* lds, int wg, int G) {
    const int tid = opaque_tid(), lane = tid & 63, wave = tid >> 6;
    LAS float* scr = (LAS float*)(lds + wave * 16384);
    const int gw = wg * 8 + wave, NGW = G * 8;
    bf16_t* Wb = (bf16_t*)(P.ws + WS_W);
    constexpr int NITEMS = 3072 + 1024 + 1536 + 512 + 2048 + 512 + 4 * 2816 + 4 * 1408;
    for (int it = gw; it < NITEMS; it += NGW) {
        int r = it; const float* src; int ldw, K, N; const float* gain; size_t doff; int map = 0;
        if (r < 3072) { const int j = r / 1536; r -= j * 1536; src = P.in[IN_MOBA_QKV] + (size_t)j * DM * 3072; ldw = 3072; K = DM; N = 3072; gain = P.in[IN_MIXN] + (j == 0 ? 0 : 3) * DM; doff = j == 0 ? W_MOBA_QKV0 : W_MOBA_QKV1; }
        else if ((r -= 3072) < 1024) { const int j = r / 512; r -= j * 512; src = P.in[IN_MOBA_O] + (size_t)j * DM * DM; ldw = DM; K = DM; N = DM; gain = nullptr; doff = j == 0 ? W_MOBA_O0 : W_MOBA_O1; }
        else if ((r -= 1024) < 1536) { src = P.in[IN_SC_IN]; ldw = 3072; K = DM; N = 3072; gain = P.in[IN_MIXN] + 1 * DM; doff = W_SC_IN; }
        else if ((r -= 1536) < 512) { src = P.in[IN_SC_OUT]; ldw = DM; K = DM; N = DM; gain = nullptr; doff = W_SC_OUT; }
        else if ((r -= 512) < 2048) { src = P.in[IN_GDN_IN]; ldw = 4112; K = DM; N = 4096; gain = P.in[IN_MIXN] + 2 * DM; doff = W_GDN_IN; }
        else if ((r -= 2048) < 512) { src = P.in[IN_GDN_O]; ldw = DM; K = DM; N = DM; gain = nullptr; doff = W_GDN_O; }
        else if ((r -= 512) < 4 * 2816) { const int j = r / 2816; r -= j * 2816; src = P.in[IN_FFN_UP] + (size_t)j * DM * (2 * FFD); ldw = 2 * FFD; K = DM; N = 2 * FFD; gain = P.in[IN_FFNN] + j * DM; doff = W_FFN_UP + j * W_FFN_UP_STRIDE; map = 1; }
        else { r -= 4 * 2816; const int j = r / 1408; r -= j * 1408; src = P.in[IN_FFN_DN] + (size_t)j * FFD * DM; ldw = DM; K = FFD; N = DM; gain = nullptr; doff = W_FFN_DN + j * W_FFN_DN_STRIDE; }
        const int nblk = N / 32, kb = r / nblk, nb = r % nblk, n0 = 32 * nb;
        int sc0 = n0;
        if (map == 1) { const int tile = n0 >> 8, w = n0 & 255; sc0 = (w < 128) ? tile * 128 + w : FFD + tile * 128 + (w - 128); }
        transpose_item(src, ldw, K, sc0, gain, (bf16_t*)((unsigned char*)Wb + doff), n0, 64 * kb, scr, lane);
    }
    { float* bgw = (float*)(P.ws + WS_MISC + MISC_BGW); const float* src = P.in[IN_GDN_IN]; const float* gain = P.in[IN_MIXN] + 2 * DM;
      for (int i = wg * 512 + tid; i < 16 * DM; i += G * 512) { const int c = i >> 10, k = i & 1023; bgw[i] = src[(size_t)k * 4112 + 4096 + c] * gain[k]; } }
    { const float* x = P.in[IN_X]; bf16_t* xb = (bf16_t*)(P.ws + WS_XB); u64_t* ssq = (u64_t*)(P.ws + WS_SSQ);
      for (int t0 = gw; t0 < T_TOK; t0 += 4 * NGW) {
          f32x4 v[4][4];
#pragma unroll
          for (int r = 0; r < 4; ++r) { const f32x4* xr = (const f32x4*)(x + (size_t)(t0 + r * NGW) * DM) + lane;
#pragma unroll
              for (int j = 0; j < 4; ++j) v[r][j] = xr[64 * j]; }
#pragma unroll
          for (int r = 0; r < 4; ++r) { const int t = t0 + r * NGW; u32x2* brow = (u32x2*)(xb + (size_t)t * DM) + lane; float s = 0.f;
#pragma unroll
              for (int j = 0; j < 4; ++j) { const f32x4 q = v[r][j]; u32x2 w; w.x = cvt_pk_bf16(q[0], q[1]); w.y = cvt_pk_bf16(q[2], q[3]); brow[64 * j] = w; s += (q[0] * q[0] + q[1] * q[1]) + (q[2] * q[2] + q[3] * q[3]); }
              s = wave_sum(s); if (lane == 0) ssq[t] = ssq_fix(s); } } }
}

__device__ __forceinline__ void phase_final(const Params& P, int wg, int G) {
    const int tid = opaque_tid(), lane = tid & 63, wave = tid >> 6, gw = wg * 8 + wave, NGW = G * 8;
    const u64_t* ssq = (const u64_t*)(P.ws + WS_SSQ) + (size_t)8 * T_TOK; const f32x4* gn = (const f32x4*)P.in[IN_FINN] + lane; const bf16_t* xb = (const bf16_t*)(P.ws + WS_XB);
    const f32x4 g0 = gn[0], g1 = gn[64], g2 = gn[128], g3 = gn[192];
    for (int t0 = gw; t0 < T_TOK; t0 += 4 * NGW) {
        u32x2 v[4][4]; float rs[4];
#pragma unroll
        for (int r = 0; r < 4; ++r) { const int t = t0 + r * NGW; rs[r] = ssq_rs(ssq[t]); const u32x2* xr = (const u32x2*)(xb + (size_t)t * DM) + lane;
#pragma unroll
            for (int j = 0; j < 4; ++j) v[r][j] = xr[64 * j]; }
#pragma unroll
        for (int r = 0; r < 4; ++r) { const int t = t0 + r * NGW; f32x4* xo = (f32x4*)(P.out + (size_t)t * DM) + lane;
            xo[0] = bf4(v[r][0]) * rs[r] * g0; xo[64] = bf4(v[r][1]) * rs[r] * g1; xo[128] = bf4(v[r][2]) * rs[r] * g2; xo[192] = bf4(v[r][3]) * rs[r] * g3; }
    }
}

__device__ __forceinline__ void phase_ffn_fix(const Params& P, int layer, int wg, int G) {
    const float* halo = (const float*)(P.ws + WS_S + S_FFN_HALO); bf16_t* act = (bf16_t*)(P.ws + WS_S + S_FFN_ACT); const float* cw = P.in[IN_FFN_CONV] + (size_t)layer * 3 * (2 * FFD);
    const int tid = opaque_tid();
    for (int i = wg * 512 + tid; i < 512 * FFD; i += G * 512) {
        const int row = i / FFD, c = i - row * FFD, g = row >> 1, tau = row & 1, t = 128 * g + tau, s = t & (SEQ - 1);
        const float* hg = halo + (size_t)g * 4 * (2 * FFD); const float* hp = hg - 4 * (2 * FFD);
        float g0, g1, g2, u0, u1, u2;
        if (tau == 0) { g0 = hg[c]; u0 = hg[FFD + c]; if (s >= 2) { g1 = hp[3 * (2 * FFD) + c]; u1 = hp[3 * (2 * FFD) + FFD + c]; g2 = hp[2 * (2 * FFD) + c]; u2 = hp[2 * (2 * FFD) + FFD + c]; } else { g1 = g2 = u1 = u2 = 0.f; } }
        else { g0 = hg[(2 * FFD) + c]; u0 = hg[(2 * FFD) + FFD + c]; g1 = hg[c]; u1 = hg[FFD + c]; if (s >= 2) { g2 = hp[3 * (2 * FFD) + c]; u2 = hp[3 * (2 * FFD) + FFD + c]; } else { g2 = u2 = 0.f; } }
        const float gc = cw[2 * (2 * FFD) + c] * g0 + cw[(2 * FFD) + c] * g1 + cw[c] * g2;
        const float uc = cw[2 * (2 * FFD) + FFD + c] * u0 + cw[(2 * FFD) + FFD + c] * u1 + cw[FFD + c] * u2;
        act[(size_t)t * FFD + c] = f2bf(silu_f(gc) * uc);
    }
}

__device__ __forceinline__ void phase_sconv(const Params& P, int wg, int G) {
    const bf16_t* proj = (const bf16_t*)(P.ws + WS_S + S_SC_PROJ); bf16_t* y = (bf16_t*)(P.ws + WS_S + S_SC_Y); const float* cw = P.in[IN_SC_CONV];
    const int c = 2 * opaque_tid();
    const float w00 = cw[c], w01 = cw[c + 1], w10 = cw[DM + c], w11 = cw[DM + c + 1], w20 = cw[2 * DM + c], w21 = cw[2 * DM + c + 1];
    for (int ch = wg; ch < T_TOK / 64; ch += G) {
        const int t0 = ch * 64, s0 = t0 & (SEQ - 1);
        float p1a = 0.f, p1b = 0.f, p2a = 0.f, p2b = 0.f;
        if (s0 != 0) {
            const unsigned c1 = *(const unsigned*)(proj + (size_t)(t0 - 1) * 3072 + DM + c), x1 = *(const unsigned*)(proj + (size_t)(t0 - 1) * 3072 + 2 * DM + c);
            const unsigned c2 = *(const unsigned*)(proj + (size_t)(t0 - 2) * 3072 + DM + c), x2 = *(const unsigned*)(proj + (size_t)(t0 - 2) * 3072 + 2 * DM + c);
            p1a = bf_lo(c1) * bf_lo(x1); p1b = bf_hi(c1) * bf_hi(x1); p2a = bf_lo(c2) * bf_lo(x2); p2b = bf_hi(c2) * bf_hi(x2);
        }
#pragma unroll 1
        for (int i0 = 0; i0 < 64; i0 += 16) {
            unsigned bb[16], cc[16], xx[16];
#pragma unroll
            for (int i = 0; i < 16; ++i) { const bf16_t* r = proj + (size_t)(t0 + i0 + i) * 3072; bb[i] = *(const unsigned*)(r + c); cc[i] = *(const unsigned*)(r + DM + c); xx[i] = *(const unsigned*)(r + 2 * DM + c); }
#pragma unroll
            for (int i = 0; i < 16; ++i) {
                const float pa = bf_lo(cc[i]) * bf_lo(xx[i]), pb = bf_hi(cc[i]) * bf_hi(xx[i]);
                const float ya = bf_lo(bb[i]) * (w20 * pa + w10 * p1a + w00 * p2a), yb = bf_hi(bb[i]) * (w21 * pb + w11 * p1b + w01 * p2b);
                *(unsigned*)(y + (size_t)(t0 + i0 + i) * DM + c) = cvt_pk_bf16(ya, yb);
                p2a = p1a; p2b = p1b; p1a = pa; p1b = pb; }
        }
    }
}

__device__ __forceinline__ void phase_moba_kmean_vt(const Params& P, LAS unsigned char* lds, int wg, int G) {
    const bf16_t* qkv = (const bf16_t*)(P.ws + WS_S + S_MOBA_QKV); bf16_t* kmh = (bf16_t*)(P.ws + WS_MISC + MISC_KMEAN); bf16_t* kml = kmh + 1024 * 128;
    const int tid = opaque_tid();
    LAS float* red = (LAS float*)lds;
    for (int u = wg; u < 1024; u += G) {
        const int b = u >> 9, h = (u >> 6) & 7, blk = u & 63; const size_t row0 = (size_t)b * SEQ + (size_t)blk * BLK;
        __syncthreads();
        { const int d2 = tid & 63, part = tid >> 6; float s0 = 0.f, s1 = 0.f; const bf16_t* kp = qkv + (row0 + part * 32) * 3072 + DM + h * HD + 2 * d2;
          unsigned kq[32];
#pragma unroll
          for (int i = 0; i < 32; ++i) kq[i] = *(const unsigned*)(kp + (size_t)i * 3072);
#pragma unroll
          for (int i = 0; i < 32; ++i) { s0 += bf_lo(kq[i]); s1 += bf_hi(kq[i]); }
          red[part * 128 + 2 * d2] = s0; red[part * 128 + 2 * d2 + 1] = s1; }
        {
            float* kn = (float*)(P.ws + WS_S + S_MOBA_KN); const int lane_ = tid & 63, w_ = tid >> 6; float mxn = 0.f; unsigned kv[32];
            const bf16_t* kp = qkv + (row0 + w_ * 32) * 3072 + DM + h * HD + 2 * lane_;
#pragma unroll
            for (int i = 0; i < 32; ++i) kv[i] = *(const unsigned*)(kp + (size_t)i * 3072);
#pragma unroll
            for (int i = 0; i < 32; ++i) { const float a = bf_lo(kv[i]), c = bf_hi(kv[i]); const float nn = __builtin_amdgcn_sqrtf(wave_sum(a * a + c * c)); mxn = fmaxf(mxn, nn); if (lane_ == 0) kn[(row0 + w_ * 32 + i) * NH + h] = nn; }
            if (lane_ == 0) red[1024 + w_] = mxn; }
        __syncthreads();
        if (tid == 0) { float m = 0.f;
#pragma unroll
            for (int w = 0; w < 8; ++w) m = fmaxf(m, red[1024 + w]);
            ((float*)(P.ws + WS_S + S_MOBA_KMAX))[u] = m; }
        if (tid < 128) { float s = 0.f;
#pragma unroll
            for (int p = 0; p < 8; ++p) s += red[p * 128 + tid];
            const float m = s * (1.0f / BLK); const bf16_t hi = f2bf(m); kmh[(size_t)u * 128 + tid] = hi; kml[(size_t)u * 128 + tid] = f2bf(m - bf2f(hi)); }
    }
}


__device__ __forceinline__ void phase_moba_gate2(const Params& P, LAS unsigned char* lds, int mj, int wg, int G) {
    const bf16_t* qkv = (const bf16_t*)(P.ws + WS_S + S_MOBA_QKV); const bf16_t* kmh = (const bf16_t*)(P.ws + WS_MISC + MISC_KMEAN); const bf16_t* kml = kmh + 1024 * 128;
    int* cnt = (int*)(P.ws + WS_CTL + CTL_CNT) + mj * 1024; unsigned short* list = (unsigned short*)(P.ws + WS_S + S_MOBA_LIST);
    const int tid = opaque_tid(), lane = tid & 63, wave = __builtin_amdgcn_readfirstlane(tid >> 6), i16 = lane & 15, quad = lane >> 4;
    LAS float* SC = (LAS float*)(lds + 34816); LAS int* cntL = (LAS int*)(lds + 34816 + 66560); LAS int* baseL = cntL + 64; LAS float* qnL = (LAS float*)(baseL + 64); LAS float* kmxL = qnL + 256;
    for (int u = wg; u < 63 * 16; u += G) {
        const int own = 63 - u / 16, bh = u & 15, b = bh >> 3, h = bh & 7, nnb = (own + 15) >> 4;
        __syncthreads();
        if (tid < 64) cntL[tid] = 0;
        for (int c = tid; c < nnb * 256; c += 512) { const int row = c >> 4, pc = c & 15;
            *(LAS u32x4*)(lds + row * 272 + pc * 16) = *(const u32x4*)(kmh + (size_t)(bh * NBLK + row) * 128 + pc * 8);
            *(LAS u32x4*)(lds + 17408 + row * 272 + pc * 16) = *(const u32x4*)(kml + (size_t)(bh * NBLK + row) * 128 + pc * 8); }
        bf16x8 qf[2][4];
#pragma unroll
        for (int q2 = 0; q2 < 2; ++q2) { const bf16_t* qp = qkv + ((size_t)b * SEQ + own * BLK + 16 * (2 * wave + q2) + i16) * 3072 + h * HD + 8 * quad;
#pragma unroll
            for (int ks = 0; ks < 4; ++ks) qf[q2][ks] = *(const bf16x8*)(qp + 32 * ks);
            float s2 = 0.f;
#pragma unroll
            for (int ks = 0; ks < 4; ++ks) { const u32x4 w4 = __builtin_bit_cast(u32x4, qf[q2][ks]);
#pragma unroll
                for (int e = 0; e < 4; ++e) { const float a = bf_lo(w4[e]), c = bf_hi(w4[e]); s2 += a * a + c * c; } }
            s2 += __shfl_xor(s2, 16); s2 += __shfl_xor(s2, 32);
            if (quad == 0) qnL[16 * (2 * wave + q2) + i16] = s2; }
        if (tid < 64) kmxL[tid] = ((const float*)(P.ws + WS_S + S_MOBA_KMAX))[bh * NBLK + tid];
        __syncthreads();
#pragma unroll
        for (int q2 = 0; q2 < 2; ++q2)
#pragma unroll 1
            for (int nb = 0; nb < nnb; ++nb) { f32x4 acc = (f32x4){0.f, 0.f, 0.f, 0.f};
#pragma unroll
                for (int ks = 0; ks < 4; ++ks) { acc = __builtin_amdgcn_mfma_f32_16x16x32_bf16(qf[q2][ks], *(const LAS bf16x8*)(lds + 17408 + (16 * nb + i16) * 272 + (32 * ks + 8 * quad) * 2), acc, 0, 0, 0);
                                                 acc = __builtin_amdgcn_mfma_f32_16x16x32_bf16(qf[q2][ks], *(const LAS bf16x8*)(lds + (16 * nb + i16) * 272 + (32 * ks + 8 * quad) * 2), acc, 0, 0, 0); }
#pragma unroll
                for (int jj = 0; jj < 4; ++jj) SC[(16 * (2 * wave + q2) + 4 * quad + jj) * 65 + 16 * nb + i16] = acc[jj]; }
        __syncthreads();
        int sel[3] = {-1, -1, -1}, lp[3] = {0, 0, 0};
        if (tid < 256) { const LAS float* sr = SC + tid * 65;
            float v0 = -3.0e38f, v1 = -3.0e38f, v2 = -3.0e38f; int i0 = -1, i1 = -1, i2 = -1;
            for (int n = 0; n < own; ++n) { const float s = sr[n];
                if (s > v0) { v2 = v1; i2 = i1; v1 = v0; i1 = i0; v0 = s; i0 = n; } else if (s > v1) { v2 = v1; i2 = i1; v1 = s; i1 = n; } else if (s > v2) { v2 = s; i2 = n; } }
            sel[0] = i0; sel[1] = i1; sel[2] = i2;
            const int tl_ = own * BLK + tid; const float qn = __builtin_amdgcn_sqrtf(qnL[tid]) * 0.08838834764831845f, kself = ((const float*)(P.ws + WS_S + S_MOBA_KN))[((size_t)b * SEQ + tl_) * NH + h], slope = exp2f(-(float)(h + 1));
            unsigned mbits = 0u;
#pragma unroll
            for (int s = 0; s < 3; ++s) if (sel[s] >= 0) { const float bound = qn * (kmxL[sel[s]] + kself) - slope * (float)(tl_ - (sel[s] * BLK + BLK - 1));
                if (bound < -110.0f) sel[s] = -1; else mbits |= 1u << s; }
            ((unsigned char*)(P.ws + WS_S + S_MOBA_MASK))[((size_t)b * SEQ + tl_) * NH + h] = (unsigned char)mbits;
#pragma unroll
            for (int s = 0; s < 3; ++s) lp[s] = (sel[s] >= 0) ? __hip_atomic_fetch_add(cntL + sel[s], 1, __ATOMIC_RELAXED, __HIP_MEMORY_SCOPE_WORKGROUP) : 0;
        }
        __syncthreads();
        if (tid < 64) { const int c = cntL[tid]; baseL[tid] = (c > 0) ? atomicAdd(cnt + (b * NH + h) * NBLK + tid, c) : 0; }
        __syncthreads();
        if (tid < 256) { const int tl = own * BLK + tid;
#pragma unroll
            for (int s = 0; s < 3; ++s) if (sel[s] >= 0) list[(size_t)((b * NH + h) * NBLK + sel[s]) * SEQ + baseL[sel[s]] + lp[s]] = (unsigned short)((tl << 2) | s); }
    }
}

constexpr int AT_KSTRIDE = 272, AT_VS = 256 * 272, AT_VSTRIDE = 288, AT_PREF = AT_VS + 256 * 288;
typedef short s16x4 __attribute__((ext_vector_type(4)));
struct AtRegs { u32x4 p[8]; bf16x8 q[4]; unsigned mbits; float ls[3]; };
#define AT_BAR() do { asm volatile("s_waitcnt lgkmcnt(0)" ::: "memory"); __builtin_amdgcn_s_barrier(); asm volatile("" ::: "memory"); } while (0)
template <bool OWN>
__device__ __forceinline__ void attn_issue_kq(const Params& P, int b, int h, int j, int tl, int tid, AtRegs& R) {
    const bf16_t* qkvb = (const bf16_t*)(P.ws + WS_S + S_MOBA_QKV) + (size_t)b * SEQ * 3072;
    const int piece = tid & 15, r0 = tid >> 4, quad = (tid & 63) >> 4;
    const char* kp = (const char*)(qkvb + (size_t)(j * BLK + 8 * ((r0 & 15) >> 2) + 4 * (r0 >> 4) + (r0 & 3)) * 3072 + DM + h * HD + piece * 8);
#pragma unroll
    for (int it = 0; it < 8; ++it) R.p[it] = *(const u32x4*)(kp + (size_t)it * (32 * 3072 * 2));
    const bf16_t* qp = qkvb + (size_t)tl * 3072 + h * HD + quad * 8;
#pragma unroll
    for (int ks = 0; ks < 4; ++ks) R.q[ks] = *(const bf16x8*)(qp + 32 * ks);
    if (OWN) { R.mbits = (j != 0) ? (unsigned)((const unsigned char*)(P.ws + WS_S + S_MOBA_MASK))[((size_t)b * SEQ + tl) * NH + h] : 0u;
        const float* plse = (const float*)(P.ws + WS_S + S_MOBA_LSE) + ((size_t)tl * NH + h) * 3;
#pragma unroll
        for (int s = 0; s < 3; ++s) R.ls[s] = plse[s]; }
}
template <bool OWN, int nkb>
__device__ __forceinline__ void attn_tile(const Params& P, LAS unsigned char* lds, int b, int h, int j, int tl, bool valid, int slot, AtRegs& R, bool hasN, int hN, int jN, int tlN) {
    const int tid = opaque_tid(), lane = tid & 63, i = lane & 15, quad = lane >> 4, piece = tid & 15, r0 = tid >> 4;
    bf16_t* qkvb = (bf16_t*)(P.ws + WS_S + S_MOBA_QKV) + (size_t)b * SEQ * 3072;
    AT_BAR();
#pragma unroll
    for (int it = 0; it < 8; ++it) *(LAS u32x4*)(lds + (r0 + 32 * it) * AT_KSTRIDE + piece * 16) = R.p[it];
    bf16x8 qf[4]; unsigned mbits = 0u; float ls[3] = {0.f, 0.f, 0.f};
#pragma unroll
    for (int ks = 0; ks < 4; ++ks) qf[ks] = R.q[ks];
    if (OWN) { mbits = R.mbits;
#pragma unroll
        for (int s = 0; s < 3; ++s) ls[s] = R.ls[s]; }
    AT_BAR();
    bf16_t* op = qkvb + (size_t)tl * 3072 + h * HD + 4 * quad;
    u32x2 pv[3][8];
    if (OWN) { const bf16_t* ppo = (const bf16_t*)(P.ws + WS_S + S_MOBA_PO) + ((size_t)tl * NH + h) * 3 * HD + 4 * quad;
#pragma unroll
        for (int s = 0; s < 3; ++s) { const bf16_t* src = ((mbits >> s) & 1u) ? ppo + (size_t)s * HD : op;
#pragma unroll
            for (int db = 0; db < 8; ++db) pv[s][db] = *(const u32x2*)(src + 16 * db); } }
    { const char* vp = (const char*)(qkvb + (size_t)(j * BLK + r0) * 3072 + 2 * DM + h * HD + piece * 8);
#pragma unroll
      for (int it = 0; it < 8; ++it) R.p[it] = *(const u32x4*)(vp + (size_t)it * (32 * 3072 * 2)); }
    f32x4 sc[16];
#pragma unroll
    for (int kb = 0; kb < 16; ++kb) {
        sc[kb] = (f32x4){0.f, 0.f, 0.f, 0.f};
        if (kb < nkb) {
#pragma unroll
            for (int ks = 0; ks < 4; ++ks) { const bf16x8 kf = *(const LAS bf16x8*)(lds + (16 * kb + i) * AT_KSTRIDE + (32 * ks + 8 * quad) * 2);
                sc[kb] = __builtin_amdgcn_mfma_f32_16x16x32_bf16(kf, qf[ks], sc[kb], 0, 0, 0); }
        }
    }
    const float slope = fast_exp2(-(float)(h + 1)) * LOG2E, scale = 0.08838834764831845f * LOG2E;
    float mx = -3.0e38f;
    const int rq = tl - j * BLK - 8 * quad; const float c0 = -slope * (float)rq;
#pragma unroll
    for (int kb = 0; kb < 16; ++kb) if (kb < nkb) {
#pragma unroll
        for (int jj = 0; jj < 4; ++jj) { const int K = 32 * (kb >> 1) + 4 * (kb & 1) + jj;
            float s = fmaf(sc[kb][jj], scale, fmaf(slope, (float)K, c0)); if (OWN && K > rq) s = -1.0e30f; sc[kb][jj] = s; mx = fmaxf(mx, s); }
    }
    mx = fmaxf(mx, __shfl_xor(mx, 16)); mx = fmaxf(mx, __shfl_xor(mx, 32));
    float l = 0.f;
#pragma unroll
    for (int kb = 0; kb < 16; ++kb) if (kb < nkb) {
#pragma unroll
        for (int jj = 0; jj < 4; ++jj) { const float p = fast_exp2(sc[kb][jj] - mx); sc[kb][jj] = p; l += p; }
    }
    l += __shfl_xor(l, 16); l += __shfl_xor(l, 32);
    const float lse = (mx + __log2f(l)) * LN2;
    f32x4 oacc[8];
    if (OWN) {
        float M = lse;
#pragma unroll
        for (int s = 0; s < 3; ++s) { ls[s] = ((mbits >> s) & 1u) ? ls[s] : -3.0e38f; M = fmaxf(M, ls[s]); }
        const float wown = __expf(lse - M); float wsl[3]; float den = wown;
#pragma unroll
        for (int s = 0; s < 3; ++s) { wsl[s] = ((mbits >> s) & 1u) ? __expf(ls[s] - M) : 0.f; den += wsl[s]; }
        const float rden = fast_rcp(den), wo = wown * fast_rcp(l) * rden;
#pragma unroll
        for (int s = 0; s < 3; ++s) wsl[s] *= rden;
#pragma unroll
        for (int kb = 0; kb < 16; ++kb) if (kb < nkb) sc[kb] = sc[kb] * wo;
#pragma unroll
        for (int db = 0; db < 8; ++db) { f32x4 o = (f32x4){0.f, 0.f, 0.f, 0.f};
#pragma unroll
            for (int s = 0; s < 3; ++s) { const u32x2 q = pv[s][db]; const float ww = wsl[s];
                o[0] += ww * bf_lo(q.x); o[1] += ww * bf_hi(q.x); o[2] += ww * bf_lo(q.y); o[3] += ww * bf_hi(q.y); }
            oacc[db] = o; }
    } else {
#pragma unroll
        for (int db = 0; db < 8; ++db) oacc[db] = (f32x4){0.f, 0.f, 0.f, 0.f};
    }
    bf16x8 pf[8];
#pragma unroll
    for (int s = 0; s < 8; ++s) if (2 * s < nkb) pf[s] = pack8(sc[2 * s], sc[2 * s + 1]);
#pragma unroll
    for (int it = 0; it < 8; ++it) *(LAS u32x4*)(lds + AT_VS + (r0 + 32 * it) * AT_VSTRIDE + piece * 16) = R.p[it];
    AT_BAR();
    if (hasN) attn_issue_kq<OWN>(P, b, hN, jN, tlN, tid, R);
#pragma unroll
    for (int s = 0; s < 8; ++s) if (2 * s < nkb) {
#pragma unroll
        for (int db = 0; db < 8; ++db) {
            const LAS unsigned char* vp = lds + AT_VS + (32 * s + 8 * quad + (i >> 2)) * AT_VSTRIDE + (16 * db + 4 * (i & 3)) * 2;
            const s16x4 lo = __builtin_amdgcn_ds_read_tr16_b64_v4i16((LAS s16x4*)vp), hi = __builtin_amdgcn_ds_read_tr16_b64_v4i16((LAS s16x4*)(vp + 4 * AT_VSTRIDE));
            const bf16x8 vf = __builtin_shufflevector(lo, hi, 0, 1, 2, 3, 4, 5, 6, 7);
            oacc[db] = __builtin_amdgcn_mfma_f32_16x16x32_bf16(vf, pf[s], oacc[db], 0, 0, 0); }
    }
    if (!OWN) {
        if (valid) {
            const float inv = fast_rcp(l); const size_t pr = ((size_t)tl * NH + h) * 3 + slot;
            bf16_t* po = (bf16_t*)(P.ws + WS_S + S_MOBA_PO) + pr * HD + 4 * quad;
#pragma unroll
            for (int db = 0; db < 8; ++db) { u32x2 w; w.x = cvt_pk_bf16(oacc[db][0] * inv, oacc[db][1] * inv); w.y = cvt_pk_bf16(oacc[db][2] * inv, oacc[db][3] * inv); *(u32x2*)(po + 16 * db) = w; }
            if (quad == 0) ((float*)(P.ws + WS_S + S_MOBA_LSE))[pr] = lse;
        }
    } else {
#pragma unroll
        for (int db = 0; db < 8; ++db) { u32x2 w; w.x = cvt_pk_bf16(oacc[db][0], oacc[db][1]); w.y = cvt_pk_bf16(oacc[db][2], oacc[db][3]); *(u32x2*)(op + 16 * db) = w; }
    }
}

__device__ __forceinline__ void phase_moba_gather(const Params& P, LAS unsigned char* lds, int mj, int b, int wg, int G) {
    const int* cnt = (const int*)(P.ws + WS_CTL + CTL_CNT) + mj * 1024 + b * 512;
    const unsigned short* list = (const unsigned short*)(P.ws + WS_S + S_MOBA_LIST) + (size_t)b * 512 * SEQ;
    const int tid = opaque_tid(), lane = tid & 63, wid = tid >> 6;
    LAS int* pref = (LAS int*)(lds + AT_PREF); LAS int* cl = pref + 520; LAS int* wtot = cl + 512;
    __syncthreads();
    { const int c = cnt[tid]; int v = (c + 127) >> 7; cl[tid] = c;
#pragma unroll
      for (int o = 1; o < 64; o <<= 1) { const int y = __shfl_up(v, o); if (lane >= o) v += y; }
      if (lane == 63) wtot[wid] = v;
      __syncthreads();
      int base = 0; for (int w = 0; w < wid; ++w) base += wtot[w];
      pref[tid + 1] = base + v; if (tid == 0) pref[0] = 0; }
    __syncthreads();
    const int total = pref[512];
    const int nx = G >> 3, xr = (G & 7) ? 0 : 1;
    int item = xr ? (wg & 7) * nx + (wg >> 3) : wg;
    if (item >= total) return;
#define AT_DECODE(it_, hj_, va_, ad_) do { int lo_ = 0, hi_ = 512; while (hi_ - lo_ > 1) { const int mid_ = (lo_ + hi_) >> 1; if (pref[mid_] <= (it_)) lo_ = mid_; else hi_ = mid_; } \
        hj_ = lo_; const int c_ = cl[lo_], e_ = ((it_) - pref[lo_]) * 128 + 16 * wid + (lane & 15); va_ = e_ < c_; ad_ = list + (size_t)lo_ * SEQ + (va_ ? e_ : c_ - 1); } while (0)
    int hjA, hjB = 0, hjC = 0; bool vaA, vaB = false, vaC = false; const unsigned short* ad; unsigned eA, eB = 0, eC = 0;
    AT_DECODE(item, hjA, vaA, ad); eA = *ad;
    bool hasB = item + G < total;
    if (hasB) { AT_DECODE(item + G, hjB, vaB, ad); eB = *ad; }
    AtRegs R;
    attn_issue_kq<false>(P, b, hjA >> 6, hjA & 63, (int)(eA >> 2), tid, R);
    for (;;) {
        const bool hasC = item + 2 * G < total;
        if (hasC) { AT_DECODE(item + 2 * G, hjC, vaC, ad); eC = *ad; }
        attn_tile<false, 16>(P, lds, b, hjA >> 6, hjA & 63, (int)(eA >> 2), vaA, (int)(eA & 3), R, hasB, hjB >> 6, hjB & 63, (int)(eB >> 2));
        if (!hasB) break;
        hjA = hjB; vaA = vaB; eA = eB; hjB = hjC; vaB = vaC; eB = eC; hasB = hasC; item += G;
    }
#undef AT_DECODE
}
__device__ __forceinline__ void phase_moba_own(const Params& P, LAS unsigned char* lds, int b, int wg, int G) {
    const int tid = opaque_tid(), lane = tid & 63, wid = tid >> 6;
    const int nx = G >> 3, xr = (G & 7) ? 0 : 1;
    int it = xr ? (wg & 7) * nx + (wg >> 3) : wg;
    if (it >= 1024) return;
#define AT_OWN(it_, h_, j_, c_, tl_) do { const int hj_ = (it_) >> 1; c_ = (((it_) >> 8) ^ (it_)) & 1; h_ = hj_ >> 6; j_ = hj_ & 63; tl_ = j_ * BLK + 128 * c_ + 16 * wid + (lane & 15); } while (0)
    int hA, jA, cA, tlA, hB = 0, jB = 0, cB = 0, tlB = 0;
    AT_OWN(it, hA, jA, cA, tlA);
    AtRegs R;
    attn_issue_kq<true>(P, b, hA, jA, tlA, tid, R);
    for (;;) {
        const bool hasB = it + G < 1024;
        if (hasB) AT_OWN(it + G, hB, jB, cB, tlB);
        if (cA) attn_tile<true, 16>(P, lds, b, hA, jA, tlA, true, 0, R, hasB, hB, jB, tlB); else attn_tile<true, 8>(P, lds, b, hA, jA, tlA, true, 0, R, hasB, hB, jB, tlB);
        if (!hasB) break;
        hA = hB; jA = jB; cA = cB; tlA = tlB; it += G;
    }
#undef AT_OWN
}
__device__ __forceinline__ void phase_gdn_bg(const Params& P, int wg, int G) {
    const int tid = opaque_tid(), lane = tid & 63, wave = tid >> 6, gw = wg * 8 + wave, NGW = G * 8;
    const bf16_t* X = (const bf16_t*)(P.ws + WS_XB); const u64_t* ssq = (const u64_t*)(P.ws + WS_SSQ) + (size_t)4 * T_TOK; const float* bgw = (const float*)(P.ws + WS_MISC + MISC_BGW);
    float* bg = (float*)(P.ws + WS_S + S_GDN_BG); const float* alog = P.in[IN_GDN_ALOG]; const float* dtb = P.in[IN_GDN_DTB];
    for (int t = gw; t < T_TOK; t += NGW) {
        const u32x2* xr = (const u32x2*)(X + (size_t)t * DM) + lane; f32x4 x4[4];
#pragma unroll
        for (int jj = 0; jj < 4; ++jj) x4[jj] = bf4(xr[64 * jj]);
        float mine = 0.f;
#pragma unroll
        for (int c = 0; c < 16; ++c) { const f32x4* wr_ = (const f32x4*)(bgw + (size_t)c * DM) + lane; float a = 0.f;
#pragma unroll
            for (int jj = 0; jj < 4; ++jj) { const f32x4 w4 = wr_[64 * jj]; a += (x4[jj][0] * w4[0] + x4[jj][1] * w4[1]) + (x4[jj][2] * w4[2] + x4[jj][3] * w4[3]); }
            a = wave_sum(a); if (lane == c) mine = a; }
        if (lane < 16) { const float raw = mine * ssq_rs(ssq[t]); float o;
            if (lane < 8) o = fast_rcp(1.0f + __expf(-raw));
            else { const int hh = lane - 8; const float xx = raw + dtb[hh]; const float sp = fmaxf(xx, 0.f) + __logf(1.0f + __expf(-fabsf(xx))); o = -__expf(alog[hh]) * sp; }
            bg[(size_t)t * 16 + lane] = o; }
    }
}
__device__ __forceinline__ u32x2 pack4(f32x4 v) { u32x2 w; w.x = cvt_pk_bf16(v[0], v[1]); w.y = cvt_pk_bf16(v[2], v[3]); return w; }
__device__ __forceinline__ void phase_gdn_chunk2(const Params& P, LAS unsigned char* lds, int wg, int G) {
    bf16_t* proj = (bf16_t*)(P.ws + WS_S + S_GDN_PROJ); bf16_t* attn = (bf16_t*)(P.ws + WS_S + S_GDN_ATTN); const float* bg = (const float*)(P.ws + WS_S + S_GDN_BG);
    const bf16_t* halo = (const bf16_t*)(P.ws + WS_S + S_GDN_HALO); float* gcum = (float*)(P.ws + WS_S + S_GDN_GC); bf16_t* wbuf = (bf16_t*)P.out; const float* cw = P.in[IN_GDN_CONV];
    LAS float* qL = (LAS float*)lds; LAS float* kL = qL + 64 * 132; LAS float* vL = kL + 64 * 132; LAS float* AL = vL + 64 * 132;
    LAS unsigned char* Qb = lds + 118784; LAS unsigned char* Kb = lds + 136192; LAS float* betaL = (LAS float*)(lds + 153600); LAS float* gcL = betaL + 64; LAS float* DinvL = (LAS float*)(lds + 154112);
    const int tid = opaque_tid(), lane = tid & 63, wave = __builtin_amdgcn_readfirstlane(tid >> 6), i16 = lane & 15, quad = lane >> 4;
    for (int u = wg; u < 4096; u += G) {
        const int b = u >> 11, h = (u >> 8) & 7, n = u & 255; const size_t t0 = (size_t)b * SEQ + (size_t)n * 64;
        bf16_t* projw = proj + t0 * 4096;
        __syncthreads();
        float be_pre = 0.f, gg_pre = 0.f;
        if (wave == 0) { const float* bgp = bg + (t0 + lane) * 16; be_pre = bgp[h]; gg_pre = bgp[8 + h]; }
        if (tid < 384) { const int mat = tid >> 7, d = tid & 127, col = mat * DM + h * HD + d;
            const float w0 = cw[col], w1 = cw[3072 + col], w2 = cw[2 * 3072 + col], w3 = cw[3 * 3072 + col];
            float x3 = 0.f, x2 = 0.f, x1 = 0.f;
            if (n > 0) { const bf16_t* hp = halo + ((t0 >> 6) - 1) * 3 * 3072 + col; x3 = bf2f(hp[0]); x2 = bf2f(hp[3072]); x1 = bf2f(hp[2 * 3072]); }
            const bf16_t* src = proj + t0 * 4096 + col; unsigned off = 0; bf16_t raw[64];
#pragma unroll
            for (int i = 0; i < 64; ++i) { raw[i] = src[off]; off += 4096; asm volatile("" : "+v"(off)); }
            __builtin_amdgcn_sched_barrier(0);
            LAS float* dst = (mat == 0 ? qL : (mat == 1 ? kL : vL)) + d;
#pragma unroll
            for (int i = 0; i < 64; ++i) { const float x0 = bf2f(raw[i]); dst[i * 132] = silu_f(w3 * x0 + w2 * x1 + w1 * x2 + w0 * x3); x3 = x2; x2 = x1; x1 = x0; } }
        __syncthreads();
#pragma unroll 4
        for (int rr = 0; rr < 16; ++rr) { const int r = wave * 16 + rr; LAS float* rowp = (r < 64 ? qL + r * 132 : kL + (r - 64) * 132) + 2 * lane;
            f32x2 v = *(LAS f32x2*)rowp; const float ss = wave_sum(v.x * v.x + v.y * v.y); const float scl = __builtin_amdgcn_rsqf(ss + EPS) * (r < 64 ? 0.08838834764831845f : 1.0f); v = v * scl; *(LAS f32x2*)rowp = v;
            *(LAS unsigned*)((r < 64 ? Qb : Kb) + (r & 63) * 272 + lane * 4) = cvt_pk_bf16(v.x, v.y); }
        if (wave == 0) { const float be = be_pre; float gg = gg_pre;
#pragma unroll
            for (int o = 1; o < 64; o <<= 1) { const float y = __shfl_up(gg, o); if (lane >= o) gg += y; }
            betaL[lane] = be; gcL[lane] = gg; gcum[(size_t)u * 64 + lane] = gg; }
        __syncthreads();
        {
            const int mat = wave >> 2, rb = wave & 3; const LAS unsigned char* Xb = mat ? Qb : Kb;
            bf16x8 af[4];
#pragma unroll
            for (int ks = 0; ks < 4; ++ks) af[ks] = *(const LAS bf16x8*)(Xb + (16 * rb + i16) * 272 + (32 * ks + 8 * quad) * 2);
            float gr[4], br[4];
#pragma unroll
            for (int jj = 0; jj < 4; ++jj) { gr[jj] = gcL[16 * rb + 4 * quad + jj]; br[jj] = betaL[16 * rb + 4 * quad + jj]; }
#pragma unroll
            for (int cb = 0; cb < 4; ++cb) {
                f32x4 acc = (f32x4){0.f, 0.f, 0.f, 0.f};
                if (cb <= rb) {
#pragma unroll
                    for (int ks = 0; ks < 4; ++ks) acc = __builtin_amdgcn_mfma_f32_16x16x32_bf16(af[ks], *(const LAS bf16x8*)(Kb + (16 * cb + i16) * 272 + (32 * ks + 8 * quad) * 2), acc, 0, 0, 0); }
                const int j = 16 * cb + i16; const float gj = gcL[j];
                const int pj = 32 * (cb >> 1) + 8 * (i16 >> 2) + 4 * (cb & 1) + (i16 & 3);
#pragma unroll
                for (int jj = 0; jj < 4; ++jj) { const int r = 16 * rb + 4 * quad + jj; const float dec = (j <= r) ? __expf(gr[jj] - gj) : 0.f;
                    if (mat == 0) AL[r * 68 + j] = (j < r) ? acc[jj] * br[jj] * dec : 0.f;
                    else *(LAS bf16_t*)(lds + 154112 + ((((r >> 4) * 2 + (pj >> 5)) * 64 + ((pj >> 3) & 3) * 16 + (r & 15)) * 8 + (pj & 7)) * 2) = f2bf((j <= r) ? acc[jj] * dec : 0.f); }
            }
        }
        __syncthreads();
        *(u32x4*)(attn + (size_t)u * 4096 + tid * 8) = *(const LAS u32x4*)(lds + 154112 + tid * 16);
#pragma unroll
        for (int k = 0; k < 2; ++k) { const int pi = tid + 512 * k, l_ = pi & 63, i_ = l_ & 15, q_ = l_ >> 4;
            { const int rb_ = pi >> 8, ks_ = (pi >> 6) & 3;
              *(u32x4*)(projw + (size_t)(pi >> 4) * 4096 + h * HD + (pi & 15) * 8) = *(const LAS u32x4*)(Qb + (16 * rb_ + i_) * 272 + (32 * ks_ + 8 * q_) * 2); }
            { const int w_ = pi >> 7, ks_ = (pi >> 6) & 1, dk = 16 * w_ + i_, p0 = 32 * ks_ + 8 * q_; float kv[8];
#pragma unroll
              for (int e = 0; e < 8; ++e) { const int tok = 16 * (2 * (p0 >> 5) + (e >> 2)) + 4 * ((p0 >> 3) & 3) + (e & 3); kv[e] = kL[tok * 132 + dk]; }
              u32x4 w; w.x = cvt_pk_bf16(kv[0], kv[1]); w.y = cvt_pk_bf16(kv[2], kv[3]); w.z = cvt_pk_bf16(kv[4], kv[5]); w.w = cvt_pk_bf16(kv[6], kv[7]);
              *(u32x4*)(projw + (size_t)(pi >> 4) * 4096 + DM + h * HD + (pi & 15) * 8) = w; } }
#pragma unroll
        for (int it = 0; it < 8; ++it) { const int p = tid + 512 * it, row = p >> 6, d = (p & 63) * 2;
            const f32x2 kv = *(LAS f32x2*)(kL + row * 132 + d), vv = *(LAS f32x2*)(vL + row * 132 + d);
            const float be = betaL[row], eg = __expf(gcL[row]);
            *(LAS f32x2*)(qL + row * 132 + d) = kv * (be * eg); *(LAS f32x2*)(vL + row * 132 + d) = vv * be; }
        __syncthreads();
        {
            { const int blk = lane >> 4, c = lane & 15; float y[16];
#pragma unroll
              for (int r = 0; r < 16; ++r) y[r] = (r == c) ? 1.0f : 0.0f;
#pragma unroll
              for (int r = 1; r < 16; ++r) { float s = 0.f;
#pragma unroll
                  for (int j4 = 0; j4 <= (r - 1) / 4; ++j4) { const f32x4 a4 = *(const LAS f32x4*)(AL + (16 * blk + r) * 68 + 16 * blk + 4 * j4);
                      s += a4[0] * y[4 * j4] + a4[1] * y[4 * j4 + 1] + a4[2] * y[4 * j4 + 2] + a4[3] * y[4 * j4 + 3]; }
                  y[r] -= s; }
#pragma unroll
              for (int r = 0; r < 16; ++r) DinvL[(16 * blk + r) * 16 + c] = y[r]; }
            LAS float* Xm = (wave < 4 ? vL : qL) + 32 * (wave & 3) + i16;
#pragma unroll 1
            for (int bi = 0; bi < 4; ++bi)
#pragma unroll 1
                for (int cbl = 0; cbl < 2; ++cbl) {
                    LAS float* Xc = Xm + 16 * cbl; f32x4 acc;
#pragma unroll
                    for (int jj = 0; jj < 4; ++jj) acc[jj] = Xc[(16 * bi + 4 * quad + jj) * 132];
#pragma unroll 1
                    for (int k = 0; k < bi; ++k)
#pragma unroll
                        for (int ks = 0; ks < 4; ++ks) acc = __builtin_amdgcn_mfma_f32_16x16x4f32(-AL[(16 * bi + i16) * 68 + 16 * k + 4 * ks + quad], Xc[(16 * k + 4 * ks + quad) * 132], acc, 0, 0, 0);
#pragma unroll
                    for (int jj = 0; jj < 4; ++jj) Xc[(16 * bi + 4 * quad + jj) * 132] = acc[jj];
                    f32x4 acc2 = (f32x4){0.f, 0.f, 0.f, 0.f};
#pragma unroll
                    for (int ks = 0; ks < 4; ++ks) acc2 = __builtin_amdgcn_mfma_f32_16x16x4f32(DinvL[(16 * bi + i16) * 16 + 4 * ks + quad], Xc[(16 * bi + 4 * ks + quad) * 132], acc2, 0, 0, 0);
#pragma unroll
                    for (int jj = 0; jj < 4; ++jj) Xc[(16 * bi + 4 * quad + jj) * 132] = acc2[jj];
                }
        }
        __syncthreads();
#pragma unroll
        for (int k = 0; k < 2; ++k) { const int pi = tid + 512 * k, q_ = pi & 3, l_ = (pi >> 2) & 63, rb_ = pi >> 8, tok = 16 * rb_ + 4 * (l_ >> 4), col = 32 * q_ + (l_ & 15);
            float uv[8];
#pragma unroll
            for (int e = 0; e < 8; ++e) uv[e] = vL[(tok + (e & 3)) * 132 + col + 16 * (e >> 2)];
            u32x4 w; w.x = cvt_pk_bf16(uv[0], uv[1]); w.y = cvt_pk_bf16(uv[2], uv[3]); w.z = cvt_pk_bf16(uv[4], uv[5]); w.w = cvt_pk_bf16(uv[6], uv[7]);
            *(u32x4*)(projw + (size_t)(pi >> 4) * 4096 + 2 * DM + h * HD + (pi & 15) * 8) = w; }
#pragma unroll
        for (int k = 0; k < 2; ++k) { const int pi = tid + 512 * k, l_ = pi & 63, rb_ = pi >> 8, ks_ = (pi >> 6) & 3;
            const LAS f32x4* wp = (const LAS f32x4*)(qL + (16 * rb_ + (l_ & 15)) * 132 + 32 * ks_ + 8 * (l_ >> 4)); const f32x4 a = wp[0], c = wp[1];
            u32x4 w; w.x = cvt_pk_bf16(a[0], a[1]); w.y = cvt_pk_bf16(a[2], a[3]); w.z = cvt_pk_bf16(c[0], c[1]); w.w = cvt_pk_bf16(c[2], c[3]);
            *(u32x4*)(wbuf + (t0 + (pi >> 4)) * DM + h * HD + (pi & 15) * 8) = w; }
    }
}
constexpr size_t DO_GP = 64 * MiB, DO_GQ = 72 * MiB, DO_GS = 88 * MiB;
#define GS_BAR() do { asm volatile("s_waitcnt lgkmcnt(0)" ::: "memory"); __builtin_amdgcn_s_barrier(); asm volatile("" ::: "memory"); } while (0)
__device__ __forceinline__ u32x2 packsoft4(f32x4 v) { u32x2 w; w.x = (unsigned)f2bf(v[0]) | ((unsigned)f2bf(v[1]) << 16); w.y = (unsigned)f2bf(v[2]) | ((unsigned)f2bf(v[3]) << 16); return w; }
__device__ __forceinline__ void phase_gdn_scanA(const Params& P, LAS unsigned char* lds, int wg, int G) {
    const bf16_t* proj = (const bf16_t*)(P.ws + WS_S + S_GDN_PROJ); const float* gcum = (const float*)(P.ws + WS_S + S_GDN_GC); const bf16_t* wbuf = (const bf16_t*)P.out;
    bf16_t* GP = (bf16_t*)((unsigned char*)P.out + DO_GP); float* GQ = (float*)((unsigned char*)P.out + DO_GQ);
    const int tid = opaque_tid(), lane = tid & 63, wave = __builtin_amdgcn_readfirstlane(tid >> 6), i16 = lane & 15, quad = lane >> 4, rb = wave & 3, hf = wave >> 2;
    LAS unsigned char* ST = lds; LAS unsigned char* VN2 = lds + 69632;
    const int p0 = 32 * (rb >> 1) + 8 * quad + 4 * (rb & 1);
    for (int task = wg; task < 256; task += G) {
        const int bh = task >> 4, g = task & 15, b = bh >> 3, h = bh & 7; const size_t t0 = (size_t)b * SEQ + (size_t)g * 1024, u0 = (size_t)bh * 256 + (size_t)g * 16;
        f32x4 sacc[16]; int dgo = i16 - 4 * quad; asm volatile("" : "+v"(dgo));
#pragma unroll
        for (int cb = 0; cb < 16; ++cb)
#pragma unroll
            for (int jj = 0; jj < 4; ++jj) sacc[cb][jj] = (cb < 8 && cb == wave && dgo == jj) ? 1.0f : 0.0f;
        __syncthreads();
#pragma unroll
        for (int cb = 0; cb < 16; ++cb) *(LAS u32x2*)(ST + (16 * cb + i16) * 272 + (16 * wave + 4 * quad) * 2) = pack4(sacc[cb]);
        const char* pA = (const char*)(wbuf + (t0 + 16 * rb + quad) * DM + h * HD + 8 * i16);
        const char* pK = (const char*)(proj + (t0 + 8 * wave + quad) * 4096 + DM + h * HD + 8 * i16);
        const char* pU = (const char*)(proj + (t0 + 16 * rb + (lane >> 2)) * 4096 + 2 * DM + h * HD + (lane & 3) * 32);
        const char* pG = (const char*)(gcum + u0 * 64 + 16 * rb + 4 * quad); const char* pGl = (const char*)(gcum + u0 * 64 + 63);
        bf16x8 fa[2][4], fk[2][2]; u32x4 uu[2][4]; f32x4 g4[2]; float gl[2];
#define GA_LOAD_A(S) do { _Pragma("unroll") for (int ks_ = 0; ks_ < 4; ++ks_) fa[S][ks_] = *(const bf16x8*)(pA + (size_t)ks_ * (4 * DM * 2)); \
        if (hf) { _Pragma("unroll") for (int q_ = 0; q_ < 4; ++q_) uu[S][q_] = *(const u32x4*)(pU + q_ * 16); } \
        g4[S] = *(const f32x4*)pG; gl[S] = *(const float*)pGl; pA += 64 * DM * 2; pU += 64 * 8192; pG += 256; pGl += 256; } while (0)
#define GA_LOAD_B(S) do { _Pragma("unroll") for (int ks_ = 0; ks_ < 2; ++ks_) fk[S][ks_] = *(const bf16x8*)(pK + (size_t)ks_ * 32768); pK += 64 * 8192; } while (0)
#pragma unroll
        for (int s_ = 0; s_ < 2; ++s_)
#pragma unroll
            for (int q_ = 0; q_ < 4; ++q_) uu[s_][q_] = (u32x4){0u, 0u, 0u, 0u};
        GA_LOAD_A(0); GA_LOAD_B(0); GA_LOAD_A(1); GA_LOAD_B(1);
        GS_BAR();
#define GA_STEP(nn, S) do { \
        const float glast_ = gl[S]; f32x4 ed_; \
        _Pragma("unroll") for (int jj_ = 0; jj_ < 4; ++jj_) ed_[jj_] = __expf(glast_ - g4[S][jj_]); \
        _Pragma("unroll") for (int c4_ = 0; c4_ < 8; c4_ += 4) { f32x4 acc1[4];        \
            _Pragma("unroll") for (int c_ = 0; c_ < 4; ++c_) { acc1[c_] = (f32x4){0.f, 0.f, 0.f, 0.f}; \
                _Pragma("unroll") for (int ks_ = 0; ks_ < 4; ++ks_) acc1[c_] = __builtin_amdgcn_mfma_f32_16x16x32_bf16(fa[S][ks_], *(const LAS bf16x8*)(ST + (16 * (8 * hf + c4_ + c_) + i16) * 272 + (32 * ks_ + 8 * quad) * 2), acc1[c_], 0, 0, 0); } \
            _Pragma("unroll") for (int c_ = 0; c_ < 4; ++c_) { const int cc_ = c4_ + c_; const unsigned ua_ = uu[S][cc_ >> 1][2 * (cc_ & 1)], ub_ = uu[S][cc_ >> 1][2 * (cc_ & 1) + 1]; f32x4 vn2_; \
                vn2_[0] = (bf_lo(ua_) - acc1[c_][0]) * ed_[0]; vn2_[1] = (bf_hi(ua_) - acc1[c_][1]) * ed_[1]; vn2_[2] = (bf_lo(ub_) - acc1[c_][2]) * ed_[2]; vn2_[3] = (bf_hi(ub_) - acc1[c_][3]) * ed_[3]; \
                *(LAS u32x2*)(VN2 + (16 * (8 * hf + cc_) + i16) * 144 + p0 * 2) = pack4(vn2_); } \
            asm volatile("" ::: "memory"); } \
        if ((nn) + 2 < 16) GA_LOAD_A(S); \
        GS_BAR(); \
        const float eg_ = __expf(glast_); \
        _Pragma("unroll") for (int cb_ = 0; cb_ < 16; ++cb_) { f32x4 acc_ = sacc[cb_] * eg_; \
            _Pragma("unroll") for (int ks_ = 0; ks_ < 2; ++ks_) acc_ = __builtin_amdgcn_mfma_f32_16x16x32_bf16(fk[S][ks_], *(const LAS bf16x8*)(VN2 + (16 * cb_ + i16) * 144 + (32 * ks_ + 8 * quad) * 2), acc_, 0, 0, 0); \
            sacc[cb_] = acc_; *(LAS u32x2*)(ST + (16 * cb_ + i16) * 272 + (16 * wave + 4 * quad) * 2) = packsoft4(acc_); \
            if ((cb_ & 3) == 3) asm volatile("" ::: "memory"); } \
        if ((nn) + 2 < 16) GA_LOAD_B(S); \
        GS_BAR(); } while (0)
#pragma unroll 1
        for (int n = 0; n < 16; n += 2) { GA_STEP(n, 0); GA_STEP(n + 1, 1); }
#undef GA_STEP
#undef GA_LOAD_A
#undef GA_LOAD_B
#pragma unroll
        for (int cb = 0; cb < 8; ++cb)
#pragma unroll
            for (int jj = 0; jj < 4; ++jj) GP[(size_t)task * 16384 + (16 * wave + 4 * quad + jj) * 128 + 16 * cb + i16] = f2bf(sacc[cb][jj]);
#pragma unroll
        for (int cb = 0; cb < 8; ++cb) *(f32x4*)(GQ + (((size_t)task * 8 + wave) * 64 + lane) * 32 + cb * 4) = sacc[8 + cb];
    }
}
__device__ __forceinline__ void phase_gdn_scanB(const Params& P, LAS unsigned char* lds, int wg, int G) {
    const int bh = (G % 8 == 0 && G >= 16) ? (wg >> 3) + 2 * (wg & 7) : wg;
    if ((G % 8 == 0 && G >= 16) ? (wg >> 3) >= 2 : wg >= 16) return;
    const bf16_t* GP = (const bf16_t*)((const unsigned char*)P.out + DO_GP); const float* GQ = (const float*)((const unsigned char*)P.out + DO_GQ); float* GS = (float*)((unsigned char*)P.out + DO_GS);
    const int tid = opaque_tid(), lane = tid & 63, wave = __builtin_amdgcn_readfirstlane(tid >> 6), i16 = lane & 15, quad = lane >> 4;
    LAS unsigned char* ST = lds;
    f32x4 sacc[8];
#pragma unroll
    for (int cb = 0; cb < 8; ++cb) sacc[cb] = (f32x4){0.f, 0.f, 0.f, 0.f};
    bf16x8 fp[2][4]; f32x4 qg[2][8];
#define GB_LOAD(S, gg) do { const size_t tk_ = (size_t)bh * 16 + (gg); \
        _Pragma("unroll") for (int ks_ = 0; ks_ < 4; ++ks_) fp[S][ks_] = *(const bf16x8*)(GP + tk_ * 16384 + (16 * wave + i16) * 128 + 32 * ks_ + 8 * quad); \
        _Pragma("unroll") for (int cb_ = 0; cb_ < 8; ++cb_) qg[S][cb_] = *(const f32x4*)(GQ + ((tk_ * 8 + wave) * 64 + lane) * 32 + cb_ * 4); } while (0)
    GB_LOAD(0, 0); GB_LOAD(1, 1);
    __syncthreads();
#define GB_STEP(g, S) do { const size_t task = (size_t)bh * 16 + (g); \
        _Pragma("unroll") for (int cb_ = 0; cb_ < 8; ++cb_) *(f32x4*)(GS + ((task * 8 + wave) * 64 + lane) * 32 + cb_ * 4) = sacc[cb_];          \
        if ((g) < 15) { \
            _Pragma("unroll") for (int cb_ = 0; cb_ < 8; ++cb_) *(LAS u32x2*)(ST + (16 * cb_ + i16) * 272 + (16 * wave + 4 * quad) * 2) = pack4(sacc[cb_] + (f32x4){0.f, 0.f, 0.f, 0.f}); \
            GS_BAR(); \
            _Pragma("unroll") for (int cb_ = 0; cb_ < 8; ++cb_) { f32x4 acc_ = qg[S][cb_]; \
                _Pragma("unroll") for (int ks_ = 0; ks_ < 4; ++ks_) acc_ = __builtin_amdgcn_mfma_f32_16x16x32_bf16(fp[S][ks_], *(const LAS bf16x8*)(ST + (16 * cb_ + i16) * 272 + (32 * ks_ + 8 * quad) * 2), acc_, 0, 0, 0); \
                sacc[cb_] = acc_; } \
            if ((g) + 2 < 15) GB_LOAD(S, (g) + 2); \
            GS_BAR(); } } while (0)
#pragma unroll 1
    for (int g = 0; g < 16; g += 2) { GB_STEP(g, 0); GB_STEP(g + 1, 1); }
#undef GB_STEP
#undef GB_LOAD
}
__device__ __forceinline__ void phase_gdn_scanC(const Params& P, LAS unsigned char* lds, int wg, int G) {
    bf16_t* proj = (bf16_t*)(P.ws + WS_S + S_GDN_PROJ); const bf16_t* attn = (const bf16_t*)(P.ws + WS_S + S_GDN_ATTN); const float* gcum = (const float*)(P.ws + WS_S + S_GDN_GC); const bf16_t* wbuf = (const bf16_t*)P.out;
    const float* GS = (const float*)((const unsigned char*)P.out + DO_GS);
    const int tid = opaque_tid(), lane = tid & 63, wave = __builtin_amdgcn_readfirstlane(tid >> 6), i16 = lane & 15, quad = lane >> 4, rb = wave & 3;
    LAS unsigned char* ST = lds; LAS unsigned char* VN = lds + 34816; LAS unsigned char* VN2 = lds + 53248; LAS unsigned char* OL = lds + 71680; LAS float* WN = (LAS float*)(lds + 89088);
    const int p0 = 32 * (rb >> 1) + 8 * quad + 4 * (rb & 1);
    for (int task = wg; task < 256; task += G) {
        const int bh = task >> 4, g = task & 15, b = bh >> 3, h = bh & 7; const size_t t0 = (size_t)b * SEQ + (size_t)g * 1024, u0 = (size_t)bh * 256 + (size_t)g * 16;
        f32x4 sacc[8];
#pragma unroll
        for (int cb = 0; cb < 8; ++cb) sacc[cb] = *(const f32x4*)(GS + (((size_t)task * 8 + wave) * 64 + lane) * 32 + cb * 4);
        __syncthreads();
#pragma unroll
        for (int cb = 0; cb < 8; ++cb) *(LAS u32x2*)(ST + (16 * cb + i16) * 272 + (16 * wave + 4 * quad) * 2) = pack4(sacc[cb] + (f32x4){0.f, 0.f, 0.f, 0.f});
        const char* pA = (wave < 4) ? (const char*)(wbuf + (t0 + 16 * rb + quad) * DM + h * HD + 8 * i16) : (const char*)(proj + (t0 + 16 * rb + quad) * 4096 + h * HD + 8 * i16);
        const size_t ksA = (wave < 4) ? (size_t)4 * DM * 2 : (size_t)4 * 4096 * 2, stA = (wave < 4) ? (size_t)64 * DM * 2 : (size_t)64 * 4096 * 2;
        const char* pK = (const char*)(proj + (t0 + 8 * wave + quad) * 4096 + DM + h * HD + 8 * i16);
        const char* pU = (const char*)(proj + (t0 + 16 * rb + (lane >> 2)) * 4096 + 2 * DM + h * HD + (lane & 3) * 32);
        const char* pT = (const char*)(attn + u0 * 4096 + (size_t)(rb * 128 + lane) * 8);
        const char* pG = (const char*)(gcum + u0 * 64 + 16 * rb + 4 * quad); const char* pGl = (const char*)(gcum + u0 * 64 + 63);
        bf16_t* pO = proj + (t0 + (tid >> 4)) * 4096 + 2 * DM + h * HD + (tid & 15) * 8;
        bf16x8 fa[2][4], fk[2][2], ft[2][2]; u32x4 uu[2][4], zr[2]; f32x4 g4[2]; float gl[2];
        if (tid < 128) WN[tid] = P.in[IN_GDN_NORM][tid];
#define GC_LOAD_A(S) do { _Pragma("unroll") for (int ks_ = 0; ks_ < 4; ++ks_) fa[S][ks_] = *(const bf16x8*)(pA + (size_t)ks_ * ksA); \
        if (wave < 4) { _Pragma("unroll") for (int q_ = 0; q_ < 4; ++q_) uu[S][q_] = *(const u32x4*)(pU + q_ * 16); } \
        g4[S] = *(const f32x4*)pG; gl[S] = *(const float*)pGl; pA += stA; pU += 64 * 8192; pG += 256; pGl += 256; } while (0)
#define GC_LOAD_B(S) do { _Pragma("unroll") for (int ks_ = 0; ks_ < 2; ++ks_) fk[S][ks_] = *(const bf16x8*)(pK + (size_t)ks_ * 32768); \
        if (wave >= 4) { _Pragma("unroll") for (int ks_ = 0; ks_ < 2; ++ks_) ft[S][ks_] = *(const bf16x8*)(pT + ks_ * 1024); } \
        pK += 64 * 8192; pT += 8192; } while (0)
#pragma unroll
        for (int s_ = 0; s_ < 2; ++s_) {
#pragma unroll
            for (int q_ = 0; q_ < 4; ++q_) uu[s_][q_] = (u32x4){0u, 0u, 0u, 0u};
#pragma unroll
            for (int q_ = 0; q_ < 2; ++q_) ft[s_][q_] = (bf16x8){0, 0, 0, 0, 0, 0, 0, 0}; }
        GC_LOAD_A(0); GC_LOAD_B(0); GC_LOAD_A(1); GC_LOAD_B(1);
        GS_BAR();
#define GC_ZLOAD(nn) do { _Pragma("unroll") for (int k_ = 0; k_ < 2; ++k_) zr[k_] = *(const u32x4*)(pO + DM + ((size_t)(nn) * 64 + 32 * k_) * 4096); } while (0)
#define GC_OSTORE(nn) do { _Pragma("unroll") for (int k_ = 0; k_ < 2; ++k_) { const u32x4 ov_ = *(const LAS u32x4*)(OL + ((tid >> 4) + 32 * k_) * 272 + (tid & 15) * 16); const u32x4 zv_ = zr[k_]; \
            float o_[8], z_[8]; _Pragma("unroll") for (int e_ = 0; e_ < 4; ++e_) { o_[2 * e_] = bf_lo(ov_[e_]); o_[2 * e_ + 1] = bf_hi(ov_[e_]); z_[2 * e_] = bf_lo(zv_[e_]); z_[2 * e_ + 1] = bf_hi(zv_[e_]); } \
            float ss_ = 0.f; _Pragma("unroll") for (int e_ = 0; e_ < 8; ++e_) ss_ += o_[e_] * o_[e_]; \
            ss_ += __shfl_xor(ss_, 1); ss_ += __shfl_xor(ss_, 2); ss_ += __shfl_xor(ss_, 4); ss_ += __shfl_xor(ss_, 8); \
            const float r_ = __builtin_amdgcn_rsqf(ss_ * (1.0f / HD) + EPS); const f32x4 wa_ = *(const LAS f32x4*)(WN + (tid & 15) * 8), wb_ = *(const LAS f32x4*)(WN + (tid & 15) * 8 + 4); \
            u32x4 w_; w_.x = cvt_pk_bf16(o_[0] * r_ * wa_[0] * silu_f(z_[0]), o_[1] * r_ * wa_[1] * silu_f(z_[1])); w_.y = cvt_pk_bf16(o_[2] * r_ * wa_[2] * silu_f(z_[2]), o_[3] * r_ * wa_[3] * silu_f(z_[3])); \
            w_.z = cvt_pk_bf16(o_[4] * r_ * wb_[0] * silu_f(z_[4]), o_[5] * r_ * wb_[1] * silu_f(z_[5])); w_.w = cvt_pk_bf16(o_[6] * r_ * wb_[2] * silu_f(z_[6]), o_[7] * r_ * wb_[3] * silu_f(z_[7])); \
            *(u32x4*)(pO + ((size_t)(nn) * 64 + 32 * k_) * 4096) = w_; } } while (0)
#define GC_STEP(nn, S) do { \
        if ((nn) > 0) GC_OSTORE((nn) - 1); \
        GC_ZLOAD(nn); \
        f32x4 acc1[8]; \
        _Pragma("unroll") for (int c_ = 0; c_ < 8; ++c_) { acc1[c_] = (f32x4){0.f, 0.f, 0.f, 0.f}; \
            _Pragma("unroll") for (int ks_ = 0; ks_ < 4; ++ks_) acc1[c_] = __builtin_amdgcn_mfma_f32_16x16x32_bf16(fa[S][ks_], *(const LAS bf16x8*)(ST + (16 * c_ + i16) * 272 + (32 * ks_ + 8 * quad) * 2), acc1[c_], 0, 0, 0); } \
        const float glast_ = gl[S]; const f32x4 gv_ = g4[S]; \
        if (wave < 4) { f32x4 ed_; \
            _Pragma("unroll") for (int jj_ = 0; jj_ < 4; ++jj_) ed_[jj_] = __expf(glast_ - gv_[jj_]); \
            _Pragma("unroll") for (int c_ = 0; c_ < 8; ++c_) { const unsigned ua_ = uu[S][c_ >> 1][2 * (c_ & 1)], ub_ = uu[S][c_ >> 1][2 * (c_ & 1) + 1]; f32x4 vn_; \
                vn_[0] = bf_lo(ua_) - acc1[c_][0]; vn_[1] = bf_hi(ua_) - acc1[c_][1]; vn_[2] = bf_lo(ub_) - acc1[c_][2]; vn_[3] = bf_hi(ub_) - acc1[c_][3]; \
                *(LAS u32x2*)(VN + (16 * c_ + i16) * 144 + p0 * 2) = pack4(vn_); *(LAS u32x2*)(VN2 + (16 * c_ + i16) * 144 + p0 * 2) = pack4(vn_ * ed_); } } \
        if ((nn) + 2 < 16) GC_LOAD_A(S); \
        GS_BAR(); \
        if (wave >= 4) { f32x4 eg4_; \
            _Pragma("unroll") for (int jj_ = 0; jj_ < 4; ++jj_) eg4_[jj_] = __expf(gv_[jj_]); \
            _Pragma("unroll") for (int c_ = 0; c_ < 8; ++c_) { f32x4 acco_ = acc1[c_] * eg4_; \
                _Pragma("unroll") for (int ks_ = 0; ks_ < 2; ++ks_) acco_ = __builtin_amdgcn_mfma_f32_16x16x32_bf16(ft[S][ks_], *(const LAS bf16x8*)(VN + (16 * c_ + i16) * 144 + (32 * ks_ + 8 * quad) * 2), acco_, 0, 0, 0); \
                _Pragma("unroll") for (int jj_ = 0; jj_ < 4; ++jj_) *(LAS bf16_t*)(OL + (16 * rb + 4 * quad + jj_) * 272 + (16 * c_ + i16) * 2) = f2bf(acco_[jj_]); } } \
        { const float eg_ = __expf(glast_); \
          _Pragma("unroll") for (int cb_ = 0; cb_ < 8; ++cb_) { f32x4 acc_ = sacc[cb_] * eg_; \
              _Pragma("unroll") for (int ks_ = 0; ks_ < 2; ++ks_) acc_ = __builtin_amdgcn_mfma_f32_16x16x32_bf16(fk[S][ks_], *(const LAS bf16x8*)(VN2 + (16 * cb_ + i16) * 144 + (32 * ks_ + 8 * quad) * 2), acc_, 0, 0, 0); \
              sacc[cb_] = acc_; *(LAS u32x2*)(ST + (16 * cb_ + i16) * 272 + (16 * wave + 4 * quad) * 2) = packsoft4(acc_); } } \
        if ((nn) + 2 < 16) GC_LOAD_B(S); \
        GS_BAR(); } while (0)
#pragma unroll 1
        for (int n = 0; n < 16; n += 2) { GC_STEP(n, 0); GC_STEP(n + 1, 1); }
        GC_OSTORE(15);
#undef GC_STEP
#undef GC_OSTORE
#undef GC_ZLOAD
#undef GC_LOAD_A
#undef GC_LOAD_B
    }
}

constexpr int NPHASES = 39;
__global__ void __launch_bounds__(512, 2) fwd_kernel(Params P0) {
    extern __shared__ __attribute__((aligned(16))) unsigned char lds_raw[];
    LAS unsigned char* lds = (LAS unsigned char*)lds_raw;
    const int tid = threadIdx.x, wg = blockIdx.x, G = gridDim.x;
    volatile LAS unsigned* bw = (volatile LAS unsigned*)(lds + LDS_BARW);
    if (tid < 4) bw[tid] = 0u;
    __syncthreads();
    const int lo = P0.ph_lo, hi = P0.ph_hi;
    XcdBarrier bar; bar.bar = (unsigned*)(P0.ws + WS_CTL); bar.x = 0; bar.st = bw;
    if (hi - lo > 1) bar = xcd_barrier_post((unsigned*)(P0.ws + WS_CTL), bw);
    u64_t* ssq_base = (u64_t*)(P0.ws + WS_SSQ);
    bf16_t* xb = (bf16_t*)(P0.ws + WS_XB);
    const bf16_t* Wb = (const bf16_t*)(P0.ws + WS_W);
    int ph = 0;
#define PH_BEGIN if (ph >= lo && ph < hi) { const Params& P = P0;
#define PH_END if (ph + 1 < hi) xcd_barrier(bar); } ++ph;
    PH_BEGIN phase_prologue(P, lds, wg, G); PH_END
    for (int it = 0; it < 8; ++it) {
        const int L = it >> 1, sub = it & 1, kind = L % 3, mj = L / 3;
        if (sub == 0) {
            PH_BEGIN
                pg8::Gemm g; pg8::EpiIn E; g.A = xb; g.M = T_TOK; g.K = DM; g.lda = DM; E.ssq = ssq_base + (size_t)(2 * L) * T_TOK; E.halo = nullptr;
                if (kind == 0) { g.Bt = (const bf16_t*)((const unsigned char*)Wb + (mj == 0 ? W_MOBA_QKV0 : W_MOBA_QKV1)); g.N = 3072; E.O = (bf16_t*)(P.ws + WS_S + S_MOBA_QKV); E.ldc = 3072; }
                else if (kind == 1) { g.Bt = (const bf16_t*)((const unsigned char*)Wb + W_SC_IN); g.N = 3072; E.O = (bf16_t*)(P.ws + WS_S + S_SC_PROJ); E.ldc = 3072; }
                else { g.Bt = (const bf16_t*)((const unsigned char*)Wb + W_GDN_IN); g.N = 4096; E.O = (bf16_t*)(P.ws + WS_S + S_GDN_PROJ); E.ldc = 4096; E.halo = (bf16_t*)(P.ws + WS_S + S_GDN_HALO); }
                pg8::StaticOrder S; S.init(g.M, g.N, G, wg);
                pg8::gemm_phase<pg8::EpiIn, false>(lds, g, S, E);
                if (kind == 2) phase_gdn_bg(P, wg, G);
            PH_END
            if (kind == 0) {
                PH_BEGIN phase_moba_kmean_vt(P, lds, wg, G); PH_END
                PH_BEGIN phase_moba_gate2(P, lds, mj, wg, G); PH_END
                for (int b = 0; b < 2; ++b) {
                    PH_BEGIN phase_moba_gather(P, lds, mj, b, wg, G); PH_END
                    PH_BEGIN phase_moba_own(P, lds, b, wg, G); PH_END
                }
            } else if (kind == 1) {
                PH_BEGIN phase_sconv(P, wg, G); PH_END
            } else {
                PH_BEGIN phase_gdn_chunk2(P, lds, wg, G); PH_END
                PH_BEGIN phase_gdn_scanA(P, lds, wg, G); PH_END
                PH_BEGIN phase_gdn_scanB(P, lds, wg, G); PH_END
                PH_BEGIN phase_gdn_scanC(P, lds, wg, G); PH_END
            }
        } else {
            PH_BEGIN
                pg8::Gemm g; g.A = xb; g.Bt = (const bf16_t*)((const unsigned char*)Wb + W_FFN_UP + (size_t)L * W_FFN_UP_STRIDE); g.M = T_TOK; g.N = 2 * FFD; g.K = DM; g.lda = DM;
                pg8::EpiUp E; E.ACT = (bf16_t*)(P.ws + WS_S + S_FFN_ACT); E.halo = (float*)(P.ws + WS_S + S_FFN_HALO); E.cw = P.in[IN_FFN_CONV] + (size_t)L * 3 * (2 * FFD); E.ssq = ssq_base + (size_t)(2 * L + 1) * T_TOK;
                pg8::StaticOrder S; S.init(g.M, g.N, G, wg);
                pg8::gemm_phase<pg8::EpiUp, true>(lds, g, S, E);
            PH_END
            PH_BEGIN phase_ffn_fix(P, L, wg, G); PH_END
        }
        PH_BEGIN
            pg8::Gemm g; g.M = T_TOK; g.N = DM;
            if (sub == 1) { g.A = (const bf16_t*)(P.ws + WS_S + S_FFN_ACT); g.lda = FFD; g.K = FFD; g.Bt = (const bf16_t*)((const unsigned char*)Wb + W_FFN_DN + (size_t)L * W_FFN_DN_STRIDE); }
            else if (kind == 0) { g.A = (const bf16_t*)(P.ws + WS_S + S_MOBA_QKV); g.lda = 3072; g.K = DM; g.Bt = (const bf16_t*)((const unsigned char*)Wb + (mj == 0 ? W_MOBA_O0 : W_MOBA_O1)); }
            else if (kind == 1) { g.A = (const bf16_t*)(P.ws + WS_S + S_SC_Y); g.lda = DM; g.K = DM; g.Bt = (const bf16_t*)((const unsigned char*)Wb + W_SC_OUT); }
            else { g.A = (const bf16_t*)(P.ws + WS_S + S_GDN_PROJ) + 2 * DM; g.lda = 4096; g.K = DM; g.Bt = (const bf16_t*)((const unsigned char*)Wb + W_GDN_O); }
            pg8::EpiOut E; E.XB = xb; E.ssq_next = ssq_base + (size_t)(2 * L + 1 + sub) * T_TOK; E.ts = (LAS float*)(lds + 131072);
            pg8::StaticOrder S; S.init(g.M, g.N, G, wg);
            pg8::gemm_phase<pg8::EpiOut, false>(lds, g, S, E);
        PH_END
    }
    PH_BEGIN phase_final(P, wg, G); PH_END
#undef PH_BEGIN
#undef PH_END
}

extern "C" void kernel_launch(void* const* d_in, const int* in_sizes, int n_in, void* d_out, int out_size, void* d_ws, size_t ws_size, hipStream_t stream) {
    static int grid = 0;
    if (grid == 0) {
        if (n_in != 18 || out_size != T_TOK * DM || ws_size < WS_END) { fprintf(stderr, "kernel_launch: unexpected problem (n_in %d, out %d, ws %zu)\n", n_in, out_size, ws_size); grid = -1; return; }
        int dev = 0, cus = 0, per_cu = 0;
        if (hipGetDevice(&dev) != hipSuccess || hipDeviceGetAttribute(&cus, hipDeviceAttributeMultiprocessorCount, dev) != hipSuccess) { grid = -1; return; }
        if (hipFuncSetAttribute((const void*)fwd_kernel, hipFuncAttributeMaxDynamicSharedMemorySize, LDS_BYTES) != hipSuccess) { fprintf(stderr, "kernel_launch: hipFuncSetAttribute failed\n"); grid = -1; return; }
        if (hipOccupancyMaxActiveBlocksPerMultiprocessor(&per_cu, (const void*)fwd_kernel, 512, LDS_BYTES) != hipSuccess || per_cu < 1) { fprintf(stderr, "kernel_launch: occupancy query says %d blocks per CU\n", per_cu); (void)hipGetLastError(); }
        grid = cus;
    }
    if (grid < 0) return;
    (void)in_sizes;
    hipMemsetAsync((char*)d_ws + WS_CTL, 0, CTL_ZERO_BYTES, stream);
    Params p; memset(&p, 0, sizeof(p));
    for (int i = 0; i < 18; ++i) p.in[i] = (const float*)d_in[i];
    p.out = (float*)d_out; p.ws = (unsigned char*)d_ws;
#if MK_N_LAUNCHES == 1
    p.ph_lo = 0; p.ph_hi = NPHASES;
    hipLaunchKernelGGL(fwd_kernel, dim3(grid), dim3(512), LDS_BYTES, stream, p);
#else
    for (int li = 0; li < NPHASES; ++li) { p.ph_lo = li; p.ph_hi = li + 1; hipLaunchKernelGGL(fwd_kernel, dim3(grid), dim3(512), LDS_BYTES, stream, p); }
#endif
}
```

```cpp
#include <hip/hip_runtime.h>
#include <stdio.h>
#include <string.h>

#ifndef MK_N_LAUNCHES
#define MK_N_LAUNCHES 1
#endif

#define LAS __attribute__((address_space(3)))
typedef unsigned short bf16_t;
typedef short bf16x8 __attribute__((ext_vector_type(8)));
typedef float f32x4 __attribute__((ext_vector_type(4)));
typedef float f32x2 __attribute__((ext_vector_type(2)));
typedef unsigned u32x4 __attribute__((ext_vector_type(4)));
typedef unsigned u32x2 __attribute__((ext_vector_type(2)));

constexpr int T_TOK = 32768, SEQ = 16384, DM = 1024, FFD = 2816, NH = 8, HD = 128, NBLK = 64, BLK = 256;
constexpr float EPS = 1e-6f;
constexpr float LOG2E = 1.4426950408889634f, LN2 = 0.6931471805599453f;

constexpr size_t MiB = 1u << 20;
constexpr size_t WS_CTL = 0, CTL_ZERO_BYTES = 4 * MiB;
constexpr size_t CTL_CNT = 512 * 1024;
constexpr size_t WS_SSQ = 1 * MiB;
constexpr size_t WS_MISC = 6 * MiB;
constexpr size_t MISC_KMEAN = 0, MISC_BGW = 512 * 1024;
constexpr size_t WS_W = 7 * MiB;
constexpr size_t WS_XB = 107 * MiB;
constexpr size_t WS_S = 171 * MiB;
constexpr size_t WS_END = 512 * MiB;
constexpr size_t W_MOBA_QKV0 = 0, W_MOBA_QKV1 = 6 * MiB, W_MOBA_O0 = 12 * MiB, W_MOBA_O1 = 14 * MiB, W_SC_IN = 16 * MiB, W_SC_OUT = 22 * MiB,
                 W_GDN_IN = 24 * MiB, W_GDN_O = 32 * MiB, W_FFN_UP = 34 * MiB, W_FFN_UP_STRIDE = 11 * MiB, W_FFN_DN = 78 * MiB, W_FFN_DN_STRIDE = 5767168;
constexpr size_t S_MOBA_KN = 322 * MiB, S_MOBA_KMAX = 323 * MiB, S_MOBA_MASK = 324 * MiB;
constexpr size_t S_MOBA_QKV = 0, S_MOBA_PO = 192 * MiB, S_MOBA_LIST = 288 * MiB, S_MOBA_LSE = 320 * MiB;
constexpr size_t S_SC_PROJ = 0, S_SC_Y = 192 * MiB;
constexpr size_t S_GDN_PROJ = 0, S_GDN_ATTN = 256 * MiB, S_GDN_BG = 288 * MiB, S_GDN_HALO = 290 * MiB, S_GDN_GC = 300 * MiB;
constexpr size_t S_FFN_ACT = 0, S_FFN_HALO = 176 * MiB;

constexpr int LDS_BYTES = 163840;
constexpr int LDS_BARW = 163840 - 64;

typedef __bf16 hbf2 __attribute__((ext_vector_type(2)));
__device__ __forceinline__ unsigned cvt_pk_bf16(float lo, float hi) { return __builtin_bit_cast(unsigned, __builtin_convertvector((f32x2){lo, hi}, hbf2)); }
__device__ __forceinline__ float bf_lo(unsigned u) { return __builtin_bit_cast(float, u << 16); }
__device__ __forceinline__ float bf_hi(unsigned u) { return __builtin_bit_cast(float, u & 0xffff0000u); }
__device__ __forceinline__ f32x4 bf4(u32x2 w) { return (f32x4){bf_lo(w.x), bf_hi(w.x), bf_lo(w.y), bf_hi(w.y)}; }
__device__ __forceinline__ float bf2f(bf16_t b) { return __builtin_bit_cast(float, (unsigned)b << 16); }
__device__ __forceinline__ bf16_t f2bf(float f) { return (bf16_t)(cvt_pk_bf16(f, 0.0f) & 0xffffu); }
__device__ __forceinline__ float fast_exp2(float x) { return __builtin_amdgcn_exp2f(x); }
__device__ __forceinline__ float fast_rcp(float x) { return __builtin_amdgcn_rcpf(x); }
__device__ __forceinline__ float silu_f(float x) { return x * fast_rcp(1.0f + fast_exp2(-x * LOG2E)); }
__device__ __forceinline__ int opaque_tid() { int t = threadIdx.x; asm volatile("" : "+v"(t)); return t; }
typedef unsigned long long u64_t;
constexpr float SSQ_SCALE = 4294967296.0f, SSQ_INV = 1.0f / 4294967296.0f;
__device__ __forceinline__ u64_t ssq_fix(float s) { return (u64_t)(s * SSQ_SCALE); }
__device__ __forceinline__ float ssq_rs(u64_t v) { return __builtin_amdgcn_rsqf((float)v * (SSQ_INV / DM) + EPS); }
__device__ __forceinline__ float wave_sum(float v) {
#pragma unroll
    for (int o = 1; o < 64; o <<= 1) v += __shfl_xor(v, o);
    return v;
}
__device__ __forceinline__ float dpp_shr1(float v) {
    return __builtin_bit_cast(float, __builtin_amdgcn_update_dpp(0, __builtin_bit_cast(int, v), 0x111, 0xf, 0xf, false));
}
__device__ __forceinline__ bf16x8 pack8(f32x4 a, f32x4 b) {
    u32x4 p;
    asm volatile("v_cvt_pk_bf16_f32 %0, %4, %5\n\tv_cvt_pk_bf16_f32 %1, %6, %7\n\tv_cvt_pk_bf16_f32 %2, %8, %9\n\tv_cvt_pk_bf16_f32 %3, %10, %11\n\ts_nop 1"
                 : "=&v"(p[0]), "=&v"(p[1]), "=&v"(p[2]), "=&v"(p[3])
                 : "v"(a[0]), "v"(a[1]), "v"(a[2]), "v"(a[3]), "v"(b[0]), "v"(b[1]), "v"(b[2]), "v"(b[3]));
    return __builtin_bit_cast(bf16x8, p);
}

#define XB_TMO      128
#define XB_XCNT(j)  (256  + 64 * (j))
#define XB_XSUB(j)  (1280 + 64 * (j))
#define XB_XGEN(j)  (2304 + 64 * (j))
#define XB_TOP      3328
#define XB_TOPGEN   3392
#define XCD_BAR_WORDS 3456
#define XB_SPIN_CAP (1u << 18)
__device__ __forceinline__ unsigned xb_ld(unsigned* p)              { return __hip_atomic_load(p, __ATOMIC_RELAXED, __HIP_MEMORY_SCOPE_AGENT); }
__device__ __forceinline__ unsigned xb_add(unsigned* p, unsigned v) { return __hip_atomic_fetch_add(p, v, __ATOMIC_RELAXED, __HIP_MEMORY_SCOPE_AGENT); }
__device__ __forceinline__ unsigned xb_xcc_id() { return (unsigned)__builtin_amdgcn_s_getreg((3 << 11) | 20) & 0xFu; }
#define XB_SPIN(cond, bar) do { unsigned _sp = 0; while (cond) { __builtin_amdgcn_s_sleep(1); \
    if ((++_sp & 255u) == 0u) { if (xb_ld(&(bar)[XB_TMO])) break; if (_sp > XB_SPIN_CAP) { atomicAdd(&(bar)[XB_TMO], 1u); break; } } } } while (0)
struct XcdBarrier { unsigned* bar; unsigned x; volatile LAS unsigned* st; };
__device__ __forceinline__ XcdBarrier xcd_barrier_post(unsigned* bar, volatile LAS unsigned* st) {
    XcdBarrier b; b.bar = bar; b.x = xb_xcc_id(); b.st = st;
    if (threadIdx.x == 0) (void)xb_add(&bar[XB_XCNT(b.x)], 1u);
    return b;
}
__device__ __forceinline__ void xcd_barrier_complete(unsigned* bar, unsigned x, unsigned& nloc, unsigned& nx) {
    const unsigned G = gridDim.x * gridDim.y * gridDim.z;
    unsigned sum, cnt, mine, sp = 0u;
    for (;;) {
        sum = 0u; cnt = 0u; mine = 0u;
#pragma unroll
        for (unsigned j = 0; j < 16; ++j) { const unsigned c = xb_ld(&bar[XB_XCNT(j)]); sum += c; cnt += (c > 0u) ? 1u : 0u; mine = (j == x) ? c : mine; }
        if (sum == G) break;
        __builtin_amdgcn_s_sleep(1);
        if ((++sp & 255u) == 0u) { if (xb_ld(&bar[XB_TMO])) break; if (sp > XB_SPIN_CAP) { atomicAdd(&bar[XB_TMO], 1u); break; } }
    }
    nloc = mine > 0u ? mine : 1u; nx = cnt > 0u ? cnt : 1u;
}
__device__ __forceinline__ void xcd_barrier(const XcdBarrier& b) {
    asm volatile("s_waitcnt vmcnt(0)" ::: "memory");
    __syncthreads();
    if (threadIdx.x == 0) {
        unsigned* bar = b.bar;
        __builtin_amdgcn_s_waitcnt(0);
        unsigned nloc = b.st[0], nx = b.st[1];
        if (nloc == 0u) { xcd_barrier_complete(bar, b.x, nloc, nx); b.st[0] = nloc; b.st[1] = nx; }
        const unsigned old = xb_add(&bar[XB_XSUB(b.x)], 1u);
        const unsigned gen = old / nloc;
        if (old + 1u == (gen + 1u) * nloc) {
            __builtin_amdgcn_fence(__ATOMIC_RELEASE, "agent");
            asm volatile("s_waitcnt vmcnt(0)" ::: "memory");
            const unsigned og = xb_add(&bar[XB_TOP], 1u);
            const unsigned tg = og / nx;
            if (og + 1u == (tg + 1u) * nx) xb_add(&bar[XB_TOPGEN], 1u);
            else XB_SPIN(xb_ld(&bar[XB_TOPGEN]) == tg, bar);
            __builtin_amdgcn_fence(__ATOMIC_ACQUIRE, "agent");
            xb_add(&bar[XB_XGEN(b.x)], 1u);
            asm volatile("s_waitcnt vmcnt(0)" ::: "memory");
        } else {
            XB_SPIN(xb_ld(&bar[XB_XGEN(b.x)]) == gen, bar);
            __builtin_amdgcn_fence(__ATOMIC_ACQUIRE, "agent");
            asm volatile("s_waitcnt vmcnt(0)" ::: "memory");
        }
    }
    __syncthreads();
}

namespace pg8 {
constexpr int BM = 256, BK = 64, HALF = 128, HTB = HALF * BK * 2, STAGE_BYTES = 8 * HTB, NXCD = 8, WGM = 8;
__host__ __device__ __forceinline__ int lds_byte(int r, int c) { const int st = (r >> 4) * 2 + (c >> 5), rr = r & 15, cc = c & 31, ob = rr * 64 + cc * 2; return st * 1024 + (ob ^ (((ob >> 9) & 1) << 5)); }
__host__ __device__ __forceinline__ void stage_rc(int b, int& R, int& C) { const int st = b / 1024, sb = b % 1024, swz = sb ^ (((sb >> 9) & 1) << 5); R = (st >> 1) * 16 + swz / 64; C = (st & 1) * 32 + (swz % 64) / 2; }
__host__ __device__ __forceinline__ int perm32(int rho) { const int n = rho >> 4, i = rho & 15; return 8 * (i >> 2) + 4 * n + (i & 3); }
struct Unit { int pm, pn; };
struct Gemm { const bf16_t* A; const bf16_t* Bt; int M, N, K, lda; };
struct StaticOrder {
    int nM, nN, nwg, G, c;
    __host__ __device__ void init(int M, int N, int G_, int c_) { nM = M / BM; nN = N / BM; nwg = nM * nN; G = G_; c = c_; }
    __host__ __device__ bool next(int i, Unit& u) const {
        const long L = (long)i * G + c; if (L >= nwg) return false;
        int wgid = (int)L; { const int q = nwg / NXCD, r = nwg % NXCD, xcd = wgid % NXCD, off = wgid / NXCD; wgid = (xcd < r ? xcd * (q + 1) : r * (q + 1) + (xcd - r) * q) + off; }
        const int nig = WGM * nN, gid = wgid / nig, fm = gid * WGM, gsz = (nM - fm) < WGM ? (nM - fm) : WGM;
        u.pm = fm + ((wgid % nig) % gsz); u.pn = (wgid % nig) / gsz; return true;
    }
};
template <class Epi, bool TOKPERM>
__device__ __forceinline__ void gemm_phase(LAS unsigned char* lds, const Gemm g, const StaticOrder& S, const Epi& E) {
    const int tid = opaque_tid(), wid = __builtin_amdgcn_readfirstlane(tid >> 6), lane = tid & 63, wr = wid >> 2, wc = wid & 3, fr = lane & 15, fq = lane >> 4;
    const int K = g.K, nt = K / BK, lda = g.lda;
    unsigned voffA[2], voffB[2];
#pragma unroll
    for (int i = 0; i < 2; ++i) { int R, C; stage_rc(tid * 16 + i * 8192, R, C); const int Rb = (R & ~31) + perm32(R & 31);
        const int Ra = TOKPERM ? (128 * (R >> 6) + 8 * (R & 15) + ((R >> 4) & 3)) : R;
        voffA[i] = (unsigned)(Ra * lda + C) * 2u; voffB[i] = (unsigned)(Rb * K + C) * 2u; }
    const size_t kstep = (size_t)(BK * 2);
    const size_t hstepA = TOKPERM ? (size_t)4 * lda * 2 : (size_t)HALF * lda * 2, hstepB = (size_t)HALF * K * 2;
    const size_t tstepA = (size_t)BM * lda * 2, tstepB = (size_t)BM * K * 2;
    const unsigned ldsw = (unsigned)wid * 1024u;
    const int aoff = lds_byte(wr * 64 + fr, fq * 8), boff = lds_byte(wc * 32 + fr, fq * 8);
#define PG8_SA(b, h) (((b) * 2 + (h)) * HTB)
#define PG8_SB(b, h) ((4 + (b) * 2 + (h)) * HTB)
#define PG8_STAGE(bufoff, gbase, voff) do { _Pragma("unroll") for (int _i = 0; _i < 2; ++_i) \
        __builtin_amdgcn_global_load_lds((const unsigned*)((const char*)(gbase) + (voff)[_i]), (LAS unsigned*)(lds + (bufoff) + ldsw + _i * 8192), 16, 0, 0); } while (0)
#define PG8_LDA(dst, b, h) do { _Pragma("unroll") for (int m = 0; m < 4; ++m) _Pragma("unroll") for (int k = 0; k < 2; ++k) dst[m][k] = *(const LAS bf16x8*)(lds + PG8_SA(b, h) + aoff + m * 2048 + k * 1024); } while (0)
#define PG8_LDB(dst, b, h) do { _Pragma("unroll") for (int n = 0; n < 2; ++n) _Pragma("unroll") for (int k = 0; k < 2; ++k) dst[n][k] = *(const LAS bf16x8*)(lds + PG8_SB(b, h) + boff + n * 2048 + k * 1024); } while (0)
#define PG8_MMA(ai, bj, At, Bt) do { __builtin_amdgcn_s_setprio(1); _Pragma("unroll") for (int m = 0; m < 4; ++m) _Pragma("unroll") for (int n = 0; n < 2; ++n) _Pragma("unroll") for (int k = 0; k < 2; ++k) \
        acc[ai][bj][m][n] = __builtin_amdgcn_mfma_f32_16x16x32_bf16(Bt[n][k], At[m][k], acc[ai][bj][m][n], 0, 0, 0); __builtin_amdgcn_s_setprio(0); } while (0)
#define PG8_WAIT_V(n) asm volatile("s_waitcnt vmcnt(" #n ")" ::: "memory")
#define PG8_WAIT_L(n) asm volatile("s_waitcnt lgkmcnt(" #n ")" ::: "memory")
#define PG8_BAR __builtin_amdgcn_s_barrier()
#define PG8_SCHED __builtin_amdgcn_sched_barrier(0)
    Unit cur, nxt; int ui = 0;
    if (!S.next(0, cur)) return;
    f32x4 acc[2][2][4][2];
#pragma unroll
    for (int a = 0; a < 2; ++a)
#pragma unroll
        for (int b = 0; b < 2; ++b)
#pragma unroll
            for (int m = 0; m < 4; ++m)
#pragma unroll
                for (int n = 0; n < 2; ++n) acc[a][b][m][n] = (f32x4){0.f, 0.f, 0.f, 0.f};
    bf16x8 At[4][2], B0[2][2], B1[2][2];
    const char* cA = (const char*)g.A + (size_t)cur.pm * tstepA; const char* cB = (const char*)g.Bt + (size_t)cur.pn * tstepB;
    PG8_STAGE(PG8_SB(0, 0), cB, voffB); PG8_STAGE(PG8_SB(0, 1), cB + hstepB, voffB); PG8_STAGE(PG8_SA(0, 0), cA, voffA); PG8_STAGE(PG8_SA(0, 1), cA + hstepA, voffA);
    if (wr == 1) PG8_BAR;
    PG8_WAIT_V(2); PG8_BAR;
    PG8_STAGE(PG8_SB(1, 0), cB + kstep, voffB); PG8_STAGE(PG8_SA(1, 0), cA + kstep, voffA); PG8_STAGE(PG8_SB(1, 1), cB + hstepB + kstep, voffB);
    PG8_WAIT_V(6); PG8_BAR;
    for (;;) {
        const bool has_next = S.next(ui + 1, nxt);
        const char* nA = has_next ? (const char*)g.A + (size_t)nxt.pm * tstepA : cA; const char* nB = has_next ? (const char*)g.Bt + (size_t)nxt.pn * tstepB : cB;
        for (int t = 0; t < nt; t += 2) {
            const bool last = (t == nt - 2);
            const char* a1 = cA + (size_t)(t + 1) * kstep;
            const char* a2 = last ? nA : cA + (size_t)(t + 2) * kstep; const char* b2 = last ? nB : cB + (size_t)(t + 2) * kstep;
            const char* a3 = a2 + kstep; const char* b3 = b2 + kstep;
            PG8_LDB(B0, 0, 0); PG8_LDB(B1, 0, 1); PG8_SCHED; PG8_LDA(At, 0, 0); PG8_STAGE(PG8_SA(1, 1), a1 + hstepA, voffA);
            PG8_WAIT_V(8); PG8_WAIT_L(0); PG8_BAR; PG8_MMA(0, 0, At, B0); PG8_MMA(0, 1, At, B1); PG8_BAR; PG8_SCHED;
            PG8_LDA(At, 0, 1); PG8_STAGE(PG8_SB(0, 0), b2, voffB); PG8_STAGE(PG8_SB(0, 1), b2 + hstepB, voffB); PG8_STAGE(PG8_SA(0, 0), a2, voffA);
            PG8_WAIT_V(8); PG8_WAIT_L(0); PG8_BAR; PG8_MMA(1, 0, At, B0); PG8_MMA(1, 1, At, B1); PG8_BAR; PG8_SCHED;
            PG8_LDB(B0, 1, 0); PG8_LDB(B1, 1, 1); PG8_SCHED; PG8_LDA(At, 1, 0); PG8_STAGE(PG8_SA(0, 1), a2 + hstepA, voffA);
            PG8_WAIT_V(8); PG8_WAIT_L(0); PG8_BAR; PG8_MMA(0, 0, At, B0); PG8_MMA(0, 1, At, B1); PG8_BAR; PG8_SCHED;
            PG8_LDA(At, 1, 1); PG8_STAGE(PG8_SB(1, 0), b3, voffB); PG8_STAGE(PG8_SB(1, 1), b3 + hstepB, voffB); PG8_STAGE(PG8_SA(1, 0), a3, voffA);
            PG8_WAIT_V(8); PG8_WAIT_L(0); PG8_BAR; PG8_MMA(1, 0, At, B0); PG8_MMA(1, 1, At, B1); PG8_BAR; PG8_SCHED;
        }
        if (wr == 0) PG8_BAR;
        E(acc, cur, wr, wc, fr, fq);
        if (!has_next) break;
#pragma unroll
        for (int a = 0; a < 2; ++a)
#pragma unroll
            for (int b = 0; b < 2; ++b)
#pragma unroll
                for (int m = 0; m < 4; ++m)
#pragma unroll
                    for (int n = 0; n < 2; ++n) acc[a][b][m][n] = (f32x4){0.f, 0.f, 0.f, 0.f};
        cur = nxt; cA = nA; cB = nB; ++ui;
        if (wr == 1) PG8_BAR;
    }
    PG8_WAIT_V(0);
    PG8_BAR;
#undef PG8_SA
#undef PG8_SB
#undef PG8_STAGE
#undef PG8_LDA
#undef PG8_LDB
#undef PG8_MMA
#undef PG8_WAIT_V
#undef PG8_WAIT_L
#undef PG8_BAR
#undef PG8_SCHED
}

struct EpiIn {
    bf16_t* O; int ldc; const u64_t* ssq; bf16_t* halo;
    __device__ __forceinline__ void operator()(const f32x4 (&acc)[2][2][4][2], const Unit& u, int wr, int wc, int fr, int fq) const {
        const int row0 = u.pm * BM + wr * 64 + fr, col0 = u.pn * BM + wc * 32 + 8 * fq;
        u64_t sq[2][4];
#pragma unroll
        for (int ai = 0; ai < 2; ++ai)
#pragma unroll
            for (int m = 0; m < 4; ++m) sq[ai][m] = ssq[row0 + ai * HALF + m * 16];
        __builtin_amdgcn_sched_barrier(0);
#pragma unroll
        for (int ai = 0; ai < 2; ++ai)
#pragma unroll
            for (int m = 0; m < 4; ++m) { const int t = row0 + ai * HALF + m * 16; const float rs = ssq_rs(sq[ai][m]);
                bf16_t* rowp = O + (size_t)t * ldc + col0;
#pragma unroll
                for (int bj = 0; bj < 2; ++bj) { const f32x4 v0 = acc[ai][bj][m][0] * rs, v1 = acc[ai][bj][m][1] * rs;
                    u32x4 w; w.x = cvt_pk_bf16(v0[0], v0[1]); w.y = cvt_pk_bf16(v0[2], v0[3]); w.z = cvt_pk_bf16(v1[0], v1[1]); w.w = cvt_pk_bf16(v1[2], v1[3]);
                    *(u32x4*)(rowp + bj * HALF) = w;
                    if (halo != nullptr && m == 3 && fr >= 13 && (col0 + bj * HALF) < 3072) *(u32x4*)(halo + ((size_t)(t >> 6) * 3 + (fr - 13)) * 3072 + col0 + bj * HALF) = w; } }
    }
};
struct EpiOut {
    bf16_t* XB; u64_t* ssq_next; LAS float* ts;
    __device__ __forceinline__ void operator()(const f32x4 (&acc)[2][2][4][2], const Unit& u, int wr, int wc, int fr, int fq) const {
        const int row0 = u.pm * BM + wr * 64 + fr, col0 = u.pn * BM + wc * 32 + 8 * fq;
        u32x4 xin[2][4][2];
#pragma unroll
        for (int ai = 0; ai < 2; ++ai)
#pragma unroll
            for (int m = 0; m < 4; ++m)
#pragma unroll
                for (int bj = 0; bj < 2; ++bj) xin[ai][m][bj] = *(const u32x4*)(XB + (size_t)(row0 + ai * HALF + m * 16) * DM + col0 + bj * HALF);
        __builtin_amdgcn_sched_barrier(0);
#pragma unroll
        for (int ai = 0; ai < 2; ++ai)
#pragma unroll
            for (int m = 0; m < 4; ++m) { const int t = row0 + ai * HALF + m * 16; float ss = 0.f;
#pragma unroll
                for (int bj = 0; bj < 2; ++bj) { const u32x4 xi = xin[ai][m][bj];
                    f32x4 v0, v1; v0[0] = bf_lo(xi.x); v0[1] = bf_hi(xi.x); v0[2] = bf_lo(xi.y); v0[3] = bf_hi(xi.y); v1[0] = bf_lo(xi.z); v1[1] = bf_hi(xi.z); v1[2] = bf_lo(xi.w); v1[3] = bf_hi(xi.w);
                    v0 = v0 + acc[ai][bj][m][0]; v1 = v1 + acc[ai][bj][m][1];
                    u32x4 w; w.x = cvt_pk_bf16(v0[0], v0[1]); w.y = cvt_pk_bf16(v0[2], v0[3]); w.z = cvt_pk_bf16(v1[0], v1[1]); w.w = cvt_pk_bf16(v1[2], v1[3]);
                    *(u32x4*)(XB + (size_t)t * DM + col0 + bj * HALF) = w;
                    ss += (v0[0] * v0[0] + v0[1] * v0[1]) + (v0[2] * v0[2] + v0[3] * v0[3]) + (v1[0] * v1[0] + v1[1] * v1[1]) + (v1[2] * v1[2] + v1[3] * v1[3]); }
                ss += __shfl_xor(ss, 16); ss += __shfl_xor(ss, 32);
                if (fq == 0) ts[(wr * 64 + fr + ai * HALF + m * 16) * 4 + wc] = ss; }
        asm volatile("s_waitcnt lgkmcnt(0)" ::: "memory"); __builtin_amdgcn_s_barrier(); asm volatile("" ::: "memory");
        const int tid = opaque_tid();
        if (tid < 256) { const f32x4 p = *(const LAS f32x4*)(ts + tid * 4); atomicAdd(ssq_next + u.pm * BM + tid, ssq_fix((p[0] + p[1]) + (p[2] + p[3]))); }
    }
};
struct EpiUp {
    bf16_t* ACT; float* halo; const float* cw; const u64_t* ssq;
    __device__ __forceinline__ void operator()(f32x4 (&acc)[2][2][4][2], const Unit& u, int wr, int wc, int fr, int fq) const {
        asm volatile("" : "+v"(fr), "+v"(fq));
        const int tbase = u.pm * BM + 128 * wr + 8 * fr, ch0 = u.pn * 128 + wc * 32 + 8 * fq;
#pragma unroll
        for (int ai = 0; ai < 2; ++ai)
#pragma unroll
            for (int m = 0; m < 4; ++m) { const float rs = ssq_rs(ssq[tbase + 4 * ai + m]);
#pragma unroll
                for (int bj = 0; bj < 2; ++bj)
#pragma unroll
                    for (int n = 0; n < 2; ++n) acc[ai][bj][m][n] = acc[ai][bj][m][n] * rs; }
        if (fr == 0 || fr == 15) {
            float* hb = halo + ((size_t)(tbase >> 7) * 4 + (fr == 0 ? 0 : 2)) * (2 * FFD) + ch0;
#pragma unroll
            for (int jj = 0; jj < 2; ++jj)
#pragma unroll
                for (int n = 0; n < 2; ++n) {
                    const f32x4 g0 = (fr == 0) ? acc[0][0][jj][n] : acc[1][0][2 + jj][n], u0 = (fr == 0) ? acc[0][1][jj][n] : acc[1][1][2 + jj][n];
                    *(f32x4*)(hb + (size_t)jj * (2 * FFD) + 4 * n) = g0; *(f32x4*)(hb + (size_t)jj * (2 * FFD) + FFD + 4 * n) = u0; }
        }
#pragma unroll
        for (int n = 0; n < 2; ++n) {
#pragma unroll
            for (int half = 1; half >= 0; --half) {
                f32x4 w[3];
#pragma unroll
                for (int k = 0; k < 3; ++k) w[k] = *(const f32x4*)(cw + (size_t)k * (2 * FFD) + half * FFD + ch0 + 4 * n);
                f32x4 p6, p7;
#pragma unroll
                for (int e = 0; e < 4; ++e) { p6[e] = dpp_shr1(acc[1][half][2][n][e]); p7[e] = dpp_shr1(acc[1][half][3][n][e]); }
#pragma unroll
                for (int j = 7; j >= 0; --j) {
                    const int j1 = j >= 1 ? j - 1 : 0, j2 = j >= 2 ? j - 2 : 0;
                    const f32x4 x0 = acc[j >> 2][half][j & 3][n];
                    const f32x4 x1 = (j >= 1) ? acc[j1 >> 2][half][j1 & 3][n] : p7;
                    const f32x4 x2 = (j >= 2) ? acc[j2 >> 2][half][j2 & 3][n] : (j == 1 ? p7 : p6);
                    const f32x4 cv = w[2] * x0 + w[1] * x1 + w[0] * x2;
                    if (half == 1) acc[j >> 2][1][j & 3][n] = cv;
                    else { f32x4 a; const f32x4 up = acc[j >> 2][1][j & 3][n];
#pragma unroll
                        for (int e = 0; e < 4; ++e) a[e] = silu_f(cv[e]) * up[e];
                        acc[j >> 2][0][j & 3][n] = a; }
                }
                asm volatile("" ::: "memory");
            }
        }
#pragma unroll
        for (int j = 0; j < 8; ++j) {
            if (fr == 0 && j < 2) continue;
            const f32x4 v0 = acc[j >> 2][0][j & 3][0], v1 = acc[j >> 2][0][j & 3][1];
            u32x4 w; w.x = cvt_pk_bf16(v0[0], v0[1]); w.y = cvt_pk_bf16(v0[2], v0[3]); w.z = cvt_pk_bf16(v1[0], v1[1]); w.w = cvt_pk_bf16(v1[2], v1[3]);
            *(u32x4*)(ACT + (size_t)(tbase + j) * FFD + ch0) = w;
        }
    }
};
}

struct Params { const float* in[18]; float* out; unsigned char* ws; int ph_lo, ph_hi; };
enum { IN_X = 0, IN_MIXN, IN_FFNN, IN_FINN, IN_MOBA_QKV, IN_MOBA_O, IN_SC_IN, IN_SC_CONV, IN_SC_OUT, IN_GDN_IN, IN_GDN_CONV, IN_GDN_ALOG, IN_GDN_DTB, IN_GDN_NORM, IN_GDN_O, IN_FFN_UP, IN_FFN_CONV, IN_FFN_DN };

__device__ __forceinline__ void transpose_item(const float* W, int ldw, int K, int srccol0, const float* gain, bf16_t* WT, int dstrow0, int k0, LAS float* scr, int lane) {
    float wv[32];
    { const float* wp = W + (size_t)(k0 + (lane >> 5)) * ldw + srccol0 + (lane & 31); unsigned off = 0;
#pragma unroll
      for (int i = 0; i < 32; ++i) { wv[i] = wp[off]; off += 2 * ldw; asm volatile("" : "+v"(off)); }
      __builtin_amdgcn_sched_barrier(0); }
#pragma unroll
    for (int i = 0; i < 32; ++i) { const int kk = 2 * i + (lane >> 5); float v = wv[i]; if (gain) v *= gain[k0 + kk]; scr[kk * 33 + (lane & 31)] = v; }
    asm volatile("s_waitcnt lgkmcnt(0)" ::: "memory");
    const int c = lane & 7;
#pragma unroll
    for (int j = 0; j < 4; ++j) { const int n = (lane >> 3) + 8 * j; const LAS float* s = scr + (8 * c) * 33 + n;
        u32x4 o; o.x = cvt_pk_bf16(s[0 * 33], s[1 * 33]); o.y = cvt_pk_bf16(s[2 * 33], s[3 * 33]); o.z = cvt_pk_bf16(s[4 * 33], s[5 * 33]); o.w = cvt_pk_bf16(s[6 * 33], s[7 * 33]);
        *(u32x4*)(WT + (size_t)(dstrow0 + n) * K + k0 + 8 * c) = o; }
    asm volatile("s_waitcnt lgkmcnt(0)" ::: "memory");
}
__device__ __forceinline__ void phase_prologue(const Params& P, LAS unsigned char* lds, int wg, int G) {
    const int tid = opaque_tid(), lane = tid & 63, wave = tid >> 6;
    LAS float* scr = (LAS float*)(lds + wave * 16384);
    const int gw = wg * 8 + wave, NGW = G * 8;
    bf16_t* Wb = (bf16_t*)(P.ws + WS_W);
    constexpr int NITEMS = 3072 + 1024 + 1536 + 512 + 2048 + 512 + 4 * 2816 + 4 * 1408;
    for (int it = gw; it < NITEMS; it += NGW) {
        int r = it; const float* src; int ldw, K, N; const float* gain; size_t doff; int map = 0;
        if (r < 3072) { const int j = r / 1536; r -= j * 1536; src = P.in[IN_MOBA_QKV] + (size_t)j * DM * 3072; ldw = 3072; K = DM; N = 3072; gain = P.in[IN_MIXN] + (j == 0 ? 0 : 3) * DM; doff = j == 0 ? W_MOBA_QKV0 : W_MOBA_QKV1; }
        else if ((r -= 3072) < 1024) { const int j = r / 512; r -= j * 512; src = P.in[IN_MOBA_O] + (size_t)j * DM * DM; ldw = DM; K = DM; N = DM; gain = nullptr; doff = j == 0 ? W_MOBA_O0 : W_MOBA_O1; }
        else if ((r -= 1024) < 1536) { src = P.in[IN_SC_IN]; ldw = 3072; K = DM; N = 3072; gain = P.in[IN_MIXN] + 1 * DM; doff = W_SC_IN; }
        else if ((r -= 1536) < 512) { src = P.in[IN_SC_OUT]; ldw = DM; K = DM; N = DM; gain = nullptr; doff = W_SC_OUT; }
        else if ((r -= 512) < 2048) { src = P.in[IN_GDN_IN]; ldw = 4112; K = DM; N = 4096; gain = P.in[IN_MIXN] + 2 * DM; doff = W_GDN_IN; }
        else if ((r -= 2048) < 512) { src = P.in[IN_GDN_O]; ldw = DM; K = DM; N = DM; gain = nullptr; doff = W_GDN_O; }
        else if ((r -= 512) < 4 * 2816) { const int j = r / 2816; r -= j * 2816; src = P.in[IN_FFN_UP] + (size_t)j * DM * (2 * FFD); ldw = 2 * FFD; K = DM; N = 2 * FFD; gain = P.in[IN_FFNN] + j * DM; doff = W_FFN_UP + j * W_FFN_UP_STRIDE; map = 1; }
        else { r -= 4 * 2816; const int j = r / 1408; r -= j * 1408; src = P.in[IN_FFN_DN] + (size_t)j * FFD * DM; ldw = DM; K = FFD; N = DM; gain = nullptr; doff = W_FFN_DN + j * W_FFN_DN_STRIDE; }
        const int nblk = N / 32, kb = r / nblk, nb = r % nblk, n0 = 32 * nb;
        int sc0 = n0;
        if (map == 1) { const int tile = n0 >> 8, w = n0 & 255; sc0 = (w < 128) ? tile * 128 + w : FFD + tile * 128 + (w - 128); }
        transpose_item(src, ldw, K, sc0, gain, (bf16_t*)((unsigned char*)Wb + doff), n0, 64 * kb, scr, lane);
    }
    { bf16_t* bgh = (bf16_t*)(P.ws + WS_MISC + MISC_BGW); bf16_t* bgl = bgh + 16 * DM; const float* src = P.in[IN_GDN_IN]; const float* gain = P.in[IN_MIXN] + 2 * DM;
      for (int i = wg * 512 + tid; i < 16 * DM; i += G * 512) { const int c = i >> 10, k = i & 1023; const float w = src[(size_t)k * 4112 + 4096 + c] * gain[k]; const bf16_t hi = f2bf(w); bgh[i] = hi; bgl[i] = f2bf(w - bf2f(hi)); } }
    { const float* x = P.in[IN_X]; bf16_t* xb = (bf16_t*)(P.ws + WS_XB); u64_t* ssq = (u64_t*)(P.ws + WS_SSQ);
      for (int t0 = gw; t0 < T_TOK; t0 += 4 * NGW) {
          f32x4 v[4][4];
#pragma unroll
          for (int r = 0; r < 4; ++r) { const f32x4* xr = (const f32x4*)(x + (size_t)(t0 + r * NGW) * DM) + lane;
#pragma unroll
              for (int j = 0; j < 4; ++j) v[r][j] = xr[64 * j]; }
#pragma unroll
          for (int r = 0; r < 4; ++r) { const int t = t0 + r * NGW; u32x2* brow = (u32x2*)(xb + (size_t)t * DM) + lane; float s = 0.f;
#pragma unroll
              for (int j = 0; j < 4; ++j) { const f32x4 q = v[r][j]; u32x2 w; w.x = cvt_pk_bf16(q[0], q[1]); w.y = cvt_pk_bf16(q[2], q[3]); brow[64 * j] = w; s += (q[0] * q[0] + q[1] * q[1]) + (q[2] * q[2] + q[3] * q[3]); }
              s = wave_sum(s); if (lane == 0) ssq[t] = ssq_fix(s); } } }
}

__device__ __forceinline__ void phase_final(const Params& P, int wg, int G) {
    const int tid = opaque_tid(), lane = tid & 63, wave = tid >> 6, gw = wg * 8 + wave, NGW = G * 8;
    const u64_t* ssq = (const u64_t*)(P.ws + WS_SSQ) + (size_t)8 * T_TOK; const f32x4* gn = (const f32x4*)P.in[IN_FINN] + lane; const bf16_t* xb = (const bf16_t*)(P.ws + WS_XB);
    const f32x4 g0 = gn[0], g1 = gn[64], g2 = gn[128], g3 = gn[192];
    for (int t0 = gw; t0 < T_TOK; t0 += 4 * NGW) {
        u32x2 v[4][4]; float rs[4];
#pragma unroll
        for (int r = 0; r < 4; ++r) { const int t = t0 + r * NGW; rs[r] = ssq_rs(ssq[t]); const u32x2* xr = (const u32x2*)(xb + (size_t)t * DM) + lane;
#pragma unroll
            for (int j = 0; j < 4; ++j) v[r][j] = xr[64 * j]; }
#pragma unroll
        for (int r = 0; r < 4; ++r) { const int t = t0 + r * NGW; f32x4* xo = (f32x4*)(P.out + (size_t)t * DM) + lane;
            xo[0] = bf4(v[r][0]) * rs[r] * g0; xo[64] = bf4(v[r][1]) * rs[r] * g1; xo[128] = bf4(v[r][2]) * rs[r] * g2; xo[192] = bf4(v[r][3]) * rs[r] * g3; }
    }
}

__device__ __forceinline__ void phase_ffn_fix(const Params& P, int layer, int wg, int G) {
    const float* halo = (const float*)(P.ws + WS_S + S_FFN_HALO); bf16_t* act = (bf16_t*)(P.ws + WS_S + S_FFN_ACT); const float* cw = P.in[IN_FFN_CONV] + (size_t)layer * 3 * (2 * FFD);
    const int tid = opaque_tid();
    for (int i = wg * 512 + tid; i < 512 * FFD; i += G * 512) {
        const int row = i / FFD, c = i - row * FFD, g = row >> 1, tau = row & 1, t = 128 * g + tau, s = t & (SEQ - 1);
        const float* hg = halo + (size_t)g * 4 * (2 * FFD); const float* hp = hg - 4 * (2 * FFD);
        float g0, g1, g2, u0, u1, u2;
        if (tau == 0) { g0 = hg[c]; u0 = hg[FFD + c]; if (s >= 2) { g1 = hp[3 * (2 * FFD) + c]; u1 = hp[3 * (2 * FFD) + FFD + c]; g2 = hp[2 * (2 * FFD) + c]; u2 = hp[2 * (2 * FFD) + FFD + c]; } else { g1 = g2 = u1 = u2 = 0.f; } }
        else { g0 = hg[(2 * FFD) + c]; u0 = hg[(2 * FFD) + FFD + c]; g1 = hg[c]; u1 = hg[FFD + c]; if (s >= 2) { g2 = hp[3 * (2 * FFD) + c]; u2 = hp[3 * (2 * FFD) + FFD + c]; } else { g2 = u2 = 0.f; } }
        const float gc = cw[2 * (2 * FFD) + c] * g0 + cw[(2 * FFD) + c] * g1 + cw[c] * g2;
        const float uc = cw[2 * (2 * FFD) + FFD + c] * u0 + cw[(2 * FFD) + FFD + c] * u1 + cw[FFD + c] * u2;
        act[(size_t)t * FFD + c] = f2bf(silu_f(gc) * uc);
    }
}

__device__ __forceinline__ void phase_sconv(const Params& P, int wg, int G) {
    const bf16_t* proj = (const bf16_t*)(P.ws + WS_S + S_SC_PROJ); bf16_t* y = (bf16_t*)(P.ws + WS_S + S_SC_Y); const float* cw = P.in[IN_SC_CONV];
    const int c = 2 * opaque_tid();
    const float w00 = cw[c], w01 = cw[c + 1], w10 = cw[DM + c], w11 = cw[DM + c + 1], w20 = cw[2 * DM + c], w21 = cw[2 * DM + c + 1];
    for (int ch = wg; ch < T_TOK / 64; ch += G) {
        const int t0 = ch * 64, s0 = t0 & (SEQ - 1);
        float p1a = 0.f, p1b = 0.f, p2a = 0.f, p2b = 0.f;
        if (s0 != 0) {
            const unsigned c1 = *(const unsigned*)(proj + (size_t)(t0 - 1) * 3072 + DM + c), x1 = *(const unsigned*)(proj + (size_t)(t0 - 1) * 3072 + 2 * DM + c);
            const unsigned c2 = *(const unsigned*)(proj + (size_t)(t0 - 2) * 3072 + DM + c), x2 = *(const unsigned*)(proj + (size_t)(t0 - 2) * 3072 + 2 * DM + c);
            p1a = bf_lo(c1) * bf_lo(x1); p1b = bf_hi(c1) * bf_hi(x1); p2a = bf_lo(c2) * bf_lo(x2); p2b = bf_hi(c2) * bf_hi(x2);
        }
#pragma unroll 1
        for (int i0 = 0; i0 < 64; i0 += 16) {
            unsigned bb[16], cc[16], xx[16];
#pragma unroll
            for (int i = 0; i < 16; ++i) { const bf16_t* r = proj + (size_t)(t0 + i0 + i) * 3072; bb[i] = *(const unsigned*)(r + c); cc[i] = *(const unsigned*)(r + DM + c); xx[i] = *(const unsigned*)(r + 2 * DM + c); }
#pragma unroll
            for (int i = 0; i < 16; ++i) {
                const float pa = bf_lo(cc[i]) * bf_lo(xx[i]), pb = bf_hi(cc[i]) * bf_hi(xx[i]);
                const float ya = bf_lo(bb[i]) * (w20 * pa + w10 * p1a + w00 * p2a), yb = bf_hi(bb[i]) * (w21 * pb + w11 * p1b + w01 * p2b);
                *(unsigned*)(y + (size_t)(t0 + i0 + i) * DM + c) = cvt_pk_bf16(ya, yb);
                p2a = p1a; p2b = p1b; p1a = pa; p1b = pb; }
        }
    }
}

__device__ __forceinline__ void phase_moba_kmean_vt(const Params& P, LAS unsigned char* lds, int wg, int G) {
    const bf16_t* qkv = (const bf16_t*)(P.ws + WS_S + S_MOBA_QKV); bf16_t* kmh = (bf16_t*)(P.ws + WS_MISC + MISC_KMEAN); bf16_t* kml = kmh + 1024 * 128;
    const int tid = opaque_tid();
    LAS float* red = (LAS float*)lds;
    for (int u = wg; u < 1024; u += G) {
        const int b = u >> 9, h = (u >> 6) & 7, blk = u & 63; const size_t row0 = (size_t)b * SEQ + (size_t)blk * BLK;
        __syncthreads();
        { const int d2 = tid & 63, part = tid >> 6; float s0 = 0.f, s1 = 0.f; const bf16_t* kp = qkv + (row0 + part * 32) * 3072 + DM + h * HD + 2 * d2;
          unsigned kq[32];
#pragma unroll
          for (int i = 0; i < 32; ++i) kq[i] = *(const unsigned*)(kp + (size_t)i * 3072);
#pragma unroll
          for (int i = 0; i < 32; ++i) { s0 += bf_lo(kq[i]); s1 += bf_hi(kq[i]); }
          red[part * 128 + 2 * d2] = s0; red[part * 128 + 2 * d2 + 1] = s1; }
        {
            float* kn = (float*)(P.ws + WS_S + S_MOBA_KN); const int lane_ = tid & 63, w_ = tid >> 6; float mxn = 0.f; unsigned kv[32];
            const bf16_t* kp = qkv + (row0 + w_ * 32) * 3072 + DM + h * HD + 2 * lane_;
#pragma unroll
            for (int i = 0; i < 32; ++i) kv[i] = *(const unsigned*)(kp + (size_t)i * 3072);
#pragma unroll
            for (int i = 0; i < 32; ++i) { const float a = bf_lo(kv[i]), c = bf_hi(kv[i]); const float nn = __builtin_amdgcn_sqrtf(wave_sum(a * a + c * c)); mxn = fmaxf(mxn, nn); if (lane_ == 0) kn[(row0 + w_ * 32 + i) * NH + h] = nn; }
            if (lane_ == 0) red[1024 + w_] = mxn; }
        __syncthreads();
        if (tid == 0) { float m = 0.f;
#pragma unroll
            for (int w = 0; w < 8; ++w) m = fmaxf(m, red[1024 + w]);
            ((float*)(P.ws + WS_S + S_MOBA_KMAX))[u] = m; }
        if (tid < 128) { float s = 0.f;
#pragma unroll
            for (int p = 0; p < 8; ++p) s += red[p * 128 + tid];
            const float m = s * (1.0f / BLK); const bf16_t hi = f2bf(m); kmh[(size_t)u * 128 + tid] = hi; kml[(size_t)u * 128 + tid] = f2bf(m - bf2f(hi)); }
    }
}


__device__ __forceinline__ void phase_moba_gate2(const Params& P, LAS unsigned char* lds, int mj, int wg, int G) {
    const bf16_t* qkv = (const bf16_t*)(P.ws + WS_S + S_MOBA_QKV); const bf16_t* kmh = (const bf16_t*)(P.ws + WS_MISC + MISC_KMEAN); const bf16_t* kml = kmh + 1024 * 128;
    int* cnt = (int*)(P.ws + WS_CTL + CTL_CNT) + mj * 1024; unsigned short* list = (unsigned short*)(P.ws + WS_S + S_MOBA_LIST);
    const int tid = opaque_tid(), lane = tid & 63, wave = __builtin_amdgcn_readfirstlane(tid >> 6), i16 = lane & 15, quad = lane >> 4;
    LAS float* SC = (LAS float*)(lds + 34816); LAS int* cntL = (LAS int*)(lds + 34816 + 66560); LAS int* baseL = cntL + 64; LAS float* qnL = (LAS float*)(baseL + 64); LAS float* kmxL = qnL + 256;
    for (int u = wg; u < 63 * 16; u += G) {
        const int own = 63 - u / 16, bh = u & 15, b = bh >> 3, h = bh & 7, nnb = (own + 15) >> 4;
        __syncthreads();
        if (tid < 64) cntL[tid] = 0;
        for (int c = tid; c < nnb * 256; c += 512) { const int row = c >> 4, pc = c & 15;
            *(LAS u32x4*)(lds + row * 272 + pc * 16) = *(const u32x4*)(kmh + (size_t)(bh * NBLK + row) * 128 + pc * 8);
            *(LAS u32x4*)(lds + 17408 + row * 272 + pc * 16) = *(const u32x4*)(kml + (size_t)(bh * NBLK + row) * 128 + pc * 8); }
        bf16x8 qf[2][4];
#pragma unroll
        for (int q2 = 0; q2 < 2; ++q2) { const bf16_t* qp = qkv + ((size_t)b * SEQ + own * BLK + 16 * (2 * wave + q2) + i16) * 3072 + h * HD + 8 * quad;
#pragma unroll
            for (int ks = 0; ks < 4; ++ks) qf[q2][ks] = *(const bf16x8*)(qp + 32 * ks);
            float s2 = 0.f;
#pragma unroll
            for (int ks = 0; ks < 4; ++ks) { const u32x4 w4 = __builtin_bit_cast(u32x4, qf[q2][ks]);
#pragma unroll
                for (int e = 0; e < 4; ++e) { const float a = bf_lo(w4[e]), c = bf_hi(w4[e]); s2 += a * a + c * c; } }
            s2 += __shfl_xor(s2, 16); s2 += __shfl_xor(s2, 32);
            if (quad == 0) qnL[16 * (2 * wave + q2) + i16] = s2; }
        if (tid < 64) kmxL[tid] = ((const float*)(P.ws + WS_S + S_MOBA_KMAX))[bh * NBLK + tid];
        __syncthreads();
#pragma unroll
        for (int q2 = 0; q2 < 2; ++q2)
#pragma unroll 1
            for (int nb = 0; nb < nnb; ++nb) { f32x4 acc = (f32x4){0.f, 0.f, 0.f, 0.f};
#pragma unroll
                for (int ks = 0; ks < 4; ++ks) { acc = __builtin_amdgcn_mfma_f32_16x16x32_bf16(qf[q2][ks], *(const LAS bf16x8*)(lds + 17408 + (16 * nb + i16) * 272 + (32 * ks + 8 * quad) * 2), acc, 0, 0, 0);
                                                 acc = __builtin_amdgcn_mfma_f32_16x16x32_bf16(qf[q2][ks], *(const LAS bf16x8*)(lds + (16 * nb + i16) * 272 + (32 * ks + 8 * quad) * 2), acc, 0, 0, 0); }
#pragma unroll
                for (int jj = 0; jj < 4; ++jj) SC[(16 * (2 * wave + q2) + 4 * quad + jj) * 65 + 16 * nb + i16] = acc[jj]; }
        __syncthreads();
        int sel[3] = {-1, -1, -1}, lp[3] = {0, 0, 0};
        if (tid < 256) { const LAS float* sr = SC + tid * 65;
            float v0 = -3.0e38f, v1 = -3.0e38f, v2 = -3.0e38f; int i0 = -1, i1 = -1, i2 = -1;
            for (int n = 0; n < own; ++n) { const float s = sr[n];
                if (s > v0) { v2 = v1; i2 = i1; v1 = v0; i1 = i0; v0 = s; i0 = n; } else if (s > v1) { v2 = v1; i2 = i1; v1 = s; i1 = n; } else if (s > v2) { v2 = s; i2 = n; } }
            sel[0] = i0; sel[1] = i1; sel[2] = i2;
            const int tl_ = own * BLK + tid; const float qn = __builtin_amdgcn_sqrtf(qnL[tid]) * 0.08838834764831845f, kself = ((const float*)(P.ws + WS_S + S_MOBA_KN))[((size_t)b * SEQ + tl_) * NH + h], slope = exp2f(-(float)(h + 1));
            unsigned mbits = 0u;
#pragma unroll
            for (int s = 0; s < 3; ++s) if (sel[s] >= 0) { const float bound = qn * (kmxL[sel[s]] + kself) - slope * (float)(tl_ - (sel[s] * BLK + BLK - 1));
                if (bound < -110.0f) sel[s] = -1; else mbits |= 1u << s; }
            ((unsigned char*)(P.ws + WS_S + S_MOBA_MASK))[((size_t)b * SEQ + tl_) * NH + h] = (unsigned char)mbits;
#pragma unroll
            for (int s = 0; s < 3; ++s) lp[s] = (sel[s] >= 0) ? __hip_atomic_fetch_add(cntL + sel[s], 1, __ATOMIC_RELAXED, __HIP_MEMORY_SCOPE_WORKGROUP) : 0;
        }
        __syncthreads();
        if (tid < 64) { const int c = cntL[tid]; baseL[tid] = (c > 0) ? atomicAdd(cnt + (b * NH + h) * NBLK + tid, c) : 0; }
        __syncthreads();
        if (tid < 256) { const int tl = own * BLK + tid;
#pragma unroll
            for (int s = 0; s < 3; ++s) if (sel[s] >= 0) list[(size_t)((b * NH + h) * NBLK + sel[s]) * SEQ + baseL[sel[s]] + lp[s]] = (unsigned short)((tl << 2) | s); }
    }
}

constexpr int AT_KSTRIDE = 272, AT_VS = 256 * 272, AT_VSTRIDE = 288, AT_PREF = AT_VS + 256 * 288;
typedef short s16x4 __attribute__((ext_vector_type(4)));
struct AtRegs { u32x4 p[8]; bf16x8 q[4]; unsigned mbits; float ls[3]; };
#define AT_BAR() do { asm volatile("s_waitcnt lgkmcnt(0)" ::: "memory"); __builtin_amdgcn_s_barrier(); asm volatile("" ::: "memory"); } while (0)
template <bool OWN>
__device__ __forceinline__ void attn_issue_kq(const Params& P, int b, int h, int j, int tl, int tid, AtRegs& R) {
    const bf16_t* qkvb = (const bf16_t*)(P.ws + WS_S + S_MOBA_QKV) + (size_t)b * SEQ * 3072;
    const int piece = tid & 15, r0 = tid >> 4, quad = (tid & 63) >> 4;
    const char* kp = (const char*)(qkvb + (size_t)(j * BLK + 8 * ((r0 & 15) >> 2) + 4 * (r0 >> 4) + (r0 & 3)) * 3072 + DM + h * HD + piece * 8);
#pragma unroll
    for (int it = 0; it < 8; ++it) R.p[it] = *(const u32x4*)(kp + (size_t)it * (32 * 3072 * 2));
    const bf16_t* qp = qkvb + (size_t)tl * 3072 + h * HD + quad * 8;
#pragma unroll
    for (int ks = 0; ks < 4; ++ks) R.q[ks] = *(const bf16x8*)(qp + 32 * ks);
    if (OWN) { R.mbits = (j != 0) ? (unsigned)((const unsigned char*)(P.ws + WS_S + S_MOBA_MASK))[((size_t)b * SEQ + tl) * NH + h] : 0u;
        const float* plse = (const float*)(P.ws + WS_S + S_MOBA_LSE) + ((size_t)tl * NH + h) * 3;
#pragma unroll
        for (int s = 0; s < 3; ++s) R.ls[s] = plse[s]; }
}
template <bool OWN, int nkb>
__device__ __forceinline__ void attn_tile(const Params& P, LAS unsigned char* lds, int b, int h, int j, int tl, bool valid, int slot, AtRegs& R, bool hasN, int hN, int jN, int tlN) {
    const int tid = opaque_tid(), lane = tid & 63, i = lane & 15, quad = lane >> 4, piece = tid & 15, r0 = tid >> 4;
    bf16_t* qkvb = (bf16_t*)(P.ws + WS_S + S_MOBA_QKV) + (size_t)b * SEQ * 3072;
    AT_BAR();
#pragma unroll
    for (int it = 0; it < 8; ++it) *(LAS u32x4*)(lds + (r0 + 32 * it) * AT_KSTRIDE + piece * 16) = R.p[it];
    bf16x8 qf[4]; unsigned mbits = 0u; float ls[3] = {0.f, 0.f, 0.f};
#pragma unroll
    for (int ks = 0; ks < 4; ++ks) qf[ks] = R.q[ks];
    if (OWN) { mbits = R.mbits;
#pragma unroll
        for (int s = 0; s < 3; ++s) ls[s] = R.ls[s]; }
    AT_BAR();
    bf16_t* op = qkvb + (size_t)tl * 3072 + h * HD + 4 * quad;
    u32x2 pv[3][8];
    if (OWN) { const bf16_t* ppo = (const bf16_t*)(P.ws + WS_S + S_MOBA_PO) + ((size_t)tl * NH + h) * 3 * HD + 4 * quad;
#pragma unroll
        for (int s = 0; s < 3; ++s) { const bf16_t* src = ((mbits >> s) & 1u) ? ppo + (size_t)s * HD : op;
#pragma unroll
            for (int db = 0; db < 8; ++db) pv[s][db] = *(const u32x2*)(src + 16 * db); } }
    { const char* vp = (const char*)(qkvb + (size_t)(j * BLK + r0) * 3072 + 2 * DM + h * HD + piece * 8);
#pragma unroll
      for (int it = 0; it < 8; ++it) R.p[it] = *(const u32x4*)(vp + (size_t)it * (32 * 3072 * 2)); }
    f32x4 sc[16];
#pragma unroll
    for (int kb = 0; kb < 16; ++kb) {
        sc[kb] = (f32x4){0.f, 0.f, 0.f, 0.f};
        if (kb < nkb) {
#pragma unroll
            for (int ks = 0; ks < 4; ++ks) { const bf16x8 kf = *(const LAS bf16x8*)(lds + (16 * kb + i) * AT_KSTRIDE + (32 * ks + 8 * quad) * 2);
                sc[kb] = __builtin_amdgcn_mfma_f32_16x16x32_bf16(kf, qf[ks], sc[kb], 0, 0, 0); }
        }
    }
    const float slope = fast_exp2(-(float)(h + 1)) * LOG2E, scale = 0.08838834764831845f * LOG2E;
    float mx = -3.0e38f;
    const int rq = tl - j * BLK - 8 * quad; const float c0 = -slope * (float)rq;
#pragma unroll
    for (int kb = 0; kb < 16; ++kb) if (kb < nkb) {
#pragma unroll
        for (int jj = 0; jj < 4; ++jj) { const int K = 32 * (kb >> 1) + 4 * (kb & 1) + jj;
            float s = fmaf(sc[kb][jj], scale, fmaf(slope, (float)K, c0)); if (OWN && K > rq) s = -1.0e30f; sc[kb][jj] = s; mx = fmaxf(mx, s); }
    }
    mx = fmaxf(mx, __shfl_xor(mx, 16)); mx = fmaxf(mx, __shfl_xor(mx, 32));
    float l = 0.f;
#pragma unroll
    for (int kb = 0; kb < 16; ++kb) if (kb < nkb) {
#pragma unroll
        for (int jj = 0; jj < 4; ++jj) { const float p = fast_exp2(sc[kb][jj] - mx); sc[kb][jj] = p; l += p; }
    }
    l += __shfl_xor(l, 16); l += __shfl_xor(l, 32);
    const float lse = (mx + __log2f(l)) * LN2;
    f32x4 oacc[8];
    if (OWN) {
        float M = lse;
#pragma unroll
        for (int s = 0; s < 3; ++s) { ls[s] = ((mbits >> s) & 1u) ? ls[s] : -3.0e38f; M = fmaxf(M, ls[s]); }
        const float wown = __expf(lse - M); float wsl[3]; float den = wown;
#pragma unroll
        for (int s = 0; s < 3; ++s) { wsl[s] = ((mbits >> s) & 1u) ? __expf(ls[s] - M) : 0.f; den += wsl[s]; }
        const float rden = fast_rcp(den), wo = wown * fast_rcp(l) * rden;
#pragma unroll
        for (int s = 0; s < 3; ++s) wsl[s] *= rden;
#pragma unroll
        for (int kb = 0; kb < 16; ++kb) if (kb < nkb) sc[kb] = sc[kb] * wo;
#pragma unroll
        for (int db = 0; db < 8; ++db) { f32x4 o = (f32x4){0.f, 0.f, 0.f, 0.f};
#pragma unroll
            for (int s = 0; s < 3; ++s) { const u32x2 q = pv[s][db]; const float ww = wsl[s];
                o[0] += ww * bf_lo(q.x); o[1] += ww * bf_hi(q.x); o[2] += ww * bf_lo(q.y); o[3] += ww * bf_hi(q.y); }
            oacc[db] = o; }
    } else {
#pragma unroll
        for (int db = 0; db < 8; ++db) oacc[db] = (f32x4){0.f, 0.f, 0.f, 0.f};
    }
    bf16x8 pf[8];
#pragma unroll
    for (int s = 0; s < 8; ++s) if (2 * s < nkb) pf[s] = pack8(sc[2 * s], sc[2 * s + 1]);
#pragma unroll
    for (int it = 0; it < 8; ++it) *(LAS u32x4*)(lds + AT_VS + (r0 + 32 * it) * AT_VSTRIDE + piece * 16) = R.p[it];
    AT_BAR();
    if (hasN) attn_issue_kq<OWN>(P, b, hN, jN, tlN, tid, R);
#pragma unroll
    for (int s = 0; s < 8; ++s) if (2 * s < nkb) {
#pragma unroll
        for (int db = 0; db < 8; ++db) {
            const LAS unsigned char* vp = lds + AT_VS + (32 * s + 8 * quad + (i >> 2)) * AT_VSTRIDE + (16 * db + 4 * (i & 3)) * 2;
            const s16x4 lo = __builtin_amdgcn_ds_read_tr16_b64_v4i16((LAS s16x4*)vp), hi = __builtin_amdgcn_ds_read_tr16_b64_v4i16((LAS s16x4*)(vp + 4 * AT_VSTRIDE));
            const bf16x8 vf = __builtin_shufflevector(lo, hi, 0, 1, 2, 3, 4, 5, 6, 7);
            oacc[db] = __builtin_amdgcn_mfma_f32_16x16x32_bf16(vf, pf[s], oacc[db], 0, 0, 0); }
    }
    if (!OWN) {
        if (valid) {
            const float inv = fast_rcp(l); const size_t pr = ((size_t)tl * NH + h) * 3 + slot;
            bf16_t* po = (bf16_t*)(P.ws + WS_S + S_MOBA_PO) + pr * HD + 4 * quad;
#pragma unroll
            for (int db = 0; db < 8; ++db) { u32x2 w; w.x = cvt_pk_bf16(oacc[db][0] * inv, oacc[db][1] * inv); w.y = cvt_pk_bf16(oacc[db][2] * inv, oacc[db][3] * inv); *(u32x2*)(po + 16 * db) = w; }
            if (quad == 0) ((float*)(P.ws + WS_S + S_MOBA_LSE))[pr] = lse;
        }
    } else {
#pragma unroll
        for (int db = 0; db < 8; ++db) { u32x2 w; w.x = cvt_pk_bf16(oacc[db][0], oacc[db][1]); w.y = cvt_pk_bf16(oacc[db][2], oacc[db][3]); *(u32x2*)(op + 16 * db) = w; }
    }
}

__device__ __forceinline__ void phase_moba_gather(const Params& P, LAS unsigned char* lds, int mj, int b, int wg, int G) {
    const int* cnt = (const int*)(P.ws + WS_CTL + CTL_CNT) + mj * 1024 + b * 512;
    const unsigned short* list = (const unsigned short*)(P.ws + WS_S + S_MOBA_LIST) + (size_t)b * 512 * SEQ;
    const int tid = opaque_tid(), lane = tid & 63, wid = tid >> 6;
    LAS int* pref = (LAS int*)(lds + AT_PREF); LAS int* cl = pref + 520; LAS int* wtot = cl + 512;
    __syncthreads();
    { const int c = cnt[tid]; int v = (c + 127) >> 7; cl[tid] = c;
#pragma unroll
      for (int o = 1; o < 64; o <<= 1) { const int y = __shfl_up(v, o); if (lane >= o) v += y; }
      if (lane == 63) wtot[wid] = v;
      __syncthreads();
      int base = 0; for (int w = 0; w < wid; ++w) base += wtot[w];
      pref[tid + 1] = base + v; if (tid == 0) pref[0] = 0; }
    __syncthreads();
    const int total = pref[512];
    const int nx = G >> 3, xr = (G & 7) ? 0 : 1;
    int item = xr ? (wg & 7) * nx + (wg >> 3) : wg;
    if (item >= total) return;
#define AT_DECODE(it_, hj_, va_, ad_) do { int lo_ = 0, hi_ = 512; while (hi_ - lo_ > 1) { const int mid_ = (lo_ + hi_) >> 1; if (pref[mid_] <= (it_)) lo_ = mid_; else hi_ = mid_; } \
        hj_ = lo_; const int c_ = cl[lo_], e_ = ((it_) - pref[lo_]) * 128 + 16 * wid + (lane & 15); va_ = e_ < c_; ad_ = list + (size_t)lo_ * SEQ + (va_ ? e_ : c_ - 1); } while (0)
    int hjA, hjB = 0, hjC = 0; bool vaA, vaB = false, vaC = false; const unsigned short* ad; unsigned eA, eB = 0, eC = 0;
    AT_DECODE(item, hjA, vaA, ad); eA = *ad;
    bool hasB = item + G < total;
    if (hasB) { AT_DECODE(item + G, hjB, vaB, ad); eB = *ad; }
    AtRegs R;
    attn_issue_kq<false>(P, b, hjA >> 6, hjA & 63, (int)(eA >> 2), tid, R);
    for (;;) {
        const bool hasC = item + 2 * G < total;
        if (hasC) { AT_DECODE(item + 2 * G, hjC, vaC, ad); eC = *ad; }
        attn_tile<false, 16>(P, lds, b, hjA >> 6, hjA & 63, (int)(eA >> 2), vaA, (int)(eA & 3), R, hasB, hjB >> 6, hjB & 63, (int)(eB >> 2));
        if (!hasB) break;
        hjA = hjB; vaA = vaB; eA = eB; hjB = hjC; vaB = vaC; eB = eC; hasB = hasC; item += G;
    }
#undef AT_DECODE
}
__device__ __forceinline__ void phase_moba_own(const Params& P, LAS unsigned char* lds, int b, int wg, int G) {
    const int tid = opaque_tid(), lane = tid & 63, wid = tid >> 6;
    const int nx = G >> 3, xr = (G & 7) ? 0 : 1;
    int it = xr ? (wg & 7) * nx + (wg >> 3) : wg;
    if (it >= 1024) return;
#define AT_OWN(it_, h_, j_, c_, tl_) do { const int hj_ = (it_) >> 1; c_ = (((it_) >> 8) ^ (it_)) & 1; h_ = hj_ >> 6; j_ = hj_ & 63; tl_ = j_ * BLK + 128 * c_ + 16 * wid + (lane & 15); } while (0)
    int hA, jA, cA, tlA, hB = 0, jB = 0, cB = 0, tlB = 0;
    AT_OWN(it, hA, jA, cA, tlA);
    AtRegs R;
    attn_issue_kq<true>(P, b, hA, jA, tlA, tid, R);
    for (;;) {
        const bool hasB = it + G < 1024;
        if (hasB) AT_OWN(it + G, hB, jB, cB, tlB);
        if (cA) attn_tile<true, 16>(P, lds, b, hA, jA, tlA, true, 0, R, hasB, hB, jB, tlB); else attn_tile<true, 8>(P, lds, b, hA, jA, tlA, true, 0, R, hasB, hB, jB, tlB);
        if (!hasB) break;
        hA = hB; jA = jB; cA = cB; tlA = tlB; it += G;
    }
#undef AT_OWN
}
__device__ __forceinline__ void phase_gdn_bg(const Params& P, int wg, int G) {
    const int tid = opaque_tid(), lane = tid & 63, wave = tid >> 6, gw = wg * 8 + wave, NGW = G * 8, i16 = lane & 15, quad = lane >> 4;
    const bf16_t* X = (const bf16_t*)(P.ws + WS_XB); const u64_t* ssq = (const u64_t*)(P.ws + WS_SSQ) + (size_t)4 * T_TOK; const bf16_t* bgh = (const bf16_t*)(P.ws + WS_MISC + MISC_BGW); const bf16_t* bgl = bgh + 16 * DM;
    float* bg = (float*)(P.ws + WS_S + S_GDN_BG); const float* alog = P.in[IN_GDN_ALOG]; const float* dtb = P.in[IN_GDN_DTB];
    for (int g = gw; g < T_TOK / 16; g += NGW) {
        const int t = g * 16 + i16; const bf16_t* xr = X + (size_t)t * DM + 8 * quad; const bf16_t* wh = bgh + i16 * DM + 8 * quad; const bf16_t* wl = bgl + i16 * DM + 8 * quad;
        f32x4 acc = (f32x4){0.f, 0.f, 0.f, 0.f};
#pragma unroll 8
        for (int ks = 0; ks < 32; ++ks) { const bf16x8 xf = *(const bf16x8*)(xr + 32 * ks);
            acc = __builtin_amdgcn_mfma_f32_16x16x32_bf16(*(const bf16x8*)(wh + 32 * ks), xf, acc, 0, 0, 0); acc = __builtin_amdgcn_mfma_f32_16x16x32_bf16(*(const bf16x8*)(wl + 32 * ks), xf, acc, 0, 0, 0); }
        const float rs = ssq_rs(ssq[t]); f32x4 o;
#pragma unroll
        for (int jj = 0; jj < 4; ++jj) { const float raw = acc[jj] * rs;
            if (quad < 2) o[jj] = fast_rcp(1.0f + __expf(-raw));
            else { const int hh = 4 * (quad - 2) + jj; const float xx = raw + dtb[hh]; const float sp = fmaxf(xx, 0.f) + __logf(1.0f + __expf(-fabsf(xx))); o[jj] = -__expf(alog[hh]) * sp; } }
        *(f32x4*)(bg + (size_t)t * 16 + 4 * quad) = o;
    }
}
__device__ __forceinline__ u32x2 pack4(f32x4 v) { u32x2 w; w.x = cvt_pk_bf16(v[0], v[1]); w.y = cvt_pk_bf16(v[2], v[3]); return w; }
__device__ __forceinline__ void phase_gdn_chunk2(const Params& P, LAS unsigned char* lds, int wg, int G) {
    bf16_t* proj = (bf16_t*)(P.ws + WS_S + S_GDN_PROJ); bf16_t* attn = (bf16_t*)(P.ws + WS_S + S_GDN_ATTN); const float* bg = (const float*)(P.ws + WS_S + S_GDN_BG);
    const bf16_t* halo = (const bf16_t*)(P.ws + WS_S + S_GDN_HALO); float* gcum = (float*)(P.ws + WS_S + S_GDN_GC); bf16_t* wbuf = (bf16_t*)P.out; const float* cw = P.in[IN_GDN_CONV];
    LAS float* qL = (LAS float*)lds; LAS float* kL = qL + 64 * 132; LAS float* vL = kL + 64 * 132; LAS float* AL = vL + 64 * 132;
    LAS unsigned char* Qb = lds + 118784; LAS unsigned char* Kb = lds + 136192; LAS float* betaL = (LAS float*)(lds + 153600); LAS float* gcL = betaL + 64; LAS float* DinvL = (LAS float*)(lds + 154112);
    const int tid = opaque_tid(), lane = tid & 63, wave = __builtin_amdgcn_readfirstlane(tid >> 6), i16 = lane & 15, quad = lane >> 4;
    for (int u = wg; u < 4096; u += G) {
        const int b = u >> 11, h = (u >> 8) & 7, n = u & 255; const size_t t0 = (size_t)b * SEQ + (size_t)n * 64;
        bf16_t* projw = proj + t0 * 4096;
        __syncthreads();
        float be_pre = 0.f, gg_pre = 0.f;
        if (wave == 0) { const float* bgp = bg + (t0 + lane) * 16; be_pre = bgp[h]; gg_pre = bgp[8 + h]; }
        if (tid < 384) { const int mat = tid >> 7, d = tid & 127, col = mat * DM + h * HD + d;
            const float w0 = cw[col], w1 = cw[3072 + col], w2 = cw[2 * 3072 + col], w3 = cw[3 * 3072 + col];
            float x3 = 0.f, x2 = 0.f, x1 = 0.f;
            if (n > 0) { const bf16_t* hp = halo + ((t0 >> 6) - 1) * 3 * 3072 + col; x3 = bf2f(hp[0]); x2 = bf2f(hp[3072]); x1 = bf2f(hp[2 * 3072]); }
            const bf16_t* src = proj + t0 * 4096 + col; unsigned off = 0; bf16_t raw[64];
#pragma unroll
            for (int i = 0; i < 64; ++i) { raw[i] = src[off]; off += 4096; asm volatile("" : "+v"(off)); }
            __builtin_amdgcn_sched_barrier(0);
            LAS float* dst = (mat == 0 ? qL : (mat == 1 ? kL : vL)) + d;
#pragma unroll
            for (int i = 0; i < 64; ++i) { const float x0 = bf2f(raw[i]); dst[i * 132] = silu_f(w3 * x0 + w2 * x1 + w1 * x2 + w0 * x3); x3 = x2; x2 = x1; x1 = x0; } }
        __syncthreads();
#pragma unroll 4
        for (int rr = 0; rr < 16; ++rr) { const int r = wave * 16 + rr; LAS float* rowp = (r < 64 ? qL + r * 132 : kL + (r - 64) * 132) + 2 * lane;
            f32x2 v = *(LAS f32x2*)rowp; const float ss = wave_sum(v.x * v.x + v.y * v.y); const float scl = __builtin_amdgcn_rsqf(ss + EPS) * (r < 64 ? 0.08838834764831845f : 1.0f); v = v * scl; *(LAS f32x2*)rowp = v;
            *(LAS unsigned*)((r < 64 ? Qb : Kb) + (r & 63) * 272 + lane * 4) = cvt_pk_bf16(v.x, v.y); }
        if (wave == 0) { const float be = be_pre; float gg = gg_pre;
#pragma unroll
            for (int o = 1; o < 64; o <<= 1) { const float y = __shfl_up(gg, o); if (lane >= o) gg += y; }
            betaL[lane] = be; gcL[lane] = gg; gcum[(size_t)u * 64 + lane] = gg; }
        __syncthreads();
        {
            const int mat = wave >> 2, rb = wave & 3; const LAS unsigned char* Xb = mat ? Qb : Kb;
            bf16x8 af[4];
#pragma unroll
            for (int ks = 0; ks < 4; ++ks) af[ks] = *(const LAS bf16x8*)(Xb + (16 * rb + i16) * 272 + (32 * ks + 8 * quad) * 2);
            float gr[4], br[4];
#pragma unroll
            for (int jj = 0; jj < 4; ++jj) { gr[jj] = gcL[16 * rb + 4 * quad + jj]; br[jj] = betaL[16 * rb + 4 * quad + jj]; }
#pragma unroll
            for (int cb = 0; cb < 4; ++cb) {
                f32x4 acc = (f32x4){0.f, 0.f, 0.f, 0.f};
                if (cb <= rb) {
#pragma unroll
                    for (int ks = 0; ks < 4; ++ks) acc = __builtin_amdgcn_mfma_f32_16x16x32_bf16(af[ks], *(const LAS bf16x8*)(Kb + (16 * cb + i16) * 272 + (32 * ks + 8 * quad) * 2), acc, 0, 0, 0); }
                const int j = 16 * cb + i16; const float gj = gcL[j];
                const int pj = 32 * (cb >> 1) + 8 * (i16 >> 2) + 4 * (cb & 1) + (i16 & 3);
#pragma unroll
                for (int jj = 0; jj < 4; ++jj) { const int r = 16 * rb + 4 * quad + jj; const float dec = (j <= r) ? __expf(gr[jj] - gj) : 0.f;
                    if (mat == 0) AL[r * 68 + j] = (j < r) ? acc[jj] * br[jj] * dec : 0.f;
                    else *(LAS bf16_t*)(lds + 154112 + ((((r >> 4) * 2 + (pj >> 5)) * 64 + ((pj >> 3) & 3) * 16 + (r & 15)) * 8 + (pj & 7)) * 2) = f2bf((j <= r) ? acc[jj] * dec : 0.f); }
            }
        }
        __syncthreads();
        *(u32x4*)(attn + (size_t)u * 4096 + tid * 8) = *(const LAS u32x4*)(lds + 154112 + tid * 16);
#pragma unroll
        for (int k = 0; k < 2; ++k) { const int pi = tid + 512 * k, l_ = pi & 63, i_ = l_ & 15, q_ = l_ >> 4;
            { const int rb_ = pi >> 8, ks_ = (pi >> 6) & 3;
              *(u32x4*)(projw + (size_t)(pi >> 4) * 4096 + h * HD + (pi & 15) * 8) = *(const LAS u32x4*)(Qb + (16 * rb_ + i_) * 272 + (32 * ks_ + 8 * q_) * 2); }
            { const int w_ = pi >> 7, ks_ = (pi >> 6) & 1, dk = 16 * w_ + i_, p0 = 32 * ks_ + 8 * q_; float kv[8];
#pragma unroll
              for (int e = 0; e < 8; ++e) { const int tok = 16 * (2 * (p0 >> 5) + (e >> 2)) + 4 * ((p0 >> 3) & 3) + (e & 3); kv[e] = kL[tok * 132 + dk]; }
              u32x4 w; w.x = cvt_pk_bf16(kv[0], kv[1]); w.y = cvt_pk_bf16(kv[2], kv[3]); w.z = cvt_pk_bf16(kv[4], kv[5]); w.w = cvt_pk_bf16(kv[6], kv[7]);
              *(u32x4*)(projw + (size_t)(pi >> 4) * 4096 + DM + h * HD + (pi & 15) * 8) = w; } }
#pragma unroll
        for (int it = 0; it < 8; ++it) { const int p = tid + 512 * it, row = p >> 6, d = (p & 63) * 2;
            const f32x2 kv = *(LAS f32x2*)(kL + row * 132 + d), vv = *(LAS f32x2*)(vL + row * 132 + d);
            const float be = betaL[row], eg = __expf(gcL[row]);
            *(LAS f32x2*)(qL + row * 132 + d) = kv * (be * eg); *(LAS f32x2*)(vL + row * 132 + d) = vv * be; }
        __syncthreads();
        {
            { const int blk = lane >> 4, c = lane & 15; float y[16];
#pragma unroll
              for (int r = 0; r < 16; ++r) y[r] = (r == c) ? 1.0f : 0.0f;
#pragma unroll
              for (int r = 1; r < 16; ++r) { float s = 0.f;
#pragma unroll
                  for (int j4 = 0; j4 <= (r - 1) / 4; ++j4) { const f32x4 a4 = *(const LAS f32x4*)(AL + (16 * blk + r) * 68 + 16 * blk + 4 * j4);
                      s += a4[0] * y[4 * j4] + a4[1] * y[4 * j4 + 1] + a4[2] * y[4 * j4 + 2] + a4[3] * y[4 * j4 + 3]; }
                  y[r] -= s; }
#pragma unroll
              for (int r = 0; r < 16; ++r) DinvL[(16 * blk + r) * 16 + c] = y[r]; }
            LAS float* Xm = (wave < 4 ? vL : qL) + 32 * (wave & 3) + i16;
#pragma unroll 1
            for (int bi = 0; bi < 4; ++bi)
#pragma unroll 1
                for (int cbl = 0; cbl < 2; ++cbl) {
                    LAS float* Xc = Xm + 16 * cbl; f32x4 acc;
#pragma unroll
                    for (int jj = 0; jj < 4; ++jj) acc[jj] = Xc[(16 * bi + 4 * quad + jj) * 132];
#pragma unroll 1
                    for (int k = 0; k < bi; ++k)
#pragma unroll
                        for (int ks = 0; ks < 4; ++ks) acc = __builtin_amdgcn_mfma_f32_16x16x4f32(-AL[(16 * bi + i16) * 68 + 16 * k + 4 * ks + quad], Xc[(16 * k + 4 * ks + quad) * 132], acc, 0, 0, 0);
#pragma unroll
                    for (int jj = 0; jj < 4; ++jj) Xc[(16 * bi + 4 * quad + jj) * 132] = acc[jj];
                    f32x4 acc2 = (f32x4){0.f, 0.f, 0.f, 0.f};
#pragma unroll
                    for (int ks = 0; ks < 4; ++ks) acc2 = __builtin_amdgcn_mfma_f32_16x16x4f32(DinvL[(16 * bi + i16) * 16 + 4 * ks + quad], Xc[(16 * bi + 4 * ks + quad) * 132], acc2, 0, 0, 0);
#pragma unroll
                    for (int jj = 0; jj < 4; ++jj) Xc[(16 * bi + 4 * quad + jj) * 132] = acc2[jj];
                }
        }
        __syncthreads();
#pragma unroll
        for (int k = 0; k < 2; ++k) { const int pi = tid + 512 * k, q_ = pi & 3, l_ = (pi >> 2) & 63, rb_ = pi >> 8, tok = 16 * rb_ + 4 * (l_ >> 4), col = 32 * q_ + (l_ & 15);
            float uv[8];
#pragma unroll
            for (int e = 0; e < 8; ++e) uv[e] = vL[(tok + (e & 3)) * 132 + col + 16 * (e >> 2)];
            u32x4 w; w.x = cvt_pk_bf16(uv[0], uv[1]); w.y = cvt_pk_bf16(uv[2], uv[3]); w.z = cvt_pk_bf16(uv[4], uv[5]); w.w = cvt_pk_bf16(uv[6], uv[7]);
            *(u32x4*)(projw + (size_t)(pi >> 4) * 4096 + 2 * DM + h * HD + (pi & 15) * 8) = w; }
#pragma unroll
        for (int k = 0; k < 2; ++k) { const int pi = tid + 512 * k, l_ = pi & 63, rb_ = pi >> 8, ks_ = (pi >> 6) & 3;
            const LAS f32x4* wp = (const LAS f32x4*)(qL + (16 * rb_ + (l_ & 15)) * 132 + 32 * ks_ + 8 * (l_ >> 4)); const f32x4 a = wp[0], c = wp[1];
            u32x4 w; w.x = cvt_pk_bf16(a[0], a[1]); w.y = cvt_pk_bf16(a[2], a[3]); w.z = cvt_pk_bf16(c[0], c[1]); w.w = cvt_pk_bf16(c[2], c[3]);
            *(u32x4*)(wbuf + (t0 + (pi >> 4)) * DM + h * HD + (pi & 15) * 8) = w; }
    }
}
constexpr size_t DO_GP = 64 * MiB, DO_GQ = 72 * MiB, DO_GS = 88 * MiB;
#define GS_BAR() do { asm volatile("s_waitcnt lgkmcnt(0)" ::: "memory"); __builtin_amdgcn_s_barrier(); asm volatile("" ::: "memory"); } while (0)
__device__ __forceinline__ u32x2 packsoft4(f32x4 v) { u32x2 w; w.x = (unsigned)f2bf(v[0]) | ((unsigned)f2bf(v[1]) << 16); w.y = (unsigned)f2bf(v[2]) | ((unsigned)f2bf(v[3]) << 16); return w; }
__device__ __forceinline__ void phase_gdn_scanA(const Params& P, LAS unsigned char* lds, int wg, int G) {
    const bf16_t* proj = (const bf16_t*)(P.ws + WS_S + S_GDN_PROJ); const float* gcum = (const float*)(P.ws + WS_S + S_GDN_GC); const bf16_t* wbuf = (const bf16_t*)P.out;
    bf16_t* GP = (bf16_t*)((unsigned char*)P.out + DO_GP); float* GQ = (float*)((unsigned char*)P.out + DO_GQ);
    const int tid = opaque_tid(), lane = tid & 63, wave = __builtin_amdgcn_readfirstlane(tid >> 6), i16 = lane & 15, quad = lane >> 4, rb = wave & 3, hf = wave >> 2;
    LAS unsigned char* ST = lds; LAS unsigned char* VN2 = lds + 69632;
    const int p0 = 32 * (rb >> 1) + 8 * quad + 4 * (rb & 1);
    for (int task = wg; task < 256; task += G) {
        const int bh = task >> 4, g = task & 15, b = bh >> 3, h = bh & 7; const size_t t0 = (size_t)b * SEQ + (size_t)g * 1024, u0 = (size_t)bh * 256 + (size_t)g * 16;
        f32x4 sacc[16]; int dgo = i16 - 4 * quad; asm volatile("" : "+v"(dgo));
#pragma unroll
        for (int cb = 0; cb < 16; ++cb)
#pragma unroll
            for (int jj = 0; jj < 4; ++jj) sacc[cb][jj] = (cb < 8 && cb == wave && dgo == jj) ? 1.0f : 0.0f;
        __syncthreads();
#pragma unroll
        for (int cb = 0; cb < 16; ++cb) *(LAS u32x2*)(ST + (16 * cb + i16) * 272 + (16 * wave + 4 * quad) * 2) = pack4(sacc[cb]);
        const char* pA = (const char*)(wbuf + (t0 + 16 * rb + quad) * DM + h * HD + 8 * i16);
        const char* pK = (const char*)(proj + (t0 + 8 * wave + quad) * 4096 + DM + h * HD + 8 * i16);
        const char* pU = (const char*)(proj + (t0 + 16 * rb + (lane >> 2)) * 4096 + 2 * DM + h * HD + (lane & 3) * 32);
        const char* pG = (const char*)(gcum + u0 * 64 + 16 * rb + 4 * quad); const char* pGl = (const char*)(gcum + u0 * 64 + 63);
        bf16x8 fa[2][4], fk[2][2]; u32x4 uu[2][4]; f32x4 g4[2]; float gl[2];
#define GA_LOAD_A(S) do { _Pragma("unroll") for (int ks_ = 0; ks_ < 4; ++ks_) fa[S][ks_] = *(const bf16x8*)(pA + (size_t)ks_ * (4 * DM * 2)); \
        if (hf) { _Pragma("unroll") for (int q_ = 0; q_ < 4; ++q_) uu[S][q_] = *(const u32x4*)(pU + q_ * 16); } \
        g4[S] = *(const f32x4*)pG; gl[S] = *(const float*)pGl; pA += 64 * DM * 2; pU += 64 * 8192; pG += 256; pGl += 256; } while (0)
#define GA_LOAD_B(S) do { _Pragma("unroll") for (int ks_ = 0; ks_ < 2; ++ks_) fk[S][ks_] = *(const bf16x8*)(pK + (size_t)ks_ * 32768); pK += 64 * 8192; } while (0)
#pragma unroll
        for (int s_ = 0; s_ < 2; ++s_)
#pragma unroll
            for (int q_ = 0; q_ < 4; ++q_) uu[s_][q_] = (u32x4){0u, 0u, 0u, 0u};
        GA_LOAD_A(0); GA_LOAD_B(0); GA_LOAD_A(1); GA_LOAD_B(1);
        GS_BAR();
#define GA_STEP(nn, S) do { \
        const float glast_ = gl[S]; f32x4 ed_; \
        _Pragma("unroll") for (int jj_ = 0; jj_ < 4; ++jj_) ed_[jj_] = __expf(glast_ - g4[S][jj_]); \
        _Pragma("unroll") for (int c4_ = 0; c4_ < 8; c4_ += 4) { f32x4 acc1[4];        \
            _Pragma("unroll") for (int c_ = 0; c_ < 4; ++c_) { acc1[c_] = (f32x4){0.f, 0.f, 0.f, 0.f}; \
                _Pragma("unroll") for (int ks_ = 0; ks_ < 4; ++ks_) acc1[c_] = __builtin_amdgcn_mfma_f32_16x16x32_bf16(fa[S][ks_], *(const LAS bf16x8*)(ST + (16 * (8 * hf + c4_ + c_) + i16) * 272 + (32 * ks_ + 8 * quad) * 2), acc1[c_], 0, 0, 0); } \
            _Pragma("unroll") for (int c_ = 0; c_ < 4; ++c_) { const int cc_ = c4_ + c_; const unsigned ua_ = uu[S][cc_ >> 1][2 * (cc_ & 1)], ub_ = uu[S][cc_ >> 1][2 * (cc_ & 1) + 1]; f32x4 vn2_; \
                vn2_[0] = (bf_lo(ua_) - acc1[c_][0]) * ed_[0]; vn2_[1] = (bf_hi(ua_) - acc1[c_][1]) * ed_[1]; vn2_[2] = (bf_lo(ub_) - acc1[c_][2]) * ed_[2]; vn2_[3] = (bf_hi(ub_) - acc1[c_][3]) * ed_[3]; \
                *(LAS u32x2*)(VN2 + (16 * (8 * hf + cc_) + i16) * 144 + p0 * 2) = pack4(vn2_); } \
            asm volatile("" ::: "memory"); } \
        if ((nn) + 2 < 16) GA_LOAD_A(S); \
        GS_BAR(); \
        const float eg_ = __expf(glast_); \
        _Pragma("unroll") for (int cb_ = 0; cb_ < 16; ++cb_) { f32x4 acc_ = sacc[cb_] * eg_; \
            _Pragma("unroll") for (int ks_ = 0; ks_ < 2; ++ks_) acc_ = __builtin_amdgcn_mfma_f32_16x16x32_bf16(fk[S][ks_], *(const LAS bf16x8*)(VN2 + (16 * cb_ + i16) * 144 + (32 * ks_ + 8 * quad) * 2), acc_, 0, 0, 0); \
            sacc[cb_] = acc_; *(LAS u32x2*)(ST + (16 * cb_ + i16) * 272 + (16 * wave + 4 * quad) * 2) = packsoft4(acc_); \
            if ((cb_ & 3) == 3) asm volatile("" ::: "memory"); } \
        if ((nn) + 2 < 16) GA_LOAD_B(S); \
        GS_BAR(); } while (0)
#pragma unroll 1
        for (int n = 0; n < 16; n += 2) { GA_STEP(n, 0); GA_STEP(n + 1, 1); }
#undef GA_STEP
#undef GA_LOAD_A
#undef GA_LOAD_B
#pragma unroll
        for (int cb = 0; cb < 8; ++cb)
#pragma unroll
            for (int jj = 0; jj < 4; ++jj) GP[(size_t)task * 16384 + (16 * wave + 4 * quad + jj) * 128 + 16 * cb + i16] = f2bf(sacc[cb][jj]);
#pragma unroll
        for (int cb = 0; cb < 8; ++cb) *(f32x4*)(GQ + (((size_t)task * 8 + wave) * 64 + lane) * 32 + cb * 4) = sacc[8 + cb];
    }
}
__device__ __forceinline__ void phase_gdn_scanB(const Params& P, LAS unsigned char* lds, int wg, int G) {
    const int bh = (G % 8 == 0 && G >= 16) ? (wg >> 3) + 2 * (wg & 7) : wg;
    if ((G % 8 == 0 && G >= 16) ? (wg >> 3) >= 2 : wg >= 16) return;
    const bf16_t* GP = (const bf16_t*)((const unsigned char*)P.out + DO_GP); const float* GQ = (const float*)((const unsigned char*)P.out + DO_GQ); float* GS = (float*)((unsigned char*)P.out + DO_GS);
    const int tid = opaque_tid(), lane = tid & 63, wave = __builtin_amdgcn_readfirstlane(tid >> 6), i16 = lane & 15, quad = lane >> 4;
    LAS unsigned char* ST = lds;
    f32x4 sacc[8];
#pragma unroll
    for (int cb = 0; cb < 8; ++cb) sacc[cb] = (f32x4){0.f, 0.f, 0.f, 0.f};
    bf16x8 fp[2][4]; f32x4 qg[2][8];
#define GB_LOAD(S, gg) do { const size_t tk_ = (size_t)bh * 16 + (gg); \
        _Pragma("unroll") for (int ks_ = 0; ks_ < 4; ++ks_) fp[S][ks_] = *(const bf16x8*)(GP + tk_ * 16384 + (16 * wave + i16) * 128 + 32 * ks_ + 8 * quad); \
        _Pragma("unroll") for (int cb_ = 0; cb_ < 8; ++cb_) qg[S][cb_] = *(const f32x4*)(GQ + ((tk_ * 8 + wave) * 64 + lane) * 32 + cb_ * 4); } while (0)
    GB_LOAD(0, 0); GB_LOAD(1, 1);
    __syncthreads();
#define GB_STEP(g, S) do { const size_t task = (size_t)bh * 16 + (g); \
        _Pragma("unroll") for (int cb_ = 0; cb_ < 8; ++cb_) *(f32x4*)(GS + ((task * 8 + wave) * 64 + lane) * 32 + cb_ * 4) = sacc[cb_];          \
        if ((g) < 15) { \
            _Pragma("unroll") for (int cb_ = 0; cb_ < 8; ++cb_) *(LAS u32x2*)(ST + (16 * cb_ + i16) * 272 + (16 * wave + 4 * quad) * 2) = pack4(sacc[cb_] + (f32x4){0.f, 0.f, 0.f, 0.f}); \
            GS_BAR(); \
            _Pragma("unroll") for (int cb_ = 0; cb_ < 8; ++cb_) { f32x4 acc_ = qg[S][cb_]; \
                _Pragma("unroll") for (int ks_ = 0; ks_ < 4; ++ks_) acc_ = __builtin_amdgcn_mfma_f32_16x16x32_bf16(fp[S][ks_], *(const LAS bf16x8*)(ST + (16 * cb_ + i16) * 272 + (32 * ks_ + 8 * quad) * 2), acc_, 0, 0, 0); \
                sacc[cb_] = acc_; } \
            if ((g) + 2 < 15) GB_LOAD(S, (g) + 2); \
            GS_BAR(); } } while (0)
#pragma unroll 1
    for (int g = 0; g < 16; g += 2) { GB_STEP(g, 0); GB_STEP(g + 1, 1); }
#undef GB_STEP
#undef GB_LOAD
}
__device__ __forceinline__ void phase_gdn_scanC(const Params& P, LAS unsigned char* lds, int wg, int G) {
    bf16_t* proj = (bf16_t*)(P.ws + WS_S + S_GDN_PROJ); const bf16_t* attn = (const bf16_t*)(P.ws + WS_S + S_GDN_ATTN); const float* gcum = (const float*)(P.ws + WS_S + S_GDN_GC); const bf16_t* wbuf = (const bf16_t*)P.out;
    const float* GS = (const float*)((const unsigned char*)P.out + DO_GS);
    const int tid = opaque_tid(), lane = tid & 63, wave = __builtin_amdgcn_readfirstlane(tid >> 6), i16 = lane & 15, quad = lane >> 4, rb = wave & 3;
    LAS unsigned char* ST = lds; LAS unsigned char* VN = lds + 34816; LAS unsigned char* VN2 = lds + 53248; LAS unsigned char* OL = lds + 71680; LAS float* WN = (LAS float*)(lds + 89088);
    const int p0 = 32 * (rb >> 1) + 8 * quad + 4 * (rb & 1);
    for (int task = wg; task < 256; task += G) {
        const int bh = task >> 4, g = task & 15, b = bh >> 3, h = bh & 7; const size_t t0 = (size_t)b * SEQ + (size_t)g * 1024, u0 = (size_t)bh * 256 + (size_t)g * 16;
        f32x4 sacc[8];
#pragma unroll
        for (int cb = 0; cb < 8; ++cb) sacc[cb] = *(const f32x4*)(GS + (((size_t)task * 8 + wave) * 64 + lane) * 32 + cb * 4);
        __syncthreads();
#pragma unroll
        for (int cb = 0; cb < 8; ++cb) *(LAS u32x2*)(ST + (16 * cb + i16) * 272 + (16 * wave + 4 * quad) * 2) = pack4(sacc[cb] + (f32x4){0.f, 0.f, 0.f, 0.f});
        const char* pA = (wave < 4) ? (const char*)(wbuf + (t0 + 16 * rb + quad) * DM + h * HD + 8 * i16) : (const char*)(proj + (t0 + 16 * rb + quad) * 4096 + h * HD + 8 * i16);
        const size_t ksA = (wave < 4) ? (size_t)4 * DM * 2 : (size_t)4 * 4096 * 2, stA = (wave < 4) ? (size_t)64 * DM * 2 : (size_t)64 * 4096 * 2;
        const char* pK = (const char*)(proj + (t0 + 8 * wave + quad) * 4096 + DM + h * HD + 8 * i16);
        const char* pU = (const char*)(proj + (t0 + 16 * rb + (lane >> 2)) * 4096 + 2 * DM + h * HD + (lane & 3) * 32);
        const char* pT = (const char*)(attn + u0 * 4096 + (size_t)(rb * 128 + lane) * 8);
        const char* pG = (const char*)(gcum + u0 * 64 + 16 * rb + 4 * quad); const char* pGl = (const char*)(gcum + u0 * 64 + 63);
        bf16_t* pO = proj + (t0 + (tid >> 4)) * 4096 + 2 * DM + h * HD + (tid & 15) * 8;
        bf16x8 fa[2][4], fk[2][2], ft[2][2]; u32x4 uu[2][4], zr[2]; f32x4 g4[2]; float gl[2];
        if (tid < 128) WN[tid] = P.in[IN_GDN_NORM][tid];
#define GC_LOAD_A(S) do { _Pragma("unroll") for (int ks_ = 0; ks_ < 4; ++ks_) fa[S][ks_] = *(const bf16x8*)(pA + (size_t)ks_ * ksA); \
        if (wave < 4) { _Pragma("unroll") for (int q_ = 0; q_ < 4; ++q_) uu[S][q_] = *(const u32x4*)(pU + q_ * 16); } \
        g4[S] = *(const f32x4*)pG; gl[S] = *(const float*)pGl; pA += stA; pU += 64 * 8192; pG += 256; pGl += 256; } while (0)
#define GC_LOAD_B(S) do { _Pragma("unroll") for (int ks_ = 0; ks_ < 2; ++ks_) fk[S][ks_] = *(const bf16x8*)(pK + (size_t)ks_ * 32768); \
        if (wave >= 4) { _Pragma("unroll") for (int ks_ = 0; ks_ < 2; ++ks_) ft[S][ks_] = *(const bf16x8*)(pT + ks_ * 1024); } \
        pK += 64 * 8192; pT += 8192; } while (0)
#pragma unroll
        for (int s_ = 0; s_ < 2; ++s_) {
#pragma unroll
            for (int q_ = 0; q_ < 4; ++q_) uu[s_][q_] = (u32x4){0u, 0u, 0u, 0u};
#pragma unroll
            for (int q_ = 0; q_ < 2; ++q_) ft[s_][q_] = (bf16x8){0, 0, 0, 0, 0, 0, 0, 0}; }
        GC_LOAD_A(0); GC_LOAD_B(0); GC_LOAD_A(1); GC_LOAD_B(1);
        GS_BAR();
#define GC_ZLOAD(nn) do { _Pragma("unroll") for (int k_ = 0; k_ < 2; ++k_) zr[k_] = *(const u32x4*)(pO + DM + ((size_t)(nn) * 64 + 32 * k_) * 4096); } while (0)
#define GC_OSTORE(nn) do { _Pragma("unroll") for (int k_ = 0; k_ < 2; ++k_) { const u32x4 ov_ = *(const LAS u32x4*)(OL + ((tid >> 4) + 32 * k_) * 272 + (tid & 15) * 16); const u32x4 zv_ = zr[k_]; \
            float o_[8], z_[8]; _Pragma("unroll") for (int e_ = 0; e_ < 4; ++e_) { o_[2 * e_] = bf_lo(ov_[e_]); o_[2 * e_ + 1] = bf_hi(ov_[e_]); z_[2 * e_] = bf_lo(zv_[e_]); z_[2 * e_ + 1] = bf_hi(zv_[e_]); } \
            float ss_ = 0.f; _Pragma("unroll") for (int e_ = 0; e_ < 8; ++e_) ss_ += o_[e_] * o_[e_]; \
            ss_ += __shfl_xor(ss_, 1); ss_ += __shfl_xor(ss_, 2); ss_ += __shfl_xor(ss_, 4); ss_ += __shfl_xor(ss_, 8); \
            const float r_ = __builtin_amdgcn_rsqf(ss_ * (1.0f / HD) + EPS); const f32x4 wa_ = *(const LAS f32x4*)(WN + (tid & 15) * 8), wb_ = *(const LAS f32x4*)(WN + (tid & 15) * 8 + 4); \
            u32x4 w_; w_.x = cvt_pk_bf16(o_[0] * r_ * wa_[0] * silu_f(z_[0]), o_[1] * r_ * wa_[1] * silu_f(z_[1])); w_.y = cvt_pk_bf16(o_[2] * r_ * wa_[2] * silu_f(z_[2]), o_[3] * r_ * wa_[3] * silu_f(z_[3])); \
            w_.z = cvt_pk_bf16(o_[4] * r_ * wb_[0] * silu_f(z_[4]), o_[5] * r_ * wb_[1] * silu_f(z_[5])); w_.w = cvt_pk_bf16(o_[6] * r_ * wb_[2] * silu_f(z_[6]), o_[7] * r_ * wb_[3] * silu_f(z_[7])); \
            *(u32x4*)(pO + ((size_t)(nn) * 64 + 32 * k_) * 4096) = w_; } } while (0)
#define GC_STEP(nn, S) do { \
        if ((nn) > 0) GC_OSTORE((nn) - 1); \
        GC_ZLOAD(nn); \
        f32x4 acc1[8]; \
        _Pragma("unroll") for (int c_ = 0; c_ < 8; ++c_) { acc1[c_] = (f32x4){0.f, 0.f, 0.f, 0.f}; \
            _Pragma("unroll") for (int ks_ = 0; ks_ < 4; ++ks_) acc1[c_] = __builtin_amdgcn_mfma_f32_16x16x32_bf16(fa[S][ks_], *(const LAS bf16x8*)(ST + (16 * c_ + i16) * 272 + (32 * ks_ + 8 * quad) * 2), acc1[c_], 0, 0, 0); } \
        const float glast_ = gl[S]; const f32x4 gv_ = g4[S]; \
        if (wave < 4) { f32x4 ed_; \
            _Pragma("unroll") for (int jj_ = 0; jj_ < 4; ++jj_) ed_[jj_] = __expf(glast_ - gv_[jj_]); \
            _Pragma("unroll") for (int c_ = 0; c_ < 8; ++c_) { const unsigned ua_ = uu[S][c_ >> 1][2 * (c_ & 1)], ub_ = uu[S][c_ >> 1][2 * (c_ & 1) + 1]; f32x4 vn_; \
                vn_[0] = bf_lo(ua_) - acc1[c_][0]; vn_[1] = bf_hi(ua_) - acc1[c_][1]; vn_[2] = bf_lo(ub_) - acc1[c_][2]; vn_[3] = bf_hi(ub_) - acc1[c_][3]; \
                *(LAS u32x2*)(VN + (16 * c_ + i16) * 144 + p0 * 2) = pack4(vn_); *(LAS u32x2*)(VN2 + (16 * c_ + i16) * 144 + p0 * 2) = pack4(vn_ * ed_); } } \
        if ((nn) + 2 < 16) GC_LOAD_A(S); \
        GS_BAR(); \
        if (wave >= 4) { f32x4 eg4_; \
            _Pragma("unroll") for (int jj_ = 0; jj_ < 4; ++jj_) eg4_[jj_] = __expf(gv_[jj_]); \
            _Pragma("unroll") for (int c_ = 0; c_ < 8; ++c_) { f32x4 acco_ = acc1[c_] * eg4_; \
                _Pragma("unroll") for (int ks_ = 0; ks_ < 2; ++ks_) acco_ = __builtin_amdgcn_mfma_f32_16x16x32_bf16(ft[S][ks_], *(const LAS bf16x8*)(VN + (16 * c_ + i16) * 144 + (32 * ks_ + 8 * quad) * 2), acco_, 0, 0, 0); \
                _Pragma("unroll") for (int jj_ = 0; jj_ < 4; ++jj_) *(LAS bf16_t*)(OL + (16 * rb + 4 * quad + jj_) * 272 + (16 * c_ + i16) * 2) = f2bf(acco_[jj_]); } } \
        { const float eg_ = __expf(glast_); \
          _Pragma("unroll") for (int cb_ = 0; cb_ < 8; ++cb_) { f32x4 acc_ = sacc[cb_] * eg_; \
              _Pragma("unroll") for (int ks_ = 0; ks_ < 2; ++ks_) acc_ = __builtin_amdgcn_mfma_f32_16x16x32_bf16(fk[S][ks_], *(const LAS bf16x8*)(VN2 + (16 * cb_ + i16) * 144 + (32 * ks_ + 8 * quad) * 2), acc_, 0, 0, 0); \
              sacc[cb_] = acc_; *(LAS u32x2*)(ST + (16 * cb_ + i16) * 272 + (16 * wave + 4 * quad) * 2) = packsoft4(acc_); } } \
        if ((nn) + 2 < 16) GC_LOAD_B(S); \
        GS_BAR(); } while (0)
#pragma unroll 1
        for (int n = 0; n < 16; n += 2) { GC_STEP(n, 0); GC_STEP(n + 1, 1); }
        GC_OSTORE(15);
#undef GC_STEP
#undef GC_OSTORE
#undef GC_ZLOAD
#undef GC_LOAD_A
#undef GC_LOAD_B
    }
}

constexpr int NPHASES = 39;
__global__ void __launch_bounds__(512, 2) fwd_kernel(Params P0) {
    extern __shared__ __attribute__((aligned(16))) unsigned char lds_raw[];
    LAS unsigned char* lds = (LAS unsigned char*)lds_raw;
    const int tid = threadIdx.x, wg = blockIdx.x, G = gridDim.x;
    volatile LAS unsigned* bw = (volatile LAS unsigned*)(lds + LDS_BARW);
    if (tid < 4) bw[tid] = 0u;
    __syncthreads();
    const int lo = P0.ph_lo, hi = P0.ph_hi;
    XcdBarrier bar; bar.bar = (unsigned*)(P0.ws + WS_CTL); bar.x = 0; bar.st = bw;
    if (hi - lo > 1) bar = xcd_barrier_post((unsigned*)(P0.ws + WS_CTL), bw);
    u64_t* ssq_base = (u64_t*)(P0.ws + WS_SSQ);
    bf16_t* xb = (bf16_t*)(P0.ws + WS_XB);
    const bf16_t* Wb = (const bf16_t*)(P0.ws + WS_W);
    int ph = 0;
#define PH_BEGIN if (ph >= lo && ph < hi) { const Params& P = P0;
#define PH_END if (ph + 1 < hi) xcd_barrier(bar); } ++ph;
    PH_BEGIN phase_prologue(P, lds, wg, G); PH_END
    for (int it = 0; it < 8; ++it) {
        const int L = it >> 1, sub = it & 1, kind = L % 3, mj = L / 3;
        if (sub == 0) {
            PH_BEGIN
                pg8::Gemm g; pg8::EpiIn E; g.A = xb; g.M = T_TOK; g.K = DM; g.lda = DM; E.ssq = ssq_base + (size_t)(2 * L) * T_TOK; E.halo = nullptr;
                if (kind == 0) { g.Bt = (const bf16_t*)((const unsigned char*)Wb + (mj == 0 ? W_MOBA_QKV0 : W_MOBA_QKV1)); g.N = 3072; E.O = (bf16_t*)(P.ws + WS_S + S_MOBA_QKV); E.ldc = 3072; }
                else if (kind == 1) { g.Bt = (const bf16_t*)((const unsigned char*)Wb + W_SC_IN); g.N = 3072; E.O = (bf16_t*)(P.ws + WS_S + S_SC_PROJ); E.ldc = 3072; }
                else { g.Bt = (const bf16_t*)((const unsigned char*)Wb + W_GDN_IN); g.N = 4096; E.O = (bf16_t*)(P.ws + WS_S + S_GDN_PROJ); E.ldc = 4096; E.halo = (bf16_t*)(P.ws + WS_S + S_GDN_HALO); }
                pg8::StaticOrder S; S.init(g.M, g.N, G, wg);
                pg8::gemm_phase<pg8::EpiIn, false>(lds, g, S, E);
                if (kind == 2) phase_gdn_bg(P, wg, G);
            PH_END
            if (kind == 0) {
                PH_BEGIN phase_moba_kmean_vt(P, lds, wg, G); PH_END
                PH_BEGIN phase_moba_gate2(P, lds, mj, wg, G); PH_END
                for (int b = 0; b < 2; ++b) {
                    PH_BEGIN phase_moba_gather(P, lds, mj, b, wg, G); PH_END
                    PH_BEGIN phase_moba_own(P, lds, b, wg, G); PH_END
                }
            } else if (kind == 1) {
                PH_BEGIN phase_sconv(P, wg, G); PH_END
            } else {
                PH_BEGIN phase_gdn_chunk2(P, lds, wg, G); PH_END
                PH_BEGIN phase_gdn_scanA(P, lds, wg, G); PH_END
                PH_BEGIN phase_gdn_scanB(P, lds, wg, G); PH_END
                PH_BEGIN phase_gdn_scanC(P, lds, wg, G); PH_END
            }
        } else {
            PH_BEGIN
                pg8::Gemm g; g.A = xb; g.Bt = (const bf16_t*)((const unsigned char*)Wb + W_FFN_UP + (size_t)L * W_FFN_UP_STRIDE); g.M = T_TOK; g.N = 2 * FFD; g.K = DM; g.lda = DM;
                pg8::EpiUp E; E.ACT = (bf16_t*)(P.ws + WS_S + S_FFN_ACT); E.halo = (float*)(P.ws + WS_S + S_FFN_HALO); E.cw = P.in[IN_FFN_CONV] + (size_t)L * 3 * (2 * FFD); E.ssq = ssq_base + (size_t)(2 * L + 1) * T_TOK;
                pg8::StaticOrder S; S.init(g.M, g.N, G, wg);
                pg8::gemm_phase<pg8::EpiUp, true>(lds, g, S, E);
            PH_END
            PH_BEGIN phase_ffn_fix(P, L, wg, G); PH_END
        }
        PH_BEGIN
            pg8::Gemm g; g.M = T_TOK; g.N = DM;
            if (sub == 1) { g.A = (const bf16_t*)(P.ws + WS_S + S_FFN_ACT); g.lda = FFD; g.K = FFD; g.Bt = (const bf16_t*)((const unsigned char*)Wb + W_FFN_DN + (size_t)L * W_FFN_DN_STRIDE); }
            else if (kind == 0) { g.A = (const bf16_t*)(P.ws + WS_S + S_MOBA_QKV); g.lda = 3072; g.K = DM; g.Bt = (const bf16_t*)((const unsigned char*)Wb + (mj == 0 ? W_MOBA_O0 : W_MOBA_O1)); }
            else if (kind == 1) { g.A = (const bf16_t*)(P.ws + WS_S + S_SC_Y); g.lda = DM; g.K = DM; g.Bt = (const bf16_t*)((const unsigned char*)Wb + W_SC_OUT); }
            else { g.A = (const bf16_t*)(P.ws + WS_S + S_GDN_PROJ) + 2 * DM; g.lda = 4096; g.K = DM; g.Bt = (const bf16_t*)((const unsigned char*)Wb + W_GDN_O); }
            pg8::EpiOut E; E.XB = xb; E.ssq_next = ssq_base + (size_t)(2 * L + 1 + sub) * T_TOK; E.ts = (LAS float*)(lds + 131072);
            pg8::StaticOrder S; S.init(g.M, g.N, G, wg);
            pg8::gemm_phase<pg8::EpiOut, false>(lds, g, S, E);
        PH_END
    }
    PH_BEGIN phase_final(P, wg, G); PH_END
#undef PH_BEGIN
#undef PH_END
}

extern "C" void kernel_launch(void* const* d_in, const int* in_sizes, int n_in, void* d_out, int out_size, void* d_ws, size_t ws_size, hipStream_t stream) {
    static int grid = 0;
    if (grid == 0) {
        if (n_in != 18 || out_size != T_TOK * DM || ws_size < WS_END) { fprintf(stderr, "kernel_launch: unexpected problem (n_in %d, out %d, ws %zu)\n", n_in, out_size, ws_size); grid = -1; return; }
        int dev = 0, cus = 0, per_cu = 0;
        if (hipGetDevice(&dev) != hipSuccess || hipDeviceGetAttribute(&cus, hipDeviceAttributeMultiprocessorCount, dev) != hipSuccess) { grid = -1; return; }
        if (hipFuncSetAttribute((const void*)fwd_kernel, hipFuncAttributeMaxDynamicSharedMemorySize, LDS_BYTES) != hipSuccess) { fprintf(stderr, "kernel_launch: hipFuncSetAttribute failed\n"); grid = -1; return; }
        if (hipOccupancyMaxActiveBlocksPerMultiprocessor(&per_cu, (const void*)fwd_kernel, 512, LDS_BYTES) != hipSuccess || per_cu < 1) { fprintf(stderr, "kernel_launch: occupancy query says %d blocks per CU\n", per_cu); (void)hipGetLastError(); }
        grid = cus;
    }
    if (grid < 0) return;
    (void)in_sizes;
    hipMemsetAsync((char*)d_ws + WS_CTL, 0, CTL_ZERO_BYTES, stream);
    Params p; memset(&p, 0, sizeof(p));
    for (int i = 0; i < 18; ++i) p.in[i] = (const float*)d_in[i];
    p.out = (float*)d_out; p.ws = (unsigned char*)d_ws;
#if MK_N_LAUNCHES == 1
    p.ph_lo = 0; p.ph_hi = NPHASES;
    hipLaunchKernelGGL(fwd_kernel, dim3(grid), dim3(512), LDS_BYTES, stream, p);
#else
    for (int li = 0; li < NPHASES; ++li) { p.ph_lo = li; p.ph_hi = li + 1; hipLaunchKernelGGL(fwd_kernel, dim3(grid), dim3(512), LDS_BYTES, stream, p); }
#endif
}
```

```cpp
#include <hip/hip_runtime.h>
#include <stdio.h>
#include <string.h>

#ifndef MK_N_LAUNCHES
#define MK_N_LAUNCHES 1
#endif

#define LAS __attribute__((address_space(3)))
typedef unsigned short bf16_t;
typedef short bf16x8 __attribute__((ext_vector_type(8)));
typedef float f32x4 __attribute__((ext_vector_type(4)));
typedef float f32x2 __attribute__((ext_vector_type(2)));
typedef unsigned u32x4 __attribute__((ext_vector_type(4)));
typedef unsigned u32x2 __attribute__((ext_vector_type(2)));

constexpr int T_TOK = 32768, SEQ = 16384, DM = 1024, FFD = 2816, NH = 8, HD = 128, NBLK = 64, BLK = 256;
constexpr float EPS = 1e-6f;
constexpr float LOG2E = 1.4426950408889634f, LN2 = 0.6931471805599453f;

constexpr size_t MiB = 1u << 20;
constexpr size_t WS_CTL = 0, CTL_ZERO_BYTES = 4 * MiB;
constexpr size_t CTL_CNT = 512 * 1024;
constexpr size_t WS_SSQ = 1 * MiB;
constexpr size_t WS_MISC = 6 * MiB;
constexpr size_t MISC_KMEAN = 0, MISC_BGW = 512 * 1024;
constexpr size_t WS_W = 7 * MiB;
constexpr size_t WS_XB = 107 * MiB;
constexpr size_t WS_S = 171 * MiB;
constexpr size_t WS_END = 512 * MiB;
constexpr size_t W_MOBA_QKV0 = 0, W_MOBA_QKV1 = 6 * MiB, W_MOBA_O0 = 12 * MiB, W_MOBA_O1 = 14 * MiB, W_SC_IN = 16 * MiB, W_SC_OUT = 22 * MiB,
                 W_GDN_IN = 24 * MiB, W_GDN_O = 32 * MiB, W_FFN_UP = 34 * MiB, W_FFN_UP_STRIDE = 11 * MiB, W_FFN_DN = 78 * MiB, W_FFN_DN_STRIDE = 5767168;
constexpr size_t S_MOBA_KN = 322 * MiB, S_MOBA_KMAX = 323 * MiB, S_MOBA_MASK = 324 * MiB;
constexpr size_t S_MOBA_QKV = 0, S_MOBA_PO = 192 * MiB, S_MOBA_LIST = 288 * MiB, S_MOBA_LSE = 320 * MiB;
constexpr size_t S_SC_PROJ = 0, S_SC_Y = 192 * MiB;
constexpr size_t S_GDN_PROJ = 0, S_GDN_ATTN = 256 * MiB, S_GDN_BG = 288 * MiB, S_GDN_HALO = 290 * MiB, S_GDN_GC = 300 * MiB;
constexpr size_t S_FFN_ACT = 0, S_FFN_HALO = 176 * MiB;

constexpr int LDS_BYTES = 163840;
constexpr int LDS_BARW = 163840 - 64;

typedef __bf16 hbf2 __attribute__((ext_vector_type(2)));
__device__ __forceinline__ unsigned cvt_pk_bf16(float lo, float hi) { return __builtin_bit_cast(unsigned, __builtin_convertvector((f32x2){lo, hi}, hbf2)); }
__device__ __forceinline__ float bf_lo(unsigned u) { return __builtin_bit_cast(float, u << 16); }
__device__ __forceinline__ float bf_hi(unsigned u) { return __builtin_bit_cast(float, u & 0xffff0000u); }
__device__ __forceinline__ f32x4 bf4(u32x2 w) { return (f32x4){bf_lo(w.x), bf_hi(w.x), bf_lo(w.y), bf_hi(w.y)}; }
__device__ __forceinline__ float bf2f(bf16_t b) { return __builtin_bit_cast(float, (unsigned)b << 16); }
__device__ __forceinline__ bf16_t f2bf(float f) { return (bf16_t)(cvt_pk_bf16(f, 0.0f) & 0xffffu); }
__device__ __forceinline__ float fast_exp2(float x) { return __builtin_amdgcn_exp2f(x); }
__device__ __forceinline__ float fast_rcp(float x) { return __builtin_amdgcn_rcpf(x); }
__device__ __forceinline__ float silu_f(float x) { return x * fast_rcp(1.0f + fast_exp2(-x * LOG2E)); }
__device__ __forceinline__ int opaque_tid() { int t = threadIdx.x; asm volatile("" : "+v"(t)); return t; }
typedef unsigned long long u64_t;
constexpr float SSQ_SCALE = 4294967296.0f, SSQ_INV = 1.0f / 4294967296.0f;
__device__ __forceinline__ u64_t ssq_fix(float s) { return (u64_t)(s * SSQ_SCALE); }
__device__ __forceinline__ float ssq_rs(u64_t v) { return __builtin_amdgcn_rsqf((float)v * (SSQ_INV / DM) + EPS); }
__device__ __forceinline__ float wave_sum(float v) {
#pragma unroll
    for (int o = 1; o < 64; o <<= 1) v += __shfl_xor(v, o);
    return v;
}
__device__ __forceinline__ float dpp_shr1(float v) {
    return __builtin_bit_cast(float, __builtin_amdgcn_update_dpp(0, __builtin_bit_cast(int, v), 0x111, 0xf, 0xf, false));
}
__device__ __forceinline__ bf16x8 pack8(f32x4 a, f32x4 b) {
    u32x4 p;
    asm volatile("v_cvt_pk_bf16_f32 %0, %4, %5\n\tv_cvt_pk_bf16_f32 %1, %6, %7\n\tv_cvt_pk_bf16_f32 %2, %8, %9\n\tv_cvt_pk_bf16_f32 %3, %10, %11\n\ts_nop 1"
                 : "=&v"(p[0]), "=&v"(p[1]), "=&v"(p[2]), "=&v"(p[3])
                 : "v"(a[0]), "v"(a[1]), "v"(a[2]), "v"(a[3]), "v"(b[0]), "v"(b[1]), "v"(b[2]), "v"(b[3]));
    return __builtin_bit_cast(bf16x8, p);
}

#define XB_TMO      128
#define XB_XCNT(j)  (256  + 64 * (j))
#define XB_XSUB(j)  (1280 + 64 * (j))
#define XB_XGEN(j)  (2304 + 64 * (j))
#define XB_TOP      3328
#define XB_TOPGEN   3392
#define XCD_BAR_WORDS 3456
#define XB_SPIN_CAP (1u << 18)
__device__ __forceinline__ unsigned xb_ld(unsigned* p)              { return __hip_atomic_load(p, __ATOMIC_RELAXED, __HIP_MEMORY_SCOPE_AGENT); }
__device__ __forceinline__ unsigned xb_add(unsigned* p, unsigned v) { return __hip_atomic_fetch_add(p, v, __ATOMIC_RELAXED, __HIP_MEMORY_SCOPE_AGENT); }
__device__ __forceinline__ unsigned xb_xcc_id() { return (unsigned)__builtin_amdgcn_s_getreg((3 << 11) | 20) & 0xFu; }
#define XB_SPIN(cond, bar) do { unsigned _sp = 0; while (cond) { __builtin_amdgcn_s_sleep(1); \
    if ((++_sp & 255u) == 0u) { if (xb_ld(&(bar)[XB_TMO])) break; if (_sp > XB_SPIN_CAP) { atomicAdd(&(bar)[XB_TMO], 1u); break; } } } } while (0)
struct XcdBarrier { unsigned* bar; unsigned x; volatile LAS unsigned* st; };
__device__ __forceinline__ XcdBarrier xcd_barrier_post(unsigned* bar, volatile LAS unsigned* st) {
    XcdBarrier b; b.bar = bar; b.x = xb_xcc_id(); b.st = st;
    if (threadIdx.x == 0) (void)xb_add(&bar[XB_XCNT(b.x)], 1u);
    return b;
}
__device__ __forceinline__ void xcd_barrier_complete(unsigned* bar, unsigned x, unsigned& nloc, unsigned& nx) {
    const unsigned G = gridDim.x * gridDim.y * gridDim.z;
    unsigned sum, cnt, mine, sp = 0u;
    for (;;) {
        sum = 0u; cnt = 0u; mine = 0u;
#pragma unroll
        for (unsigned j = 0; j < 16; ++j) { const unsigned c = xb_ld(&bar[XB_XCNT(j)]); sum += c; cnt += (c > 0u) ? 1u : 0u; mine = (j == x) ? c : mine; }
        if (sum == G) break;
        __builtin_amdgcn_s_sleep(1);
        if ((++sp & 255u) == 0u) { if (xb_ld(&bar[XB_TMO])) break; if (sp > XB_SPIN_CAP) { atomicAdd(&bar[XB_TMO], 1u); break; } }
    }
    nloc = mine > 0u ? mine : 1u; nx = cnt > 0u ? cnt : 1u;
}
__device__ __forceinline__ void xcd_barrier(const XcdBarrier& b) {
    asm volatile("s_waitcnt vmcnt(0)" ::: "memory");
    __syncthreads();
    if (threadIdx.x == 0) {
        unsigned* bar = b.bar;
        __builtin_amdgcn_s_waitcnt(0);
        unsigned nloc = b.st[0], nx = b.st[1];
        if (nloc == 0u) { xcd_barrier_complete(bar, b.x, nloc, nx); b.st[0] = nloc; b.st[1] = nx; }
        const unsigned old = xb_add(&bar[XB_XSUB(b.x)], 1u);
        const unsigned gen = old / nloc;
        if (old + 1u == (gen + 1u) * nloc) {
            __builtin_amdgcn_fence(__ATOMIC_RELEASE, "agent");
            asm volatile("s_waitcnt vmcnt(0)" ::: "memory");
            const unsigned og = xb_add(&bar[XB_TOP], 1u);
            const unsigned tg = og / nx;
            if (og + 1u == (tg + 1u) * nx) xb_add(&bar[XB_TOPGEN], 1u);
            else XB_SPIN(xb_ld(&bar[XB_TOPGEN]) == tg, bar);
            __builtin_amdgcn_fence(__ATOMIC_ACQUIRE, "agent");
            xb_add(&bar[XB_XGEN(b.x)], 1u);
            asm volatile("s_waitcnt vmcnt(0)" ::: "memory");
        } else {
            XB_SPIN(xb_ld(&bar[XB_XGEN(b.x)]) == gen, bar);
            __builtin_amdgcn_fence(__ATOMIC_ACQUIRE, "agent");
            asm volatile("s_waitcnt vmcnt(0)" ::: "memory");
        }
    }
    __syncthreads();
}

namespace pg8 {
constexpr int BM = 256, BK = 64, HALF = 128, HTB = HALF * BK * 2, STAGE_BYTES = 8 * HTB, NXCD = 8, WGM = 8;
__host__ __device__ __forceinline__ int lds_byte(int r, int c) { const int st = (r >> 4) * 2 + (c >> 5), rr = r & 15, cc = c & 31, ob = rr * 64 + cc * 2; return st * 1024 + (ob ^ (((ob >> 9) & 1) << 5)); }
__host__ __device__ __forceinline__ void stage_rc(int b, int& R, int& C) { const int st = b / 1024, sb = b % 1024, swz = sb ^ (((sb >> 9) & 1) << 5); R = (st >> 1) * 16 + swz / 64; C = (st & 1) * 32 + (swz % 64) / 2; }
__host__ __device__ __forceinline__ int perm32(int rho) { const int n = rho >> 4, i = rho & 15; return 8 * (i >> 2) + 4 * n + (i & 3); }
struct Unit { int pm, pn; };
struct Gemm { const bf16_t* A; const bf16_t* Bt; int M, N, K, lda; };
struct StaticOrder {
    int nM, nN, nwg, G, c;
    __host__ __device__ void init(int M, int N, int G_, int c_) { nM = M / BM; nN = N / BM; nwg = nM * nN; G = G_; c = c_; }
    __host__ __device__ bool next(int i, Unit& u) const {
        const long L = (long)i * G + c; if (L >= nwg) return false;
        int wgid = (int)L; { const int q = nwg / NXCD, r = nwg % NXCD, xcd = wgid % NXCD, off = wgid / NXCD; wgid = (xcd < r ? xcd * (q + 1) : r * (q + 1) + (xcd - r) * q) + off; }
        const int nig = WGM * nN, gid = wgid / nig, fm = gid * WGM, gsz = (nM - fm) < WGM ? (nM - fm) : WGM;
        u.pm = fm + ((wgid % nig) % gsz); u.pn = (wgid % nig) / gsz; return true;
    }
};
template <class Epi, bool TOKPERM>
__device__ __forceinline__ void gemm_phase(LAS unsigned char* lds, const Gemm g, const StaticOrder& S, const Epi& E) {
    const int tid = opaque_tid(), wid = __builtin_amdgcn_readfirstlane(tid >> 6), lane = tid & 63, wr = wid >> 2, wc = wid & 3, fr = lane & 15, fq = lane >> 4;
    const int K = g.K, nt = K / BK, lda = g.lda;
    unsigned voffA[2], voffB[2];
#pragma unroll
    for (int i = 0; i < 2; ++i) { int R, C; stage_rc(tid * 16 + i * 8192, R, C); const int Rb = (R & ~31) + perm32(R & 31);
        const int Ra = TOKPERM ? (128 * (R >> 6) + 8 * (R & 15) + ((R >> 4) & 3)) : R;
        voffA[i] = (unsigned)(Ra * lda + C) * 2u; voffB[i] = (unsigned)(Rb * K + C) * 2u; }
    const size_t kstep = (size_t)(BK * 2);
    const size_t hstepA = TOKPERM ? (size_t)4 * lda * 2 : (size_t)HALF * lda * 2, hstepB = (size_t)HALF * K * 2;
    const size_t tstepA = (size_t)BM * lda * 2, tstepB = (size_t)BM * K * 2;
    const unsigned ldsw = (unsigned)wid * 1024u;
    const int aoff = lds_byte(wr * 64 + fr, fq * 8), boff = lds_byte(wc * 32 + fr, fq * 8);
#define PG8_SA(b, h) (((b) * 2 + (h)) * HTB)
#define PG8_SB(b, h) ((4 + (b) * 2 + (h)) * HTB)
#define PG8_STAGE(bufoff, gbase, voff) do { _Pragma("unroll") for (int _i = 0; _i < 2; ++_i) \
        __builtin_amdgcn_global_load_lds((const unsigned*)((const char*)(gbase) + (voff)[_i]), (LAS unsigned*)(lds + (bufoff) + ldsw + _i * 8192), 16, 0, 0); } while (0)
#define PG8_LDA(dst, b, h) do { _Pragma("unroll") for (int m = 0; m < 4; ++m) _Pragma("unroll") for (int k = 0; k < 2; ++k) dst[m][k] = *(const LAS bf16x8*)(lds + PG8_SA(b, h) + aoff + m * 2048 + k * 1024); } while (0)
#define PG8_LDB(dst, b, h) do { _Pragma("unroll") for (int n = 0; n < 2; ++n) _Pragma("unroll") for (int k = 0; k < 2; ++k) dst[n][k] = *(const LAS bf16x8*)(lds + PG8_SB(b, h) + boff + n * 2048 + k * 1024); } while (0)
#define PG8_MMA(ai, bj, At, Bt) do { __builtin_amdgcn_s_setprio(1); _Pragma("unroll") for (int m = 0; m < 4; ++m) _Pragma("unroll") for (int n = 0; n < 2; ++n) _Pragma("unroll") for (int k = 0; k < 2; ++k) \
        acc[ai][bj][m][n] = __builtin_amdgcn_mfma_f32_16x16x32_bf16(Bt[n][k], At[m][k], acc[ai][bj][m][n], 0, 0, 0); __builtin_amdgcn_s_setprio(0); } while (0)
#define PG8_WAIT_V(n) asm volatile("s_waitcnt vmcnt(" #n ")" ::: "memory")
#define PG8_WAIT_L(n) asm volatile("s_waitcnt lgkmcnt(" #n ")" ::: "memory")
#define PG8_BAR __builtin_amdgcn_s_barrier()
#define PG8_SCHED __builtin_amdgcn_sched_barrier(0)
    Unit cur, nxt; int ui = 0;
    if (!S.next(0, cur)) return;
    f32x4 acc[2][2][4][2];
#pragma unroll
    for (int a = 0; a < 2; ++a)
#pragma unroll
        for (int b = 0; b < 2; ++b)
#pragma unroll
            for (int m = 0; m < 4; ++m)
#pragma unroll
                for (int n = 0; n < 2; ++n) acc[a][b][m][n] = (f32x4){0.f, 0.f, 0.f, 0.f};
    bf16x8 At[4][2], B0[2][2], B1[2][2];
    const char* cA = (const char*)g.A + (size_t)cur.pm * tstepA; const char* cB = (const char*)g.Bt + (size_t)cur.pn * tstepB;
    PG8_STAGE(PG8_SB(0, 0), cB, voffB); PG8_STAGE(PG8_SB(0, 1), cB + hstepB, voffB); PG8_STAGE(PG8_SA(0, 0), cA, voffA); PG8_STAGE(PG8_SA(0, 1), cA + hstepA, voffA);
    if (wr == 1) PG8_BAR;
    PG8_WAIT_V(2); PG8_BAR;
    PG8_STAGE(PG8_SB(1, 0), cB + kstep, voffB); PG8_STAGE(PG8_SA(1, 0), cA + kstep, voffA); PG8_STAGE(PG8_SB(1, 1), cB + hstepB + kstep, voffB);
    PG8_WAIT_V(6); PG8_BAR;
    for (;;) {
        const bool has_next = S.next(ui + 1, nxt);
        const char* nA = has_next ? (const char*)g.A + (size_t)nxt.pm * tstepA : cA; const char* nB = has_next ? (const char*)g.Bt + (size_t)nxt.pn * tstepB : cB;
        for (int t = 0; t < nt; t += 2) {
            const bool last = (t == nt - 2);
            const char* a1 = cA + (size_t)(t + 1) * kstep;
            const char* a2 = last ? nA : cA + (size_t)(t + 2) * kstep; const char* b2 = last ? nB : cB + (size_t)(t + 2) * kstep;
            const char* a3 = a2 + kstep; const char* b3 = b2 + kstep;
            PG8_LDB(B0, 0, 0); PG8_LDB(B1, 0, 1); PG8_SCHED; PG8_LDA(At, 0, 0); PG8_STAGE(PG8_SA(1, 1), a1 + hstepA, voffA);
            PG8_WAIT_V(8); PG8_WAIT_L(0); PG8_BAR; PG8_MMA(0, 0, At, B0); PG8_MMA(0, 1, At, B1); PG8_BAR; PG8_SCHED;
            PG8_LDA(At, 0, 1); PG8_STAGE(PG8_SB(0, 0), b2, voffB); PG8_STAGE(PG8_SB(0, 1), b2 + hstepB, voffB); PG8_STAGE(PG8_SA(0, 0), a2, voffA);
            PG8_WAIT_V(8); PG8_WAIT_L(0); PG8_BAR; PG8_MMA(1, 0, At, B0); PG8_MMA(1, 1, At, B1); PG8_BAR; PG8_SCHED;
            PG8_LDB(B0, 1, 0); PG8_LDB(B1, 1, 1); PG8_SCHED; PG8_LDA(At, 1, 0); PG8_STAGE(PG8_SA(0, 1), a2 + hstepA, voffA);
            PG8_WAIT_V(8); PG8_WAIT_L(0); PG8_BAR; PG8_MMA(0, 0, At, B0); PG8_MMA(0, 1, At, B1); PG8_BAR; PG8_SCHED;
            PG8_LDA(At, 1, 1); PG8_STAGE(PG8_SB(1, 0), b3, voffB); PG8_STAGE(PG8_SB(1, 1), b3 + hstepB, voffB); PG8_STAGE(PG8_SA(1, 0), a3, voffA);
            PG8_WAIT_V(8); PG8_WAIT_L(0); PG8_BAR; PG8_MMA(1, 0, At, B0); PG8_MMA(1, 1, At, B1); PG8_BAR; PG8_SCHED;
        }
        if (wr == 0) PG8_BAR;
        E(acc, cur, wr, wc, fr, fq);
        if (!has_next) break;
#pragma unroll
        for (int a = 0; a < 2; ++a)
#pragma unroll
            for (int b = 0; b < 2; ++b)
#pragma unroll
                for (int m = 0; m < 4; ++m)
#pragma unroll
                    for (int n = 0; n < 2; ++n) acc[a][b][m][n] = (f32x4){0.f, 0.f, 0.f, 0.f};
        cur = nxt; cA = nA; cB = nB; ++ui;
        if (wr == 1) PG8_BAR;
    }
    PG8_WAIT_V(0);
    PG8_BAR;
#undef PG8_SA
#undef PG8_SB
#undef PG8_STAGE
#undef PG8_LDA
#undef PG8_LDB
#undef PG8_MMA
#undef PG8_WAIT_V
#undef PG8_WAIT_L
#undef PG8_BAR
#undef PG8_SCHED
}

struct EpiIn {
    bf16_t* O; int ldc; const u64_t* ssq; bf16_t* halo;
    bf16_t* kmh; bf16_t* kml; float* kn; float* kmax; LAS float* sc;
    __device__ __forceinline__ void operator()(const f32x4 (&acc)[2][2][4][2], const Unit& u, int wr, int wc, int fr, int fq) const {
        const int row0 = u.pm * BM + wr * 64 + fr, col0 = u.pn * BM + wc * 32 + 8 * fq;
        const bool kstat = (kmh != nullptr) && u.pn >= 4 && u.pn < 8;
        float cs[2][8];
#pragma unroll
        for (int bj = 0; bj < 2; ++bj)
#pragma unroll
            for (int e = 0; e < 8; ++e) cs[bj][e] = 0.f;
        u64_t sq[2][4];
#pragma unroll
        for (int ai = 0; ai < 2; ++ai)
#pragma unroll
            for (int m = 0; m < 4; ++m) sq[ai][m] = ssq[row0 + ai * HALF + m * 16];
        __builtin_amdgcn_sched_barrier(0);
#pragma unroll
        for (int ai = 0; ai < 2; ++ai)
#pragma unroll
            for (int m = 0; m < 4; ++m) { const int t = row0 + ai * HALF + m * 16; const float rs = ssq_rs(sq[ai][m]);
                bf16_t* rowp = O + (size_t)t * ldc + col0;
#pragma unroll
                for (int bj = 0; bj < 2; ++bj) { const f32x4 v0 = acc[ai][bj][m][0] * rs, v1 = acc[ai][bj][m][1] * rs;
                    u32x4 w; w.x = cvt_pk_bf16(v0[0], v0[1]); w.y = cvt_pk_bf16(v0[2], v0[3]); w.z = cvt_pk_bf16(v1[0], v1[1]); w.w = cvt_pk_bf16(v1[2], v1[3]);
                    *(u32x4*)(rowp + bj * HALF) = w;
                    if (halo != nullptr && m == 3 && fr >= 13 && (col0 + bj * HALF) < 3072) *(u32x4*)(halo + ((size_t)(t >> 6) * 3 + (fr - 13)) * 3072 + col0 + bj * HALF) = w;
                    if (kstat) { float ss = 0.f;
#pragma unroll
                        for (int e = 0; e < 4; ++e) { const float a = bf_lo(w[e]), c = bf_hi(w[e]); cs[bj][2 * e] += a; cs[bj][2 * e + 1] += c; ss += a * a + c * c; }
                        ss += __shfl_xor(ss, 16); ss += __shfl_xor(ss, 32);
                        if (fq == 0) sc[512 + ((wr * 64 + fr + ai * HALF + m * 16) * 2 + bj) * 4 + wc] = ss; } } }
        if (kstat) {
#pragma unroll
            for (int bj = 0; bj < 2; ++bj)
#pragma unroll
                for (int e = 0; e < 8; ++e) { float v = cs[bj][e]; v += __shfl_xor(v, 1); v += __shfl_xor(v, 2); v += __shfl_xor(v, 4); v += __shfl_xor(v, 8); if (fr == 0) sc[wr * 256 + bj * HALF + wc * 32 + 8 * fq + e] = v; }
            asm volatile("s_waitcnt lgkmcnt(0)" ::: "memory"); __builtin_amdgcn_s_barrier(); asm volatile("" ::: "memory");
            const int tid = opaque_tid(), b = u.pm >> 6, blk = u.pm & 63, h0 = 2 * (u.pn - 4);
            if (tid < 256) { const float mean = (sc[tid] + sc[256 + tid]) * (1.0f / BLK); const int ui = ((b * NH + h0 + (tid >> 7)) * NBLK + blk); const bf16_t hi = f2bf(mean);
                kmh[(size_t)ui * 128 + (tid & 127)] = hi; kml[(size_t)ui * 128 + (tid & 127)] = f2bf(mean - bf2f(hi)); }
            { const int row = tid >> 1, bj = tid & 1; const f32x4 p4 = *(const LAS f32x4*)(sc + 512 + (row * 2 + bj) * 4);
              const float nn = __builtin_amdgcn_sqrtf((p4[0] + p4[1]) + (p4[2] + p4[3]));
              kn[((size_t)u.pm * BM + row) * NH + h0 + bj] = nn;
              float mx = nn; mx = fmaxf(mx, __shfl_xor(mx, 2)); mx = fmaxf(mx, __shfl_xor(mx, 4)); mx = fmaxf(mx, __shfl_xor(mx, 8)); mx = fmaxf(mx, __shfl_xor(mx, 16)); mx = fmaxf(mx, __shfl_xor(mx, 32));
              if ((tid & 63) < 2) sc[512 + 2048 + (tid >> 6) * 2 + bj] = mx; }
            asm volatile("s_waitcnt lgkmcnt(0)" ::: "memory"); __builtin_amdgcn_s_barrier(); asm volatile("" ::: "memory");
            if (tid < 2) { float m = 0.f;
#pragma unroll
                for (int w = 0; w < 8; ++w) m = fmaxf(m, sc[512 + 2048 + w * 2 + tid]);
                kmax[(b * NH + h0 + tid) * NBLK + blk] = m; }
        }
    }
};
struct EpiOut {
    bf16_t* XB; u64_t* ssq_next; LAS float* ts;
    __device__ __forceinline__ void operator()(const f32x4 (&acc)[2][2][4][2], const Unit& u, int wr, int wc, int fr, int fq) const {
        const int row0 = u.pm * BM + wr * 64 + fr, col0 = u.pn * BM + wc * 32 + 8 * fq;
        u32x4 xin[2][4][2];
#pragma unroll
        for (int ai = 0; ai < 2; ++ai)
#pragma unroll
            for (int m = 0; m < 4; ++m)
#pragma unroll
                for (int bj = 0; bj < 2; ++bj) xin[ai][m][bj] = *(const u32x4*)(XB + (size_t)(row0 + ai * HALF + m * 16) * DM + col0 + bj * HALF);
        __builtin_amdgcn_sched_barrier(0);
#pragma unroll
        for (int ai = 0; ai < 2; ++ai)
#pragma unroll
            for (int m = 0; m < 4; ++m) { const int t = row0 + ai * HALF + m * 16; float ss = 0.f;
#pragma unroll
                for (int bj = 0; bj < 2; ++bj) { const u32x4 xi = xin[ai][m][bj];
                    f32x4 v0, v1; v0[0] = bf_lo(xi.x); v0[1] = bf_hi(xi.x); v0[2] = bf_lo(xi.y); v0[3] = bf_hi(xi.y); v1[0] = bf_lo(xi.z); v1[1] = bf_hi(xi.z); v1[2] = bf_lo(xi.w); v1[3] = bf_hi(xi.w);
                    v0 = v0 + acc[ai][bj][m][0]; v1 = v1 + acc[ai][bj][m][1];
                    u32x4 w; w.x = cvt_pk_bf16(v0[0], v0[1]); w.y = cvt_pk_bf16(v0[2], v0[3]); w.z = cvt_pk_bf16(v1[0], v1[1]); w.w = cvt_pk_bf16(v1[2], v1[3]);
                    *(u32x4*)(XB + (size_t)t * DM + col0 + bj * HALF) = w;
                    ss += (v0[0] * v0[0] + v0[1] * v0[1]) + (v0[2] * v0[2] + v0[3] * v0[3]) + (v1[0] * v1[0] + v1[1] * v1[1]) + (v1[2] * v1[2] + v1[3] * v1[3]); }
                ss += __shfl_xor(ss, 16); ss += __shfl_xor(ss, 32);
                if (fq == 0) ts[(wr * 64 + fr + ai * HALF + m * 16) * 4 + wc] = ss; }
        asm volatile("s_waitcnt lgkmcnt(0)" ::: "memory"); __builtin_amdgcn_s_barrier(); asm volatile("" ::: "memory");
        const int tid = opaque_tid();
        if (tid < 256) { const f32x4 p = *(const LAS f32x4*)(ts + tid * 4); atomicAdd(ssq_next + u.pm * BM + tid, ssq_fix((p[0] + p[1]) + (p[2] + p[3]))); }
    }
};
struct EpiUp {
    bf16_t* ACT; float* halo; const float* cw; const u64_t* ssq;
    __device__ __forceinline__ void operator()(f32x4 (&acc)[2][2][4][2], const Unit& u, int wr, int wc, int fr, int fq) const {
        asm volatile("" : "+v"(fr), "+v"(fq));
        const int tbase = u.pm * BM + 128 * wr + 8 * fr, ch0 = u.pn * 128 + wc * 32 + 8 * fq;
#pragma unroll
        for (int ai = 0; ai < 2; ++ai)
#pragma unroll
            for (int m = 0; m < 4; ++m) { const float rs = ssq_rs(ssq[tbase + 4 * ai + m]);
#pragma unroll
                for (int bj = 0; bj < 2; ++bj)
#pragma unroll
                    for (int n = 0; n < 2; ++n) acc[ai][bj][m][n] = acc[ai][bj][m][n] * rs; }
        if (fr == 0 || fr == 15) {
            float* hb = halo + ((size_t)(tbase >> 7) * 4 + (fr == 0 ? 0 : 2)) * (2 * FFD) + ch0;
#pragma unroll
            for (int jj = 0; jj < 2; ++jj)
#pragma unroll
                for (int n = 0; n < 2; ++n) {
                    const f32x4 g0 = (fr == 0) ? acc[0][0][jj][n] : acc[1][0][2 + jj][n], u0 = (fr == 0) ? acc[0][1][jj][n] : acc[1][1][2 + jj][n];
                    *(f32x4*)(hb + (size_t)jj * (2 * FFD) + 4 * n) = g0; *(f32x4*)(hb + (size_t)jj * (2 * FFD) + FFD + 4 * n) = u0; }
        }
#pragma unroll
        for (int n = 0; n < 2; ++n) {
#pragma unroll
            for (int half = 1; half >= 0; --half) {
                f32x4 w[3];
#pragma unroll
                for (int k = 0; k < 3; ++k) w[k] = *(const f32x4*)(cw + (size_t)k * (2 * FFD) + half * FFD + ch0 + 4 * n);
                f32x4 p6, p7;
#pragma unroll
                for (int e = 0; e < 4; ++e) { p6[e] = dpp_shr1(acc[1][half][2][n][e]); p7[e] = dpp_shr1(acc[1][half][3][n][e]); }
#pragma unroll
                for (int j = 7; j >= 0; --j) {
                    const int j1 = j >= 1 ? j - 1 : 0, j2 = j >= 2 ? j - 2 : 0;
                    const f32x4 x0 = acc[j >> 2][half][j & 3][n];
                    const f32x4 x1 = (j >= 1) ? acc[j1 >> 2][half][j1 & 3][n] : p7;
                    const f32x4 x2 = (j >= 2) ? acc[j2 >> 2][half][j2 & 3][n] : (j == 1 ? p7 : p6);
                    const f32x4 cv = w[2] * x0 + w[1] * x1 + w[0] * x2;
                    if (half == 1) acc[j >> 2][1][j & 3][n] = cv;
                    else { f32x4 a; const f32x4 up = acc[j >> 2][1][j & 3][n];
#pragma unroll
                        for (int e = 0; e < 4; ++e) a[e] = silu_f(cv[e]) * up[e];
                        acc[j >> 2][0][j & 3][n] = a; }
                }
                asm volatile("" ::: "memory");
            }
        }
#pragma unroll
        for (int j = 0; j < 8; ++j) {
            if (fr == 0 && j < 2) continue;
            const f32x4 v0 = acc[j >> 2][0][j & 3][0], v1 = acc[j >> 2][0][j & 3][1];
            u32x4 w; w.x = cvt_pk_bf16(v0[0], v0[1]); w.y = cvt_pk_bf16(v0[2], v0[3]); w.z = cvt_pk_bf16(v1[0], v1[1]); w.w = cvt_pk_bf16(v1[2], v1[3]);
            *(u32x4*)(ACT + (size_t)(tbase + j) * FFD + ch0) = w;
        }
    }
};
}

struct Params { const float* in[18]; float* out; unsigned char* ws; int ph_lo, ph_hi; };
enum { IN_X = 0, IN_MIXN, IN_FFNN, IN_FINN, IN_MOBA_QKV, IN_MOBA_O, IN_SC_IN, IN_SC_CONV, IN_SC_OUT, IN_GDN_IN, IN_GDN_CONV, IN_GDN_ALOG, IN_GDN_DTB, IN_GDN_NORM, IN_GDN_O, IN_FFN_UP, IN_FFN_CONV, IN_FFN_DN };

__device__ __forceinline__ void transpose_item(const float* W, int ldw, int K, int srccol0, const float* gain, bf16_t* WT, int dstrow0, int k0, LAS float* scr, int lane) {
    float wv[32];
    { const float* wp = W + (size_t)(k0 + (lane >> 5)) * ldw + srccol0 + (lane & 31); unsigned off = 0;
#pragma unroll
      for (int i = 0; i < 32; ++i) { wv[i] = wp[off]; off += 2 * ldw; asm volatile("" : "+v"(off)); }
      __builtin_amdgcn_sched_barrier(0); }
#pragma unroll
    for (int i = 0; i < 32; ++i) { const int kk = 2 * i + (lane >> 5); float v = wv[i]; if (gain) v *= gain[k0 + kk]; scr[kk * 33 + (lane & 31)] = v; }
    asm volatile("s_waitcnt lgkmcnt(0)" ::: "memory");
    const int c = lane & 7;
#pragma unroll
    for (int j = 0; j < 4; ++j) { const int n = (lane >> 3) + 8 * j; const LAS float* s = scr + (8 * c) * 33 + n;
        u32x4 o; o.x = cvt_pk_bf16(s[0 * 33], s[1 * 33]); o.y = cvt_pk_bf16(s[2 * 33], s[3 * 33]); o.z = cvt_pk_bf16(s[4 * 33], s[5 * 33]); o.w = cvt_pk_bf16(s[6 * 33], s[7 * 33]);
        *(u32x4*)(WT + (size_t)(dstrow0 + n) * K + k0 + 8 * c) = o; }
    asm volatile("s_waitcnt lgkmcnt(0)" ::: "memory");
}
__device__ __forceinline__ void phase_prologue(const Params& P, LAS unsigned char* lds, int wg, int G) {
    const int tid = opaque_tid(), lane = tid & 63, wave = tid >> 6;
    LAS float* scr = (LAS float*)(lds + wave * 16384);
    const int gw = wg * 8 + wave, NGW = G * 8;
    bf16_t* Wb = (bf16_t*)(P.ws + WS_W);
    constexpr int NITEMS = 3072 + 1024 + 1536 + 512 + 2048 + 512 + 4 * 2816 + 4 * 1408;
    for (int it = gw; it < NITEMS; it += NGW) {
        int r = it; const float* src; int ldw, K, N; const float* gain; size_t doff; int map = 0;
        if (r < 3072) { const int j = r / 1536; r -= j * 1536; src = P.in[IN_MOBA_QKV] + (size_t)j * DM * 3072; ldw = 3072; K = DM; N = 3072; gain = P.in[IN_MIXN] + (j == 0 ? 0 : 3) * DM; doff = j == 0 ? W_MOBA_QKV0 : W_MOBA_QKV1; }
        else if ((r -= 3072) < 1024) { const int j = r / 512; r -= j * 512; src = P.in[IN_MOBA_O] + (size_t)j * DM * DM; ldw = DM; K = DM; N = DM; gain = nullptr; doff = j == 0 ? W_MOBA_O0 : W_MOBA_O1; }
        else if ((r -= 1024) < 1536) { src = P.in[IN_SC_IN]; ldw = 3072; K = DM; N = 3072; gain = P.in[IN_MIXN] + 1 * DM; doff = W_SC_IN; }
        else if ((r -= 1536) < 512) { src = P.in[IN_SC_OUT]; ldw = DM; K = DM; N = DM; gain = nullptr; doff = W_SC_OUT; }
        else if ((r -= 512) < 2048) { src = P.in[IN_GDN_IN]; ldw = 4112; K = DM; N = 4096; gain = P.in[IN_MIXN] + 2 * DM; doff = W_GDN_IN; }
        else if ((r -= 2048) < 512) { src = P.in[IN_GDN_O]; ldw = DM; K = DM; N = DM; gain = nullptr; doff = W_GDN_O; }
        else if ((r -= 512) < 4 * 2816) { const int j = r / 2816; r -= j * 2816; src = P.in[IN_FFN_UP] + (size_t)j * DM * (2 * FFD); ldw = 2 * FFD; K = DM; N = 2 * FFD; gain = P.in[IN_FFNN] + j * DM; doff = W_FFN_UP + j * W_FFN_UP_STRIDE; map = 1; }
        else { r -= 4 * 2816; const int j = r / 1408; r -= j * 1408; src = P.in[IN_FFN_DN] + (size_t)j * FFD * DM; ldw = DM; K = FFD; N = DM; gain = nullptr; doff = W_FFN_DN + j * W_FFN_DN_STRIDE; }
        const int nblk = N / 32, kb = r / nblk, nb = r % nblk, n0 = 32 * nb;
        int sc0 = n0;
        if (map == 1) { const int tile = n0 >> 8, w = n0 & 255; sc0 = (w < 128) ? tile * 128 + w : FFD + tile * 128 + (w - 128); }
        transpose_item(src, ldw, K, sc0, gain, (bf16_t*)((unsigned char*)Wb + doff), n0, 64 * kb, scr, lane);
    }
    { bf16_t* bgh = (bf16_t*)(P.ws + WS_MISC + MISC_BGW); bf16_t* bgl = bgh + 16 * DM; const float* src = P.in[IN_GDN_IN]; const float* gain = P.in[IN_MIXN] + 2 * DM;
      for (int i = wg * 512 + tid; i < 16 * DM; i += G * 512) { const int c = i >> 10, k = i & 1023; const float w = src[(size_t)k * 4112 + 4096 + c] * gain[k]; const bf16_t hi = f2bf(w); bgh[i] = hi; bgl[i] = f2bf(w - bf2f(hi)); } }
    { const float* x = P.in[IN_X]; bf16_t* xb = (bf16_t*)(P.ws + WS_XB); u64_t* ssq = (u64_t*)(P.ws + WS_SSQ);
      for (int t0 = gw; t0 < T_TOK; t0 += 4 * NGW) {
          f32x4 v[4][4];
#pragma unroll
          for (int r = 0; r < 4; ++r) { const f32x4* xr = (const f32x4*)(x + (size_t)(t0 + r * NGW) * DM) + lane;
#pragma unroll
              for (int j = 0; j < 4; ++j) v[r][j] = xr[64 * j]; }
#pragma unroll
          for (int r = 0; r < 4; ++r) { const int t = t0 + r * NGW; u32x2* brow = (u32x2*)(xb + (size_t)t * DM) + lane; float s = 0.f;
#pragma unroll
              for (int j = 0; j < 4; ++j) { const f32x4 q = v[r][j]; u32x2 w; w.x = cvt_pk_bf16(q[0], q[1]); w.y = cvt_pk_bf16(q[2], q[3]); brow[64 * j] = w; s += (q[0] * q[0] + q[1] * q[1]) + (q[2] * q[2] + q[3] * q[3]); }
              s = wave_sum(s); if (lane == 0) ssq[t] = ssq_fix(s); } } }
}

__device__ __forceinline__ void phase_final(const Params& P, int wg, int G) {
    const int tid = opaque_tid(), lane = tid & 63, wave = tid >> 6, gw = wg * 8 + wave, NGW = G * 8;
    const u64_t* ssq = (const u64_t*)(P.ws + WS_SSQ) + (size_t)8 * T_TOK; const f32x4* gn = (const f32x4*)P.in[IN_FINN] + lane; const bf16_t* xb = (const bf16_t*)(P.ws + WS_XB);
    const f32x4 g0 = gn[0], g1 = gn[64], g2 = gn[128], g3 = gn[192];
    for (int t0 = gw; t0 < T_TOK; t0 += 4 * NGW) {
        u32x2 v[4][4]; float rs[4];
#pragma unroll
        for (int r = 0; r < 4; ++r) { const int t = t0 + r * NGW; rs[r] = ssq_rs(ssq[t]); const u32x2* xr = (const u32x2*)(xb + (size_t)t * DM) + lane;
#pragma unroll
            for (int j = 0; j < 4; ++j) v[r][j] = xr[64 * j]; }
#pragma unroll
        for (int r = 0; r < 4; ++r) { const int t = t0 + r * NGW; f32x4* xo = (f32x4*)(P.out + (size_t)t * DM) + lane;
            xo[0] = bf4(v[r][0]) * rs[r] * g0; xo[64] = bf4(v[r][1]) * rs[r] * g1; xo[128] = bf4(v[r][2]) * rs[r] * g2; xo[192] = bf4(v[r][3]) * rs[r] * g3; }
    }
}

__device__ __forceinline__ void phase_ffn_fix(const Params& P, int layer, int wg, int G) {
    const float* halo = (const float*)(P.ws + WS_S + S_FFN_HALO); bf16_t* act = (bf16_t*)(P.ws + WS_S + S_FFN_ACT); const float* cw = P.in[IN_FFN_CONV] + (size_t)layer * 3 * (2 * FFD);
    const int tid = opaque_tid();
    for (int i = wg * 512 + tid; i < 512 * FFD; i += G * 512) {
        const int row = i / FFD, c = i - row * FFD, g = row >> 1, tau = row & 1, t = 128 * g + tau, s = t & (SEQ - 1);
        const float* hg = halo + (size_t)g * 4 * (2 * FFD); const float* hp = hg - 4 * (2 * FFD);
        float g0, g1, g2, u0, u1, u2;
        if (tau == 0) { g0 = hg[c]; u0 = hg[FFD + c]; if (s >= 2) { g1 = hp[3 * (2 * FFD) + c]; u1 = hp[3 * (2 * FFD) + FFD + c]; g2 = hp[2 * (2 * FFD) + c]; u2 = hp[2 * (2 * FFD) + FFD + c]; } else { g1 = g2 = u1 = u2 = 0.f; } }
        else { g0 = hg[(2 * FFD) + c]; u0 = hg[(2 * FFD) + FFD + c]; g1 = hg[c]; u1 = hg[FFD + c]; if (s >= 2) { g2 = hp[3 * (2 * FFD) + c]; u2 = hp[3 * (2 * FFD) + FFD + c]; } else { g2 = u2 = 0.f; } }
        const float gc = cw[2 * (2 * FFD) + c] * g0 + cw[(2 * FFD) + c] * g1 + cw[c] * g2;
        const float uc = cw[2 * (2 * FFD) + FFD + c] * u0 + cw[(2 * FFD) + FFD + c] * u1 + cw[FFD + c] * u2;
        act[(size_t)t * FFD + c] = f2bf(silu_f(gc) * uc);
    }
}

__device__ __forceinline__ void phase_sconv(const Params& P, int wg, int G) {
    const bf16_t* proj = (const bf16_t*)(P.ws + WS_S + S_SC_PROJ); bf16_t* y = (bf16_t*)(P.ws + WS_S + S_SC_Y); const float* cw = P.in[IN_SC_CONV];
    const int c = 2 * opaque_tid();
    const float w00 = cw[c], w01 = cw[c + 1], w10 = cw[DM + c], w11 = cw[DM + c + 1], w20 = cw[2 * DM + c], w21 = cw[2 * DM + c + 1];
    for (int ch = wg; ch < T_TOK / 64; ch += G) {
        const int t0 = ch * 64, s0 = t0 & (SEQ - 1);
        float p1a = 0.f, p1b = 0.f, p2a = 0.f, p2b = 0.f;
        if (s0 != 0) {
            const unsigned c1 = *(const unsigned*)(proj + (size_t)(t0 - 1) * 3072 + DM + c), x1 = *(const unsigned*)(proj + (size_t)(t0 - 1) * 3072 + 2 * DM + c);
            const unsigned c2 = *(const unsigned*)(proj + (size_t)(t0 - 2) * 3072 + DM + c), x2 = *(const unsigned*)(proj + (size_t)(t0 - 2) * 3072 + 2 * DM + c);
            p1a = bf_lo(c1) * bf_lo(x1); p1b = bf_hi(c1) * bf_hi(x1); p2a = bf_lo(c2) * bf_lo(x2); p2b = bf_hi(c2) * bf_hi(x2);
        }
#pragma unroll 1
        for (int i0 = 0; i0 < 64; i0 += 16) {
            unsigned bb[16], cc[16], xx[16];
#pragma unroll
            for (int i = 0; i < 16; ++i) { const bf16_t* r = proj + (size_t)(t0 + i0 + i) * 3072; bb[i] = *(const unsigned*)(r + c); cc[i] = *(const unsigned*)(r + DM + c); xx[i] = *(const unsigned*)(r + 2 * DM + c); }
#pragma unroll
            for (int i = 0; i < 16; ++i) {
                const float pa = bf_lo(cc[i]) * bf_lo(xx[i]), pb = bf_hi(cc[i]) * bf_hi(xx[i]);
                const float ya = bf_lo(bb[i]) * (w20 * pa + w10 * p1a + w00 * p2a), yb = bf_hi(bb[i]) * (w21 * pb + w11 * p1b + w01 * p2b);
                *(unsigned*)(y + (size_t)(t0 + i0 + i) * DM + c) = cvt_pk_bf16(ya, yb);
                p2a = p1a; p2b = p1b; p1a = pa; p1b = pb; }
        }
    }
}


__device__ __forceinline__ void phase_moba_gate2(const Params& P, LAS unsigned char* lds, int mj, int wg, int G) {
    const bf16_t* qkv = (const bf16_t*)(P.ws + WS_S + S_MOBA_QKV); const bf16_t* kmh = (const bf16_t*)(P.ws + WS_MISC + MISC_KMEAN); const bf16_t* kml = kmh + 1024 * 128;
    int* cnt = (int*)(P.ws + WS_CTL + CTL_CNT) + mj * 1024; unsigned short* list = (unsigned short*)(P.ws + WS_S + S_MOBA_LIST);
    const int tid = opaque_tid(), lane = tid & 63, wave = __builtin_amdgcn_readfirstlane(tid >> 6), i16 = lane & 15, quad = lane >> 4;
    LAS float* SC = (LAS float*)(lds + 34816); LAS int* cntL = (LAS int*)(lds + 34816 + 66560); LAS int* baseL = cntL + 64; LAS float* qnL = (LAS float*)(baseL + 64); LAS float* kmxL = qnL + 256;
    for (int u = wg; u < 63 * 16; u += G) {
        const int own = 63 - u / 16, bh = u & 15, b = bh >> 3, h = bh & 7, nnb = (own + 15) >> 4;
        __syncthreads();
        if (tid < 64) cntL[tid] = 0;
        for (int c = tid; c < nnb * 256; c += 512) { const int row = c >> 4, pc = c & 15;
            *(LAS u32x4*)(lds + row * 272 + pc * 16) = *(const u32x4*)(kmh + (size_t)(bh * NBLK + row) * 128 + pc * 8);
            *(LAS u32x4*)(lds + 17408 + row * 272 + pc * 16) = *(const u32x4*)(kml + (size_t)(bh * NBLK + row) * 128 + pc * 8); }
        bf16x8 qf[2][4];
#pragma unroll
        for (int q2 = 0; q2 < 2; ++q2) { const bf16_t* qp = qkv + ((size_t)b * SEQ + own * BLK + 16 * (2 * wave + q2) + i16) * 3072 + h * HD + 8 * quad;
#pragma unroll
            for (int ks = 0; ks < 4; ++ks) qf[q2][ks] = *(const bf16x8*)(qp + 32 * ks);
            float s2 = 0.f;
#pragma unroll
            for (int ks = 0; ks < 4; ++ks) { const u32x4 w4 = __builtin_bit_cast(u32x4, qf[q2][ks]);
#pragma unroll
                for (int e = 0; e < 4; ++e) { const float a = bf_lo(w4[e]), c = bf_hi(w4[e]); s2 += a * a + c * c; } }
            s2 += __shfl_xor(s2, 16); s2 += __shfl_xor(s2, 32);
            if (quad == 0) qnL[16 * (2 * wave + q2) + i16] = s2; }
        if (tid < 64) kmxL[tid] = ((const float*)(P.ws + WS_S + S_MOBA_KMAX))[bh * NBLK + tid];
        float kself_pre = 0.f;
        if (tid < 256) kself_pre = ((const float*)(P.ws + WS_S + S_MOBA_KN))[((size_t)b * SEQ + own * BLK + tid) * NH + h];
        __syncthreads();
#pragma unroll
        for (int q2 = 0; q2 < 2; ++q2)
#pragma unroll 1
            for (int nb = 0; nb < nnb; ++nb) { f32x4 acc = (f32x4){0.f, 0.f, 0.f, 0.f};
#pragma unroll
                for (int ks = 0; ks < 4; ++ks) { acc = __builtin_amdgcn_mfma_f32_16x16x32_bf16(qf[q2][ks], *(const LAS bf16x8*)(lds + 17408 + (16 * nb + i16) * 272 + (32 * ks + 8 * quad) * 2), acc, 0, 0, 0);
                                                 acc = __builtin_amdgcn_mfma_f32_16x16x32_bf16(qf[q2][ks], *(const LAS bf16x8*)(lds + (16 * nb + i16) * 272 + (32 * ks + 8 * quad) * 2), acc, 0, 0, 0); }
#pragma unroll
                for (int jj = 0; jj < 4; ++jj) SC[(16 * (2 * wave + q2) + 4 * quad + jj) * 65 + 16 * nb + i16] = acc[jj]; }
        __syncthreads();
        int sel[3] = {-1, -1, -1}, lp[3] = {0, 0, 0};
        if (tid < 256) { const LAS float* sr = SC + tid * 65;
            float v0 = -3.0e38f, v1 = -3.0e38f, v2 = -3.0e38f; int i0 = -1, i1 = -1, i2 = -1;
            for (int n = 0; n < own; ++n) { const float s = sr[n];
                if (s > v0) { v2 = v1; i2 = i1; v1 = v0; i1 = i0; v0 = s; i0 = n; } else if (s > v1) { v2 = v1; i2 = i1; v1 = s; i1 = n; } else if (s > v2) { v2 = s; i2 = n; } }
            sel[0] = i0; sel[1] = i1; sel[2] = i2;
            const int tl_ = own * BLK + tid; const float qn = __builtin_amdgcn_sqrtf(qnL[tid]) * 0.08838834764831845f, kself = kself_pre, slope = exp2f(-(float)(h + 1));
            unsigned mbits = 0u;
#pragma unroll
            for (int s = 0; s < 3; ++s) if (sel[s] >= 0) { const float bound = qn * (kmxL[sel[s]] + kself) - slope * (float)(tl_ - (sel[s] * BLK + BLK - 1));
                if (bound < -110.0f) sel[s] = -1; else mbits |= 1u << s; }
            ((unsigned char*)(P.ws + WS_S + S_MOBA_MASK))[((size_t)b * SEQ + tl_) * NH + h] = (unsigned char)mbits;
#pragma unroll
            for (int s = 0; s < 3; ++s) lp[s] = (sel[s] >= 0) ? __hip_atomic_fetch_add(cntL + sel[s], 1, __ATOMIC_RELAXED, __HIP_MEMORY_SCOPE_WORKGROUP) : 0;
        }
        __syncthreads();
        if (tid < 64) { const int c = cntL[tid]; baseL[tid] = (c > 0) ? atomicAdd(cnt + (b * NH + h) * NBLK + tid, c) : 0; }
        __syncthreads();
        if (tid < 256) { const int tl = own * BLK + tid;
#pragma unroll
            for (int s = 0; s < 3; ++s) if (sel[s] >= 0) list[(size_t)((b * NH + h) * NBLK + sel[s]) * SEQ + baseL[sel[s]] + lp[s]] = (unsigned short)((tl << 2) | s); }
    }
}

constexpr int AT_KSTRIDE = 272, AT_VS = 256 * 272, AT_VSTRIDE = 288, AT_PREF = AT_VS + 256 * 288;
typedef short s16x4 __attribute__((ext_vector_type(4)));
struct AtRegs { u32x4 p[8]; bf16x8 q[4]; unsigned mbits; float ls[3]; };
#define AT_BAR() do { asm volatile("s_waitcnt lgkmcnt(0)" ::: "memory"); __builtin_amdgcn_s_barrier(); asm volatile("" ::: "memory"); } while (0)
template <bool OWN>
__device__ __forceinline__ void attn_issue_kq(const Params& P, int b, int h, int j, int tl, int tid, AtRegs& R) {
    const bf16_t* qkvb = (const bf16_t*)(P.ws + WS_S + S_MOBA_QKV) + (size_t)b * SEQ * 3072;
    const int piece = tid & 15, r0 = tid >> 4, quad = (tid & 63) >> 4;
    const char* kp = (const char*)(qkvb + (size_t)(j * BLK + 8 * ((r0 & 15) >> 2) + 4 * (r0 >> 4) + (r0 & 3)) * 3072 + DM + h * HD + piece * 8);
#pragma unroll
    for (int it = 0; it < 8; ++it) R.p[it] = *(const u32x4*)(kp + (size_t)it * (32 * 3072 * 2));
    const bf16_t* qp = qkvb + (size_t)tl * 3072 + h * HD + quad * 8;
#pragma unroll
    for (int ks = 0; ks < 4; ++ks) R.q[ks] = *(const bf16x8*)(qp + 32 * ks);
    if (OWN) { R.mbits = (j != 0) ? (unsigned)((const unsigned char*)(P.ws + WS_S + S_MOBA_MASK))[((size_t)b * SEQ + tl) * NH + h] : 0u;
        const float* plse = (const float*)(P.ws + WS_S + S_MOBA_LSE) + ((size_t)tl * NH + h) * 3;
#pragma unroll
        for (int s = 0; s < 3; ++s) R.ls[s] = plse[s]; }
}
template <bool OWN, int nkb>
__device__ __forceinline__ void attn_tile(const Params& P, LAS unsigned char* lds, int b, int h, int j, int tl, bool valid, int slot, AtRegs& R, bool hasN, int hN, int jN, int tlN) {
    const int tid = opaque_tid(), lane = tid & 63, i = lane & 15, quad = lane >> 4, piece = tid & 15, r0 = tid >> 4;
    bf16_t* qkvb = (bf16_t*)(P.ws + WS_S + S_MOBA_QKV) + (size_t)b * SEQ * 3072;
    AT_BAR();
#pragma unroll
    for (int it = 0; it < 8; ++it) *(LAS u32x4*)(lds + (r0 + 32 * it) * AT_KSTRIDE + piece * 16) = R.p[it];
    bf16x8 qf[4]; unsigned mbits = 0u; float ls[3] = {0.f, 0.f, 0.f};
#pragma unroll
    for (int ks = 0; ks < 4; ++ks) qf[ks] = R.q[ks];
    if (OWN) { mbits = R.mbits;
#pragma unroll
        for (int s = 0; s < 3; ++s) ls[s] = R.ls[s]; }
    AT_BAR();
    bf16_t* op = qkvb + (size_t)tl * 3072 + h * HD + 4 * quad;
    u32x2 pv[3][8];
    if (OWN) { const bf16_t* ppo = (const bf16_t*)(P.ws + WS_S + S_MOBA_PO) + ((size_t)tl * NH + h) * 3 * HD + 4 * quad;
#pragma unroll
        for (int s = 0; s < 3; ++s) { const bf16_t* src = ((mbits >> s) & 1u) ? ppo + (size_t)s * HD : op;
#pragma unroll
            for (int db = 0; db < 8; ++db) pv[s][db] = *(const u32x2*)(src + 16 * db); } }
    { const char* vp = (const char*)(qkvb + (size_t)(j * BLK + r0) * 3072 + 2 * DM + h * HD + piece * 8);
#pragma unroll
      for (int it = 0; it < 8; ++it) R.p[it] = *(const u32x4*)(vp + (size_t)it * (32 * 3072 * 2)); }
    f32x4 sc[16];
#pragma unroll
    for (int kb = 0; kb < 16; ++kb) {
        sc[kb] = (f32x4){0.f, 0.f, 0.f, 0.f};
        if (kb < nkb) {
#pragma unroll
            for (int ks = 0; ks < 4; ++ks) { const bf16x8 kf = *(const LAS bf16x8*)(lds + (16 * kb + i) * AT_KSTRIDE + (32 * ks + 8 * quad) * 2);
                sc[kb] = __builtin_amdgcn_mfma_f32_16x16x32_bf16(kf, qf[ks], sc[kb], 0, 0, 0); }
        }
    }
    const float slope = fast_exp2(-(float)(h + 1)) * LOG2E, scale = 0.08838834764831845f * LOG2E;
    float mx = -3.0e38f;
    const int rq = tl - j * BLK - 8 * quad; const float c0 = -slope * (float)rq;
#pragma unroll
    for (int kb = 0; kb < 16; ++kb) if (kb < nkb) {
#pragma unroll
        for (int jj = 0; jj < 4; ++jj) { const int K = 32 * (kb >> 1) + 4 * (kb & 1) + jj;
            float s = fmaf(sc[kb][jj], scale, fmaf(slope, (float)K, c0)); if (OWN && K > rq) s = -1.0e30f; sc[kb][jj] = s; mx = fmaxf(mx, s); }
    }
    mx = fmaxf(mx, __shfl_xor(mx, 16)); mx = fmaxf(mx, __shfl_xor(mx, 32));
    float l = 0.f;
#pragma unroll
    for (int kb = 0; kb < 16; ++kb) if (kb < nkb) {
#pragma unroll
        for (int jj = 0; jj < 4; ++jj) { const float p = fast_exp2(sc[kb][jj] - mx); sc[kb][jj] = p; l += p; }
    }
    l += __shfl_xor(l, 16); l += __shfl_xor(l, 32);
    const float lse = (mx + __log2f(l)) * LN2;
    f32x4 oacc[8];
    if (OWN) {
        float M = lse;
#pragma unroll
        for (int s = 0; s < 3; ++s) { ls[s] = ((mbits >> s) & 1u) ? ls[s] : -3.0e38f; M = fmaxf(M, ls[s]); }
        const float wown = __expf(lse - M); float wsl[3]; float den = wown;
#pragma unroll
        for (int s = 0; s < 3; ++s) { wsl[s] = ((mbits >> s) & 1u) ? __expf(ls[s] - M) : 0.f; den += wsl[s]; }
        const float rden = fast_rcp(den), wo = wown * fast_rcp(l) * rden;
#pragma unroll
        for (int s = 0; s < 3; ++s) wsl[s] *= rden;
#pragma unroll
        for (int kb = 0; kb < 16; ++kb) if (kb < nkb) sc[kb] = sc[kb] * wo;
#pragma unroll
        for (int db = 0; db < 8; ++db) { f32x4 o = (f32x4){0.f, 0.f, 0.f, 0.f};
#pragma unroll
            for (int s = 0; s < 3; ++s) { const u32x2 q = pv[s][db]; const float ww = wsl[s];
                o[0] += ww * bf_lo(q.x); o[1] += ww * bf_hi(q.x); o[2] += ww * bf_lo(q.y); o[3] += ww * bf_hi(q.y); }
            oacc[db] = o; }
    } else {
#pragma unroll
        for (int db = 0; db < 8; ++db) oacc[db] = (f32x4){0.f, 0.f, 0.f, 0.f};
    }
    bf16x8 pf[8];
#pragma unroll
    for (int s = 0; s < 8; ++s) if (2 * s < nkb) pf[s] = pack8(sc[2 * s], sc[2 * s + 1]);
#pragma unroll
    for (int it = 0; it < 8; ++it) *(LAS u32x4*)(lds + AT_VS + (r0 + 32 * it) * AT_VSTRIDE + piece * 16) = R.p[it];
    AT_BAR();
    if (hasN) attn_issue_kq<OWN>(P, b, hN, jN, tlN, tid, R);
#pragma unroll
    for (int s = 0; s < 8; ++s) if (2 * s < nkb) {
#pragma unroll
        for (int db = 0; db < 8; ++db) {
            const LAS unsigned char* vp = lds + AT_VS + (32 * s + 8 * quad + (i >> 2)) * AT_VSTRIDE + (16 * db + 4 * (i & 3)) * 2;
            const s16x4 lo = __builtin_amdgcn_ds_read_tr16_b64_v4i16((LAS s16x4*)vp), hi = __builtin_amdgcn_ds_read_tr16_b64_v4i16((LAS s16x4*)(vp + 4 * AT_VSTRIDE));
            const bf16x8 vf = __builtin_shufflevector(lo, hi, 0, 1, 2, 3, 4, 5, 6, 7);
            oacc[db] = __builtin_amdgcn_mfma_f32_16x16x32_bf16(vf, pf[s], oacc[db], 0, 0, 0); }
    }
    if (!OWN) {
        if (valid) {
            const float inv = fast_rcp(l); const size_t pr = ((size_t)tl * NH + h) * 3 + slot;
            bf16_t* po = (bf16_t*)(P.ws + WS_S + S_MOBA_PO) + pr * HD + 4 * quad;
#pragma unroll
            for (int db = 0; db < 8; ++db) { u32x2 w; w.x = cvt_pk_bf16(oacc[db][0] * inv, oacc[db][1] * inv); w.y = cvt_pk_bf16(oacc[db][2] * inv, oacc[db][3] * inv); *(u32x2*)(po + 16 * db) = w; }
            if (quad == 0) ((float*)(P.ws + WS_S + S_MOBA_LSE))[pr] = lse;
        }
    } else {
#pragma unroll
        for (int db = 0; db < 8; ++db) { u32x2 w; w.x = cvt_pk_bf16(oacc[db][0], oacc[db][1]); w.y = cvt_pk_bf16(oacc[db][2], oacc[db][3]); *(u32x2*)(op + 16 * db) = w; }
    }
}

__device__ __forceinline__ void phase_moba_gather(const Params& P, LAS unsigned char* lds, int mj, int b, int wg, int G) {
    const int* cnt = (const int*)(P.ws + WS_CTL + CTL_CNT) + mj * 1024 + b * 512;
    const unsigned short* list = (const unsigned short*)(P.ws + WS_S + S_MOBA_LIST) + (size_t)b * 512 * SEQ;
    const int tid = opaque_tid(), lane = tid & 63, wid = tid >> 6;
    LAS int* pref = (LAS int*)(lds + AT_PREF); LAS int* cl = pref + 520; LAS int* wtot = cl + 512;
    __syncthreads();
    { const int c = cnt[tid]; int v = (c + 127) >> 7; cl[tid] = c;
#pragma unroll
      for (int o = 1; o < 64; o <<= 1) { const int y = __shfl_up(v, o); if (lane >= o) v += y; }
      if (lane == 63) wtot[wid] = v;
      __syncthreads();
      int base = 0; for (int w = 0; w < wid; ++w) base += wtot[w];
      pref[tid + 1] = base + v; if (tid == 0) pref[0] = 0; }
    __syncthreads();
    const int total = pref[512];
    const int nx = G >> 3, xr = (G & 7) ? 0 : 1;
    int item = xr ? (wg & 7) * nx + (wg >> 3) : wg;
    if (item >= total) return;
#define AT_DECODE(it_, hj_, va_, ad_) do { int lo_ = 0, hi_ = 512; while (hi_ - lo_ > 1) { const int mid_ = (lo_ + hi_) >> 1; if (pref[mid_] <= (it_)) lo_ = mid_; else hi_ = mid_; } \
        hj_ = lo_; const int c_ = cl[lo_], e_ = ((it_) - pref[lo_]) * 128 + 16 * wid + (lane & 15); va_ = e_ < c_; ad_ = list + (size_t)lo_ * SEQ + (va_ ? e_ : c_ - 1); } while (0)
    int hjA, hjB = 0, hjC = 0; bool vaA, vaB = false, vaC = false; const unsigned short* ad; unsigned eA, eB = 0, eC = 0;
    AT_DECODE(item, hjA, vaA, ad); eA = *ad;
    bool hasB = item + G < total;
    if (hasB) { AT_DECODE(item + G, hjB, vaB, ad); eB = *ad; }
    AtRegs R;
    attn_issue_kq<false>(P, b, hjA >> 6, hjA & 63, (int)(eA >> 2), tid, R);
    for (;;) {
        const bool hasC = item + 2 * G < total;
        if (hasC) { AT_DECODE(item + 2 * G, hjC, vaC, ad); eC = *ad; }
        attn_tile<false, 16>(P, lds, b, hjA >> 6, hjA & 63, (int)(eA >> 2), vaA, (int)(eA & 3), R, hasB, hjB >> 6, hjB & 63, (int)(eB >> 2));
        if (!hasB) break;
        hjA = hjB; vaA = vaB; eA = eB; hjB = hjC; vaB = vaC; eB = eC; hasB = hasC; item += G;
    }
#undef AT_DECODE
}
__device__ __forceinline__ void phase_moba_own(const Params& P, LAS unsigned char* lds, int b, int wg, int G) {
    const int tid = opaque_tid(), lane = tid & 63, wid = tid >> 6;
    const int nx = G >> 3, xr = (G & 7) ? 0 : 1;
    int it = xr ? (wg & 7) * nx + (wg >> 3) : wg;
    if (it >= 1024) return;
#define AT_OWN(it_, h_, j_, c_, tl_) do { const int hj_ = (it_) >> 1; c_ = (((it_) >> 8) ^ (it_)) & 1; h_ = hj_ >> 6; j_ = hj_ & 63; tl_ = j_ * BLK + 128 * c_ + 16 * wid + (lane & 15); } while (0)
    int hA, jA, cA, tlA, hB = 0, jB = 0, cB = 0, tlB = 0;
    AT_OWN(it, hA, jA, cA, tlA);
    AtRegs R;
    attn_issue_kq<true>(P, b, hA, jA, tlA, tid, R);
    for (;;) {
        const bool hasB = it + G < 1024;
        if (hasB) AT_OWN(it + G, hB, jB, cB, tlB);
        if (cA) attn_tile<true, 16>(P, lds, b, hA, jA, tlA, true, 0, R, hasB, hB, jB, tlB); else attn_tile<true, 8>(P, lds, b, hA, jA, tlA, true, 0, R, hasB, hB, jB, tlB);
        if (!hasB) break;
        hA = hB; jA = jB; cA = cB; tlA = tlB; it += G;
    }
#undef AT_OWN
}
__device__ __forceinline__ void phase_gdn_bg(const Params& P, int wg, int G) {
    const int tid = opaque_tid(), lane = tid & 63, wave = tid >> 6, gw = wg * 8 + wave, NGW = G * 8, i16 = lane & 15, quad = lane >> 4;
    const bf16_t* X = (const bf16_t*)(P.ws + WS_XB); const u64_t* ssq = (const u64_t*)(P.ws + WS_SSQ) + (size_t)4 * T_TOK; const bf16_t* bgh = (const bf16_t*)(P.ws + WS_MISC + MISC_BGW); const bf16_t* bgl = bgh + 16 * DM;
    float* bg = (float*)(P.ws + WS_S + S_GDN_BG); const float* alog = P.in[IN_GDN_ALOG]; const float* dtb = P.in[IN_GDN_DTB];
    for (int g = gw; g < T_TOK / 16; g += NGW) {
        const int t = g * 16 + i16; const bf16_t* xr = X + (size_t)t * DM + 8 * quad; const bf16_t* wh = bgh + i16 * DM + 8 * quad; const bf16_t* wl = bgl + i16 * DM + 8 * quad;
        f32x4 acc = (f32x4){0.f, 0.f, 0.f, 0.f};
#pragma unroll 8
        for (int ks = 0; ks < 32; ++ks) { const bf16x8 xf = *(const bf16x8*)(xr + 32 * ks);
            acc = __builtin_amdgcn_mfma_f32_16x16x32_bf16(*(const bf16x8*)(wh + 32 * ks), xf, acc, 0, 0, 0); acc = __builtin_amdgcn_mfma_f32_16x16x32_bf16(*(const bf16x8*)(wl + 32 * ks), xf, acc, 0, 0, 0); }
        const float rs = ssq_rs(ssq[t]); f32x4 o;
#pragma unroll
        for (int jj = 0; jj < 4; ++jj) { const float raw = acc[jj] * rs;
            if (quad < 2) o[jj] = fast_rcp(1.0f + __expf(-raw));
            else { const int hh = 4 * (quad - 2) + jj; const float xx = raw + dtb[hh]; const float sp = fmaxf(xx, 0.f) + __logf(1.0f + __expf(-fabsf(xx))); o[jj] = -__expf(alog[hh]) * sp; } }
        *(f32x4*)(bg + (size_t)t * 16 + 4 * quad) = o;
    }
}
__device__ __forceinline__ u32x2 pack4(f32x4 v) { u32x2 w; w.x = cvt_pk_bf16(v[0], v[1]); w.y = cvt_pk_bf16(v[2], v[3]); return w; }
__device__ __forceinline__ void phase_gdn_chunk2(const Params& P, LAS unsigned char* lds, int wg, int G) {
    bf16_t* proj = (bf16_t*)(P.ws + WS_S + S_GDN_PROJ); bf16_t* attn = (bf16_t*)(P.ws + WS_S + S_GDN_ATTN); const float* bg = (const float*)(P.ws + WS_S + S_GDN_BG);
    const bf16_t* halo = (const bf16_t*)(P.ws + WS_S + S_GDN_HALO); float* gcum = (float*)(P.ws + WS_S + S_GDN_GC); bf16_t* wbuf = (bf16_t*)P.out; const float* cw = P.in[IN_GDN_CONV];
    LAS float* qL = (LAS float*)lds; LAS float* kL = qL + 64 * 132; LAS float* vL = kL + 64 * 132; LAS float* AL = vL + 64 * 132;
    LAS unsigned char* Qb = lds + 118784; LAS unsigned char* Kb = lds + 136192; LAS float* betaL = (LAS float*)(lds + 153600); LAS float* gcL = betaL + 64; LAS float* DinvL = (LAS float*)(lds + 154112);
    const int tid = opaque_tid(), lane = tid & 63, wave = __builtin_amdgcn_readfirstlane(tid >> 6), i16 = lane & 15, quad = lane >> 4;
    for (int u = wg; u < 4096; u += G) {
        const int b = u >> 11, h = (u >> 8) & 7, n = u & 255; const size_t t0 = (size_t)b * SEQ + (size_t)n * 64;
        bf16_t* projw = proj + t0 * 4096;
        __syncthreads();
        float be_pre = 0.f, gg_pre = 0.f;
        if (wave == 0) { const float* bgp = bg + (t0 + lane) * 16; be_pre = bgp[h]; gg_pre = bgp[8 + h]; }
        if (tid < 384) { const int mat = tid >> 7, d = tid & 127, col = mat * DM + h * HD + d;
            const float w0 = cw[col], w1 = cw[3072 + col], w2 = cw[2 * 3072 + col], w3 = cw[3 * 3072 + col];
            float x3 = 0.f, x2 = 0.f, x1 = 0.f;
            if (n > 0) { const bf16_t* hp = halo + ((t0 >> 6) - 1) * 3 * 3072 + col; x3 = bf2f(hp[0]); x2 = bf2f(hp[3072]); x1 = bf2f(hp[2 * 3072]); }
            const bf16_t* src = proj + t0 * 4096 + col; unsigned off = 0; bf16_t raw[64];
#pragma unroll
            for (int i = 0; i < 64; ++i) { raw[i] = src[off]; off += 4096; asm volatile("" : "+v"(off)); }
            __builtin_amdgcn_sched_barrier(0);
            LAS float* dst = (mat == 0 ? qL : (mat == 1 ? kL : vL)) + d;
#pragma unroll
            for (int i = 0; i < 64; ++i) { const float x0 = bf2f(raw[i]); dst[i * 132] = silu_f(w3 * x0 + w2 * x1 + w1 * x2 + w0 * x3); x3 = x2; x2 = x1; x1 = x0; } }
        __syncthreads();
#pragma unroll 4
        for (int rr = 0; rr < 16; ++rr) { const int r = wave * 16 + rr; LAS float* rowp = (r < 64 ? qL + r * 132 : kL + (r - 64) * 132) + 2 * lane;
            f32x2 v = *(LAS f32x2*)rowp; const float ss = wave_sum(v.x * v.x + v.y * v.y); const float scl = __builtin_amdgcn_rsqf(ss + EPS) * (r < 64 ? 0.08838834764831845f : 1.0f); v = v * scl; *(LAS f32x2*)rowp = v;
            *(LAS unsigned*)((r < 64 ? Qb : Kb) + (r & 63) * 272 + lane * 4) = cvt_pk_bf16(v.x, v.y); }
        if (wave == 0) { const float be = be_pre; float gg = gg_pre;
#pragma unroll
            for (int o = 1; o < 64; o <<= 1) { const float y = __shfl_up(gg, o); if (lane >= o) gg += y; }
            betaL[lane] = be; gcL[lane] = gg; gcum[(size_t)u * 64 + lane] = gg; }
        __syncthreads();
        {
            const int mat = wave >> 2, rb = wave & 3; const LAS unsigned char* Xb = mat ? Qb : Kb;
            bf16x8 af[4];
#pragma unroll
            for (int ks = 0; ks < 4; ++ks) af[ks] = *(const LAS bf16x8*)(Xb + (16 * rb + i16) * 272 + (32 * ks + 8 * quad) * 2);
            float gr[4], br[4];
#pragma unroll
            for (int jj = 0; jj < 4; ++jj) { gr[jj] = gcL[16 * rb + 4 * quad + jj]; br[jj] = betaL[16 * rb + 4 * quad + jj]; }
#pragma unroll
            for (int cb = 0; cb < 4; ++cb) {
                f32x4 acc = (f32x4){0.f, 0.f, 0.f, 0.f};
                if (cb <= rb) {
#pragma unroll
                    for (int ks = 0; ks < 4; ++ks) acc = __builtin_amdgcn_mfma_f32_16x16x32_bf16(af[ks], *(const LAS bf16x8*)(Kb + (16 * cb + i16) * 272 + (32 * ks + 8 * quad) * 2), acc, 0, 0, 0); }
                const int j = 16 * cb + i16; const float gj = gcL[j];
                const int pj = 32 * (cb >> 1) + 8 * (i16 >> 2) + 4 * (cb & 1) + (i16 & 3);
#pragma unroll
                for (int jj = 0; jj < 4; ++jj) { const int r = 16 * rb + 4 * quad + jj; const float dec = (j <= r) ? __expf(gr[jj] - gj) : 0.f;
                    if (mat == 0) AL[r * 68 + j] = (j < r) ? acc[jj] * br[jj] * dec : 0.f;
                    else *(LAS bf16_t*)(lds + 154112 + ((((r >> 4) * 2 + (pj >> 5)) * 64 + ((pj >> 3) & 3) * 16 + (r & 15)) * 8 + (pj & 7)) * 2) = f2bf((j <= r) ? acc[jj] * dec : 0.f); }
            }
        }
        __syncthreads();
        *(u32x4*)(attn + (size_t)u * 4096 + tid * 8) = *(const LAS u32x4*)(lds + 154112 + tid * 16);
#pragma unroll
        for (int k = 0; k < 2; ++k) { const int pi = tid + 512 * k, l_ = pi & 63, i_ = l_ & 15, q_ = l_ >> 4;
            { const int rb_ = pi >> 8, ks_ = (pi >> 6) & 3;
              *(u32x4*)(projw + (size_t)(pi >> 4) * 4096 + h * HD + (pi & 15) * 8) = *(const LAS u32x4*)(Qb + (16 * rb_ + i_) * 272 + (32 * ks_ + 8 * q_) * 2); }
            { const int w_ = pi >> 7, ks_ = (pi >> 6) & 1, dk = 16 * w_ + i_, p0 = 32 * ks_ + 8 * q_; float kv[8];
#pragma unroll
              for (int e = 0; e < 8; ++e) { const int tok = 16 * (2 * (p0 >> 5) + (e >> 2)) + 4 * ((p0 >> 3) & 3) + (e & 3); kv[e] = kL[tok * 132 + dk]; }
              u32x4 w; w.x = cvt_pk_bf16(kv[0], kv[1]); w.y = cvt_pk_bf16(kv[2], kv[3]); w.z = cvt_pk_bf16(kv[4], kv[5]); w.w = cvt_pk_bf16(kv[6], kv[7]);
              *(u32x4*)(projw + (size_t)(pi >> 4) * 4096 + DM + h * HD + (pi & 15) * 8) = w; } }
#pragma unroll
        for (int it = 0; it < 8; ++it) { const int p = tid + 512 * it, row = p >> 6, d = (p & 63) * 2;
            const f32x2 kv = *(LAS f32x2*)(kL + row * 132 + d), vv = *(LAS f32x2*)(vL + row * 132 + d);
            const float be = betaL[row], eg = __expf(gcL[row]);
            *(LAS f32x2*)(qL + row * 132 + d) = kv * (be * eg); *(LAS f32x2*)(vL + row * 132 + d) = vv * be; }
        __syncthreads();
        {
            { const int blk = lane >> 4, c = lane & 15; float y[16];
#pragma unroll
              for (int r = 0; r < 16; ++r) y[r] = (r == c) ? 1.0f : 0.0f;
#pragma unroll
              for (int r = 1; r < 16; ++r) { float s = 0.f;
#pragma unroll
                  for (int j4 = 0; j4 <= (r - 1) / 4; ++j4) { const f32x4 a4 = *(const LAS f32x4*)(AL + (16 * blk + r) * 68 + 16 * blk + 4 * j4);
                      s += a4[0] * y[4 * j4] + a4[1] * y[4 * j4 + 1] + a4[2] * y[4 * j4 + 2] + a4[3] * y[4 * j4 + 3]; }
                  y[r] -= s; }
#pragma unroll
              for (int r = 0; r < 16; ++r) DinvL[(16 * blk + r) * 16 + c] = y[r]; }
            LAS float* Xm = (wave < 4 ? vL : qL) + 32 * (wave & 3) + i16;
#pragma unroll 1
            for (int bi = 0; bi < 4; ++bi)
#pragma unroll 1
                for (int cbl = 0; cbl < 2; ++cbl) {
                    LAS float* Xc = Xm + 16 * cbl; f32x4 acc;
#pragma unroll
                    for (int jj = 0; jj < 4; ++jj) acc[jj] = Xc[(16 * bi + 4 * quad + jj) * 132];
#pragma unroll 1
                    for (int k = 0; k < bi; ++k)
#pragma unroll
                        for (int ks = 0; ks < 4; ++ks) acc = __builtin_amdgcn_mfma_f32_16x16x4f32(-AL[(16 * bi + i16) * 68 + 16 * k + 4 * ks + quad], Xc[(16 * k + 4 * ks + quad) * 132], acc, 0, 0, 0);
#pragma unroll
                    for (int jj = 0; jj < 4; ++jj) Xc[(16 * bi + 4 * quad + jj) * 132] = acc[jj];
                    f32x4 acc2 = (f32x4){0.f, 0.f, 0.f, 0.f};
#pragma unroll
                    for (int ks = 0; ks < 4; ++ks) acc2 = __builtin_amdgcn_mfma_f32_16x16x4f32(DinvL[(16 * bi + i16) * 16 + 4 * ks + quad], Xc[(16 * bi + 4 * ks + quad) * 132], acc2, 0, 0, 0);
#pragma unroll
                    for (int jj = 0; jj < 4; ++jj) Xc[(16 * bi + 4 * quad + jj) * 132] = acc2[jj];
                }
        }
        __syncthreads();
#pragma unroll
        for (int k = 0; k < 2; ++k) { const int pi = tid + 512 * k, q_ = pi & 3, l_ = (pi >> 2) & 63, rb_ = pi >> 8, tok = 16 * rb_ + 4 * (l_ >> 4), col = 32 * q_ + (l_ & 15);
            float uv[8];
#pragma unroll
            for (int e = 0; e < 8; ++e) uv[e] = vL[(tok + (e & 3)) * 132 + col + 16 * (e >> 2)];
            u32x4 w; w.x = cvt_pk_bf16(uv[0], uv[1]); w.y = cvt_pk_bf16(uv[2], uv[3]); w.z = cvt_pk_bf16(uv[4], uv[5]); w.w = cvt_pk_bf16(uv[6], uv[7]);
            *(u32x4*)(projw + (size_t)(pi >> 4) * 4096 + 2 * DM + h * HD + (pi & 15) * 8) = w; }
#pragma unroll
        for (int k = 0; k < 2; ++k) { const int pi = tid + 512 * k, l_ = pi & 63, rb_ = pi >> 8, ks_ = (pi >> 6) & 3;
            const LAS f32x4* wp = (const LAS f32x4*)(qL + (16 * rb_ + (l_ & 15)) * 132 + 32 * ks_ + 8 * (l_ >> 4)); const f32x4 a = wp[0], c = wp[1];
            u32x4 w; w.x = cvt_pk_bf16(a[0], a[1]); w.y = cvt_pk_bf16(a[2], a[3]); w.z = cvt_pk_bf16(c[0], c[1]); w.w = cvt_pk_bf16(c[2], c[3]);
            *(u32x4*)(wbuf + (t0 + (pi >> 4)) * DM + h * HD + (pi & 15) * 8) = w; }
    }
}
constexpr size_t DO_GP = 64 * MiB, DO_GQ = 72 * MiB, DO_GS = 88 * MiB;
#define GS_BAR() do { asm volatile("s_waitcnt lgkmcnt(0)" ::: "memory"); __builtin_amdgcn_s_barrier(); asm volatile("" ::: "memory"); } while (0)
__device__ __forceinline__ u32x2 packsoft4(f32x4 v) { u32x2 w; w.x = (unsigned)f2bf(v[0]) | ((unsigned)f2bf(v[1]) << 16); w.y = (unsigned)f2bf(v[2]) | ((unsigned)f2bf(v[3]) << 16); return w; }
__device__ __forceinline__ void phase_gdn_scanA(const Params& P, LAS unsigned char* lds, int wg, int G) {
    const bf16_t* proj = (const bf16_t*)(P.ws + WS_S + S_GDN_PROJ); const float* gcum = (const float*)(P.ws + WS_S + S_GDN_GC); const bf16_t* wbuf = (const bf16_t*)P.out;
    bf16_t* GP = (bf16_t*)((unsigned char*)P.out + DO_GP); float* GQ = (float*)((unsigned char*)P.out + DO_GQ);
    const int tid = opaque_tid(), lane = tid & 63, wave = __builtin_amdgcn_readfirstlane(tid >> 6), i16 = lane & 15, quad = lane >> 4, rb = wave & 3, hf = wave >> 2;
    LAS unsigned char* ST = lds; LAS unsigned char* VN2 = lds + 69632;
    const int p0 = 32 * (rb >> 1) + 8 * quad + 4 * (rb & 1);
    for (int task = wg; task < 256; task += G) {
        const int bh = task >> 4, g = task & 15, b = bh >> 3, h = bh & 7; const size_t t0 = (size_t)b * SEQ + (size_t)g * 1024, u0 = (size_t)bh * 256 + (size_t)g * 16;
        f32x4 sacc[16]; int dgo = i16 - 4 * quad; asm volatile("" : "+v"(dgo));
#pragma unroll
        for (int cb = 0; cb < 16; ++cb)
#pragma unroll
            for (int jj = 0; jj < 4; ++jj) sacc[cb][jj] = (cb < 8 && cb == wave && dgo == jj) ? 1.0f : 0.0f;
        __syncthreads();
#pragma unroll
        for (int cb = 0; cb < 16; ++cb) *(LAS u32x2*)(ST + (16 * cb + i16) * 272 + (16 * wave + 4 * quad) * 2) = pack4(sacc[cb]);
        const char* pA = (const char*)(wbuf + (t0 + 16 * rb + quad) * DM + h * HD + 8 * i16);
        const char* pK = (const char*)(proj + (t0 + 8 * wave + quad) * 4096 + DM + h * HD + 8 * i16);
        const char* pU = (const char*)(proj + (t0 + 16 * rb + (lane >> 2)) * 4096 + 2 * DM + h * HD + (lane & 3) * 32);
        const char* pG = (const char*)(gcum + u0 * 64 + 16 * rb + 4 * quad); const char* pGl = (const char*)(gcum + u0 * 64 + 63);
        bf16x8 fa[2][4], fk[2][2]; u32x4 uu[2][4]; f32x4 g4[2]; float gl[2];
#define GA_LOAD_A(S) do { _Pragma("unroll") for (int ks_ = 0; ks_ < 4; ++ks_) fa[S][ks_] = *(const bf16x8*)(pA + (size_t)ks_ * (4 * DM * 2)); \
        if (hf) { _Pragma("unroll") for (int q_ = 0; q_ < 4; ++q_) uu[S][q_] = *(const u32x4*)(pU + q_ * 16); } \
        g4[S] = *(const f32x4*)pG; gl[S] = *(const float*)pGl; pA += 64 * DM * 2; pU += 64 * 8192; pG += 256; pGl += 256; } while (0)
#define GA_LOAD_B(S) do { _Pragma("unroll") for (int ks_ = 0; ks_ < 2; ++ks_) fk[S][ks_] = *(const bf16x8*)(pK + (size_t)ks_ * 32768); pK += 64 * 8192; } while (0)
#pragma unroll
        for (int s_ = 0; s_ < 2; ++s_)
#pragma unroll
            for (int q_ = 0; q_ < 4; ++q_) uu[s_][q_] = (u32x4){0u, 0u, 0u, 0u};
        GA_LOAD_A(0); GA_LOAD_B(0); GA_LOAD_A(1); GA_LOAD_B(1);
        GS_BAR();
#define GA_STEP(nn, S) do { \
        const float glast_ = gl[S]; f32x4 ed_; \
        _Pragma("unroll") for (int jj_ = 0; jj_ < 4; ++jj_) ed_[jj_] = __expf(glast_ - g4[S][jj_]); \
        _Pragma("unroll") for (int c4_ = 0; c4_ < 8; c4_ += 4) { f32x4 acc1[4];        \
            _Pragma("unroll") for (int c_ = 0; c_ < 4; ++c_) { acc1[c_] = (f32x4){0.f, 0.f, 0.f, 0.f}; \
                _Pragma("unroll") for (int ks_ = 0; ks_ < 4; ++ks_) acc1[c_] = __builtin_amdgcn_mfma_f32_16x16x32_bf16(fa[S][ks_], *(const LAS bf16x8*)(ST + (16 * (8 * hf + c4_ + c_) + i16) * 272 + (32 * ks_ + 8 * quad) * 2), acc1[c_], 0, 0, 0); } \
            _Pragma("unroll") for (int c_ = 0; c_ < 4; ++c_) { const int cc_ = c4_ + c_; const unsigned ua_ = uu[S][cc_ >> 1][2 * (cc_ & 1)], ub_ = uu[S][cc_ >> 1][2 * (cc_ & 1) + 1]; f32x4 vn2_; \
                vn2_[0] = (bf_lo(ua_) - acc1[c_][0]) * ed_[0]; vn2_[1] = (bf_hi(ua_) - acc1[c_][1]) * ed_[1]; vn2_[2] = (bf_lo(ub_) - acc1[c_][2]) * ed_[2]; vn2_[3] = (bf_hi(ub_) - acc1[c_][3]) * ed_[3]; \
                *(LAS u32x2*)(VN2 + (16 * (8 * hf + cc_) + i16) * 144 + p0 * 2) = pack4(vn2_); } \
            asm volatile("" ::: "memory"); } \
        if ((nn) + 2 < 16) GA_LOAD_A(S); \
        GS_BAR(); \
        const float eg_ = __expf(glast_); \
        _Pragma("unroll") for (int cb_ = 0; cb_ < 16; ++cb_) { f32x4 acc_ = sacc[cb_] * eg_; \
            _Pragma("unroll") for (int ks_ = 0; ks_ < 2; ++ks_) acc_ = __builtin_amdgcn_mfma_f32_16x16x32_bf16(fk[S][ks_], *(const LAS bf16x8*)(VN2 + (16 * cb_ + i16) * 144 + (32 * ks_ + 8 * quad) * 2), acc_, 0, 0, 0); \
            sacc[cb_] = acc_; *(LAS u32x2*)(ST + (16 * cb_ + i16) * 272 + (16 * wave + 4 * quad) * 2) = packsoft4(acc_); \
            if ((cb_ & 3) == 3) asm volatile("" ::: "memory"); } \
        if ((nn) + 2 < 16) GA_LOAD_B(S); \
        GS_BAR(); } while (0)
#pragma unroll 1
        for (int n = 0; n < 16; n += 2) { GA_STEP(n, 0); GA_STEP(n + 1, 1); }
#undef GA_STEP
#undef GA_LOAD_A
#undef GA_LOAD_B
#pragma unroll
        for (int cb = 0; cb < 8; ++cb)
#pragma unroll
            for (int jj = 0; jj < 4; ++jj) GP[(size_t)task * 16384 + (16 * wave + 4 * quad + jj) * 128 + 16 * cb + i16] = f2bf(sacc[cb][jj]);
#pragma unroll
        for (int cb = 0; cb < 8; ++cb) *(f32x4*)(GQ + (((size_t)task * 8 + wave) * 64 + lane) * 32 + cb * 4) = sacc[8 + cb];
    }
}
__device__ __forceinline__ void phase_gdn_scanB(const Params& P, LAS unsigned char* lds, int wg, int G) {
    const int sx = (G % 8 == 0 && G >= 128) ? (wg >> 3) + 16 * (wg & 7) : wg;
    if (wg >= 128) return;
    const int bh = sx >> 3, sl = sx & 7;
    const bf16_t* GP = (const bf16_t*)((const unsigned char*)P.out + DO_GP); const float* GQ = (const float*)((const unsigned char*)P.out + DO_GQ); float* GS = (float*)((unsigned char*)P.out + DO_GS);
    const int tid = opaque_tid(), lane = tid & 63, wave = __builtin_amdgcn_readfirstlane(tid >> 6), i16 = lane & 15, quad = lane >> 4;
    LAS unsigned char* ST = lds;
    f32x4 sacc = (f32x4){0.f, 0.f, 0.f, 0.f};
    bf16x8 fp[8][4]; f32x4 qg[8];
#define GB_LOAD(S, gg) do { const size_t tk_ = (size_t)bh * 16 + (gg); \
        _Pragma("unroll") for (int ks_ = 0; ks_ < 4; ++ks_) fp[S][ks_] = *(const bf16x8*)(GP + tk_ * 16384 + (16 * wave + i16) * 128 + 32 * ks_ + 8 * quad); \
        qg[S] = *(const f32x4*)(GQ + ((tk_ * 8 + wave) * 64 + lane) * 32 + sl * 4); } while (0)
    GB_LOAD(0, 0); GB_LOAD(1, 1); GB_LOAD(2, 2); GB_LOAD(3, 3); GB_LOAD(4, 4); GB_LOAD(5, 5); GB_LOAD(6, 6); GB_LOAD(7, 7);
    __syncthreads();
#define GB_STEP(g, S) do { if ((g) < 16) { const size_t task = (size_t)bh * 16 + (g); \
        *(f32x4*)(GS + ((task * 8 + wave) * 64 + lane) * 32 + sl * 4) = sacc;          \
        if ((g) < 15) { \
            *(LAS u32x2*)(ST + i16 * 272 + (16 * wave + 4 * quad) * 2) = pack4(sacc + (f32x4){0.f, 0.f, 0.f, 0.f}); \
            GS_BAR(); \
            f32x4 acc_ = qg[S]; \
            _Pragma("unroll") for (int ks_ = 0; ks_ < 4; ++ks_) acc_ = __builtin_amdgcn_mfma_f32_16x16x32_bf16(fp[S][ks_], *(const LAS bf16x8*)(ST + i16 * 272 + (32 * ks_ + 8 * quad) * 2), acc_, 0, 0, 0); \
            sacc = acc_; \
            GB_LOAD(S, (g) + 8 < 15 ? (g) + 8 : 14);        \
            GS_BAR(); } } } while (0)
#pragma unroll 1
    for (int g = 0; g < 16; g += 8) { GB_STEP(g, 0); GB_STEP(g + 1, 1); GB_STEP(g + 2, 2); GB_STEP(g + 3, 3); GB_STEP(g + 4, 4); GB_STEP(g + 5, 5); GB_STEP(g + 6, 6); GB_STEP(g + 7, 7); }
#undef GB_STEP
#undef GB_LOAD
}
__device__ __forceinline__ void phase_gdn_scanC(const Params& P, LAS unsigned char* lds, int wg, int G) {
    bf16_t* proj = (bf16_t*)(P.ws + WS_S + S_GDN_PROJ); const bf16_t* attn = (const bf16_t*)(P.ws + WS_S + S_GDN_ATTN); const float* gcum = (const float*)(P.ws + WS_S + S_GDN_GC); const bf16_t* wbuf = (const bf16_t*)P.out;
    const float* GS = (const float*)((const unsigned char*)P.out + DO_GS);
    const int tid = opaque_tid(), lane = tid & 63, wave = __builtin_amdgcn_readfirstlane(tid >> 6), i16 = lane & 15, quad = lane >> 4, rb = wave & 3;
    LAS unsigned char* ST = lds; LAS unsigned char* VN = lds + 34816; LAS unsigned char* VN2 = lds + 53248; LAS unsigned char* OL = lds + 71680; LAS float* WN = (LAS float*)(lds + 89088);
    const int p0 = 32 * (rb >> 1) + 8 * quad + 4 * (rb & 1);
    for (int task = wg; task < 256; task += G) {
        const int bh = task >> 4, g = task & 15, b = bh >> 3, h = bh & 7; const size_t t0 = (size_t)b * SEQ + (size_t)g * 1024, u0 = (size_t)bh * 256 + (size_t)g * 16;
        f32x4 sacc[8];
#pragma unroll
        for (int cb = 0; cb < 8; ++cb) sacc[cb] = *(const f32x4*)(GS + (((size_t)task * 8 + wave) * 64 + lane) * 32 + cb * 4);
        __syncthreads();
#pragma unroll
        for (int cb = 0; cb < 8; ++cb) *(LAS u32x2*)(ST + (16 * cb + i16) * 272 + (16 * wave + 4 * quad) * 2) = pack4(sacc[cb] + (f32x4){0.f, 0.f, 0.f, 0.f});
        const char* pA = (wave < 4) ? (const char*)(wbuf + (t0 + 16 * rb + quad) * DM + h * HD + 8 * i16) : (const char*)(proj + (t0 + 16 * rb + quad) * 4096 + h * HD + 8 * i16);
        const size_t ksA = (wave < 4) ? (size_t)4 * DM * 2 : (size_t)4 * 4096 * 2, stA = (wave < 4) ? (size_t)64 * DM * 2 : (size_t)64 * 4096 * 2;
        const char* pK = (const char*)(proj + (t0 + 8 * wave + quad) * 4096 + DM + h * HD + 8 * i16);
        const char* pU = (const char*)(proj + (t0 + 16 * rb + (lane >> 2)) * 4096 + 2 * DM + h * HD + (lane & 3) * 32);
        const char* pT = (const char*)(attn + u0 * 4096 + (size_t)(rb * 128 + lane) * 8);
        const char* pG = (const char*)(gcum + u0 * 64 + 16 * rb + 4 * quad); const char* pGl = (const char*)(gcum + u0 * 64 + 63);
        bf16_t* pO = proj + (t0 + (tid >> 4)) * 4096 + 2 * DM + h * HD + (tid & 15) * 8;
        bf16x8 fa[2][4], fk[2][2], ft[2][2]; u32x4 uu[2][4], zr[2]; f32x4 g4[2]; float gl[2];
        if (tid < 128) WN[tid] = P.in[IN_GDN_NORM][tid];
#define GC_LOAD_A(S) do { _Pragma("unroll") for (int ks_ = 0; ks_ < 4; ++ks_) fa[S][ks_] = *(const bf16x8*)(pA + (size_t)ks_ * ksA); \
        if (wave < 4) { _Pragma("unroll") for (int q_ = 0; q_ < 4; ++q_) uu[S][q_] = *(const u32x4*)(pU + q_ * 16); } \
        g4[S] = *(const f32x4*)pG; gl[S] = *(const float*)pGl; pA += stA; pU += 64 * 8192; pG += 256; pGl += 256; } while (0)
#define GC_LOAD_B(S) do { _Pragma("unroll") for (int ks_ = 0; ks_ < 2; ++ks_) fk[S][ks_] = *(const bf16x8*)(pK + (size_t)ks_ * 32768); \
        if (wave >= 4) { _Pragma("unroll") for (int ks_ = 0; ks_ < 2; ++ks_) ft[S][ks_] = *(const bf16x8*)(pT + ks_ * 1024); } \
        pK += 64 * 8192; pT += 8192; } while (0)
#pragma unroll
        for (int s_ = 0; s_ < 2; ++s_) {
#pragma unroll
            for (int q_ = 0; q_ < 4; ++q_) uu[s_][q_] = (u32x4){0u, 0u, 0u, 0u};
#pragma unroll
            for (int q_ = 0; q_ < 2; ++q_) ft[s_][q_] = (bf16x8){0, 0, 0, 0, 0, 0, 0, 0}; }
        GC_LOAD_A(0); GC_LOAD_B(0); GC_LOAD_A(1); GC_LOAD_B(1);
        GS_BAR();
#define GC_ZLOAD(nn) do { _Pragma("unroll") for (int k_ = 0; k_ < 2; ++k_) zr[k_] = *(const u32x4*)(pO + DM + ((size_t)(nn) * 64 + 32 * k_) * 4096); } while (0)
#define GC_OSTORE(nn) do { _Pragma("unroll") for (int k_ = 0; k_ < 2; ++k_) { const u32x4 ov_ = *(const LAS u32x4*)(OL + ((tid >> 4) + 32 * k_) * 272 + (tid & 15) * 16); const u32x4 zv_ = zr[k_]; \
            float o_[8], z_[8]; _Pragma("unroll") for (int e_ = 0; e_ < 4; ++e_) { o_[2 * e_] = bf_lo(ov_[e_]); o_[2 * e_ + 1] = bf_hi(ov_[e_]); z_[2 * e_] = bf_lo(zv_[e_]); z_[2 * e_ + 1] = bf_hi(zv_[e_]); } \
            float ss_ = 0.f; _Pragma("unroll") for (int e_ = 0; e_ < 8; ++e_) ss_ += o_[e_] * o_[e_]; \
            ss_ += __shfl_xor(ss_, 1); ss_ += __shfl_xor(ss_, 2); ss_ += __shfl_xor(ss_, 4); ss_ += __shfl_xor(ss_, 8); \
            const float r_ = __builtin_amdgcn_rsqf(ss_ * (1.0f / HD) + EPS); const f32x4 wa_ = *(const LAS f32x4*)(WN + (tid & 15) * 8), wb_ = *(const LAS f32x4*)(WN + (tid & 15) * 8 + 4); \
            u32x4 w_; w_.x = cvt_pk_bf16(o_[0] * r_ * wa_[0] * silu_f(z_[0]), o_[1] * r_ * wa_[1] * silu_f(z_[1])); w_.y = cvt_pk_bf16(o_[2] * r_ * wa_[2] * silu_f(z_[2]), o_[3] * r_ * wa_[3] * silu_f(z_[3])); \
            w_.z = cvt_pk_bf16(o_[4] * r_ * wb_[0] * silu_f(z_[4]), o_[5] * r_ * wb_[1] * silu_f(z_[5])); w_.w = cvt_pk_bf16(o_[6] * r_ * wb_[2] * silu_f(z_[6]), o_[7] * r_ * wb_[3] * silu_f(z_[7])); \
            *(u32x4*)(pO + ((size_t)(nn) * 64 + 32 * k_) * 4096) = w_; } } while (0)
#define GC_STEP(nn, S) do { \
        if ((nn) > 0) GC_OSTORE((nn) - 1); \
        GC_ZLOAD(nn); \
        f32x4 acc1[8]; \
        _Pragma("unroll") for (int c_ = 0; c_ < 8; ++c_) { acc1[c_] = (f32x4){0.f, 0.f, 0.f, 0.f}; \
            _Pragma("unroll") for (int ks_ = 0; ks_ < 4; ++ks_) acc1[c_] = __builtin_amdgcn_mfma_f32_16x16x32_bf16(fa[S][ks_], *(const LAS bf16x8*)(ST + (16 * c_ + i16) * 272 + (32 * ks_ + 8 * quad) * 2), acc1[c_], 0, 0, 0); } \
        const float glast_ = gl[S]; const f32x4 gv_ = g4[S]; \
        if (wave < 4) { f32x4 ed_; \
            _Pragma("unroll") for (int jj_ = 0; jj_ < 4; ++jj_) ed_[jj_] = __expf(glast_ - gv_[jj_]); \
            _Pragma("unroll") for (int c_ = 0; c_ < 8; ++c_) { const unsigned ua_ = uu[S][c_ >> 1][2 * (c_ & 1)], ub_ = uu[S][c_ >> 1][2 * (c_ & 1) + 1]; f32x4 vn_; \
                vn_[0] = bf_lo(ua_) - acc1[c_][0]; vn_[1] = bf_hi(ua_) - acc1[c_][1]; vn_[2] = bf_lo(ub_) - acc1[c_][2]; vn_[3] = bf_hi(ub_) - acc1[c_][3]; \
                *(LAS u32x2*)(VN + (16 * c_ + i16) * 144 + p0 * 2) = pack4(vn_); *(LAS u32x2*)(VN2 + (16 * c_ + i16) * 144 + p0 * 2) = pack4(vn_ * ed_); } } \
        if ((nn) + 2 < 16) GC_LOAD_A(S); \
        GS_BAR(); \
        if (wave >= 4) { f32x4 eg4_; \
            _Pragma("unroll") for (int jj_ = 0; jj_ < 4; ++jj_) eg4_[jj_] = __expf(gv_[jj_]); \
            _Pragma("unroll") for (int c_ = 0; c_ < 8; ++c_) { f32x4 acco_ = acc1[c_] * eg4_; \
                _Pragma("unroll") for (int ks_ = 0; ks_ < 2; ++ks_) acco_ = __builtin_amdgcn_mfma_f32_16x16x32_bf16(ft[S][ks_], *(const LAS bf16x8*)(VN + (16 * c_ + i16) * 144 + (32 * ks_ + 8 * quad) * 2), acco_, 0, 0, 0); \
                _Pragma("unroll") for (int jj_ = 0; jj_ < 4; ++jj_) *(LAS bf16_t*)(OL + (16 * rb + 4 * quad + jj_) * 272 + (16 * c_ + i16) * 2) = f2bf(acco_[jj_]); } } \
        { const float eg_ = __expf(glast_); \
          _Pragma("unroll") for (int cb_ = 0; cb_ < 8; ++cb_) { f32x4 acc_ = sacc[cb_] * eg_; \
              _Pragma("unroll") for (int ks_ = 0; ks_ < 2; ++ks_) acc_ = __builtin_amdgcn_mfma_f32_16x16x32_bf16(fk[S][ks_], *(const LAS bf16x8*)(VN2 + (16 * cb_ + i16) * 144 + (32 * ks_ + 8 * quad) * 2), acc_, 0, 0, 0); \
              sacc[cb_] = acc_; *(LAS u32x2*)(ST + (16 * cb_ + i16) * 272 + (16 * wave + 4 * quad) * 2) = packsoft4(acc_); } } \
        if ((nn) + 2 < 16) GC_LOAD_B(S); \
        GS_BAR(); } while (0)
#pragma unroll 1
        for (int n = 0; n < 16; n += 2) { GC_STEP(n, 0); GC_STEP(n + 1, 1); }
        GC_OSTORE(15);
#undef GC_STEP
#undef GC_OSTORE
#undef GC_ZLOAD
#undef GC_LOAD_A
#undef GC_LOAD_B
    }
}

constexpr int NPHASES = 37;
__global__ void __launch_bounds__(512, 2) fwd_kernel(Params P0) {
    extern __shared__ __attribute__((aligned(16))) unsigned char lds_raw[];
    LAS unsigned char* lds = (LAS unsigned char*)lds_raw;
    const int tid = threadIdx.x, wg = blockIdx.x, G = gridDim.x;
    volatile LAS unsigned* bw = (volatile LAS unsigned*)(lds + LDS_BARW);
    if (tid < 4) bw[tid] = 0u;
    __syncthreads();
    const int lo = P0.ph_lo, hi = P0.ph_hi;
    XcdBarrier bar; bar.bar = (unsigned*)(P0.ws + WS_CTL); bar.x = 0; bar.st = bw;
    if (hi - lo > 1) bar = xcd_barrier_post((unsigned*)(P0.ws + WS_CTL), bw);
    u64_t* ssq_base = (u64_t*)(P0.ws + WS_SSQ);
    bf16_t* xb = (bf16_t*)(P0.ws + WS_XB);
    const bf16_t* Wb = (const bf16_t*)(P0.ws + WS_W);
    int ph = 0;
#define PH_BEGIN if (ph >= lo && ph < hi) { const Params& P = P0;
#define PH_END if (ph + 1 < hi) xcd_barrier(bar); } ++ph;
    PH_BEGIN phase_prologue(P, lds, wg, G); PH_END
    for (int it = 0; it < 8; ++it) {
        const int L = it >> 1, sub = it & 1, kind = L % 3, mj = L / 3;
        if (sub == 0) {
            PH_BEGIN
                pg8::Gemm g; pg8::EpiIn E; g.A = xb; g.M = T_TOK; g.K = DM; g.lda = DM; E.ssq = ssq_base + (size_t)(2 * L) * T_TOK; E.halo = nullptr; E.kmh = nullptr; E.kml = nullptr; E.kn = nullptr; E.kmax = nullptr; E.sc = (LAS float*)(lds + 131072);
                if (kind == 0) { g.Bt = (const bf16_t*)((const unsigned char*)Wb + (mj == 0 ? W_MOBA_QKV0 : W_MOBA_QKV1)); g.N = 3072; E.O = (bf16_t*)(P.ws + WS_S + S_MOBA_QKV); E.ldc = 3072; E.kmh = (bf16_t*)(P.ws + WS_MISC + MISC_KMEAN); E.kml = E.kmh + 1024 * 128; E.kn = (float*)(P.ws + WS_S + S_MOBA_KN); E.kmax = (float*)(P.ws + WS_S + S_MOBA_KMAX); }
                else if (kind == 1) { g.Bt = (const bf16_t*)((const unsigned char*)Wb + W_SC_IN); g.N = 3072; E.O = (bf16_t*)(P.ws + WS_S + S_SC_PROJ); E.ldc = 3072; }
                else { g.Bt = (const bf16_t*)((const unsigned char*)Wb + W_GDN_IN); g.N = 4096; E.O = (bf16_t*)(P.ws + WS_S + S_GDN_PROJ); E.ldc = 4096; E.halo = (bf16_t*)(P.ws + WS_S + S_GDN_HALO); }
                pg8::StaticOrder S; S.init(g.M, g.N, G, wg);
                pg8::gemm_phase<pg8::EpiIn, false>(lds, g, S, E);
                if (kind == 2) phase_gdn_bg(P, wg, G);
            PH_END
            if (kind == 0) {
                PH_BEGIN phase_moba_gate2(P, lds, mj, wg, G); PH_END
                for (int b = 0; b < 2; ++b) {
                    PH_BEGIN phase_moba_gather(P, lds, mj, b, wg, G); PH_END
                    PH_BEGIN phase_moba_own(P, lds, b, wg, G); PH_END
                }
            } else if (kind == 1) {
                PH_BEGIN phase_sconv(P, wg, G); PH_END
            } else {
                PH_BEGIN phase_gdn_chunk2(P, lds, wg, G); PH_END
                PH_BEGIN phase_gdn_scanA(P, lds, wg, G); PH_END
                PH_BEGIN phase_gdn_scanB(P, lds, wg, G); PH_END
                PH_BEGIN phase_gdn_scanC(P, lds, wg, G); PH_END
            }
        } else {
            PH_BEGIN
                pg8::Gemm g; g.A = xb; g.Bt = (const bf16_t*)((const unsigned char*)Wb + W_FFN_UP + (size_t)L * W_FFN_UP_STRIDE); g.M = T_TOK; g.N = 2 * FFD; g.K = DM; g.lda = DM;
                pg8::EpiUp E; E.ACT = (bf16_t*)(P.ws + WS_S + S_FFN_ACT); E.halo = (float*)(P.ws + WS_S + S_FFN_HALO); E.cw = P.in[IN_FFN_CONV] + (size_t)L * 3 * (2 * FFD); E.ssq = ssq_base + (size_t)(2 * L + 1) * T_TOK;
                pg8::StaticOrder S; S.init(g.M, g.N, G, wg);
                pg8::gemm_phase<pg8::EpiUp, true>(lds, g, S, E);
            PH_END
            PH_BEGIN phase_ffn_fix(P, L, wg, G); PH_END
        }
        PH_BEGIN
            pg8::Gemm g; g.M = T_TOK; g.N = DM;
            if (sub == 1) { g.A = (const bf16_t*)(P.ws + WS_S + S_FFN_ACT); g.lda = FFD; g.K = FFD; g.Bt = (const bf16_t*)((const unsigned char*)Wb + W_FFN_DN + (size_t)L * W_FFN_DN_STRIDE); }
            else if (kind == 0) { g.A = (const bf16_t*)(P.ws + WS_S + S_MOBA_QKV); g.lda = 3072; g.K = DM; g.Bt = (const bf16_t*)((const unsigned char*)Wb + (mj == 0 ? W_MOBA_O0 : W_MOBA_O1)); }
            else if (kind == 1) { g.A = (const bf16_t*)(P.ws + WS_S + S_SC_Y); g.lda = DM; g.K = DM; g.Bt = (const bf16_t*)((const unsigned char*)Wb + W_SC_OUT); }
            else { g.A = (const bf16_t*)(P.ws + WS_S + S_GDN_PROJ) + 2 * DM; g.lda = 4096; g.K = DM; g.Bt = (const bf16_t*)((const unsigned char*)Wb + W_GDN_O); }
            pg8::EpiOut E; E.XB = xb; E.ssq_next = ssq_base + (size_t)(2 * L + 1 + sub) * T_TOK; E.ts = (LAS float*)(lds + 131072);
            pg8::StaticOrder S; S.init(g.M, g.N, G, wg);
            pg8::gemm_phase<pg8::EpiOut, false>(lds, g, S, E);
        PH_END
    }
    PH_BEGIN phase_final(P, wg, G); PH_END
#undef PH_BEGIN
#undef PH_END
}

extern "C" void kernel_launch(void* const* d_in, const int* in_sizes, int n_in, void* d_out, int out_size, void* d_ws, size_t ws_size, hipStream_t stream) {
    static int grid = 0;
    if (grid == 0) {
        if (n_in != 18 || out_size != T_TOK * DM || ws_size < WS_END) { fprintf(stderr, "kernel_launch: unexpected problem (n_in %d, out %d, ws %zu)\n", n_in, out_size, ws_size); grid = -1; return; }
        int dev = 0, cus = 0, per_cu = 0;
        if (hipGetDevice(&dev) != hipSuccess || hipDeviceGetAttribute(&cus, hipDeviceAttributeMultiprocessorCount, dev) != hipSuccess) { grid = -1; return; }
        if (hipFuncSetAttribute((const void*)fwd_kernel, hipFuncAttributeMaxDynamicSharedMemorySize, LDS_BYTES) != hipSuccess) { fprintf(stderr, "kernel_launch: hipFuncSetAttribute failed\n"); grid = -1; return; }
        if (hipOccupancyMaxActiveBlocksPerMultiprocessor(&per_cu, (const void*)fwd_kernel, 512, LDS_BYTES) != hipSuccess || per_cu < 1) { fprintf(stderr, "kernel_launch: occupancy query says %d blocks per CU\n", per_cu); (void)hipGetLastError(); }
        grid = cus;
    }
    if (grid < 0) return;
    (void)in_sizes;
    hipMemsetAsync((char*)d_ws + WS_CTL, 0, CTL_ZERO_BYTES, stream);
    Params p; memset(&p, 0, sizeof(p));
    for (int i = 0; i < 18; ++i) p.in[i] = (const float*)d_in[i];
    p.out = (float*)d_out; p.ws = (unsigned char*)d_ws;
#if MK_N_LAUNCHES == 1
    p.ph_lo = 0; p.ph_hi = NPHASES;
    hipLaunchKernelGGL(fwd_kernel, dim3(grid), dim3(512), LDS_BYTES, stream, p);
#else
    for (int li = 0; li < NPHASES; ++li) { p.ph_lo = li; p.ph_hi = li + 1; hipLaunchKernelGGL(fwd_kernel, dim3(grid), dim3(512), LDS_BYTES, stream, p); }
#endif
}
```
